# Optimizing an MI355X kernel written in HIP

```python
import math
import jax, jax.numpy as jnp
from jax import lax
import numpy as np

D_MODEL = 1024
BATCH = 4
SEQ = 8192
DEPTH = 1

N_HEADS_A = 8
HEAD_DIM_A = 64
N_IDX_HEADS = 8
IDX_DIM = 64
TOPK_MAX = 256
Q_BLOCK = 128
N_HEADS_B = 4
HEAD_DIM_B = 128
RET_CHUNK = 128
RET_THETA_BASE = 10000.0
D_A = N_HEADS_A * HEAD_DIM_A
D_B = N_HEADS_B * HEAD_DIM_B
D_MIX = D_A + D_B
D_FF = ((8 * D_MODEL // 3 + 255) // 256) * 256
N_BUCKETS = 32
MAX_DISTANCE = 128
EPS = 1e-6
SPLIT_SIZES = (D_A, D_A, D_A, N_IDX_HEADS * IDX_DIM, IDX_DIM, N_IDX_HEADS, D_B, D_B, D_B, D_B)
D_IN = D_A * 3 + N_IDX_HEADS * IDX_DIM + IDX_DIM + N_IDX_HEADS + D_B * 4

kernel_name = "hymba_dsa_retnet_hybrid_layer"


def rmsnorm(x, g):
    x32 = x.astype(jnp.float32)
    y = x32 * lax.rsqrt(jnp.mean(x32 * x32, axis=-1, keepdims=True) + EPS)
    return (y * g.astype(jnp.float32)).astype(x.dtype)


def layernorm(x, g, b):
    x32 = x.astype(jnp.float32)
    mu = jnp.mean(x32, axis=-1, keepdims=True)
    var = jnp.mean(jnp.square(x32 - mu), axis=-1, keepdims=True)
    y = (x32 - mu) * lax.rsqrt(var + EPS)
    return (y * g.astype(jnp.float32) + b.astype(jnp.float32)).astype(x.dtype)


def rel_bucket(dist):
    n = jnp.maximum(dist, 0)
    max_exact = N_BUCKETS // 2
    nf = jnp.maximum(n, max_exact).astype(jnp.float32)
    large = max_exact + (jnp.log(nf / max_exact) / math.log(MAX_DISTANCE / max_exact)
                         * (N_BUCKETS - max_exact)).astype(jnp.int32)
    large = jnp.minimum(large, N_BUCKETS - 1)
    return jnp.where(n < max_exact, n, large)


def rotate(x, pos):
    half = x.shape[-1] // 2
    theta = 1.0 / (RET_THETA_BASE ** jnp.linspace(0.0, 1.0, half, dtype=jnp.float32))
    ang = pos.astype(jnp.float32)[:, None] * theta[None, :]
    cos = jnp.cos(ang)[None, :, None, :]
    sin = jnp.sin(ang)[None, :, None, :]
    x32 = x.astype(jnp.float32)
    x1, x2 = x32[..., :half], x32[..., half:]
    out = jnp.concatenate([x1 * cos - x2 * sin, x2 * cos + x1 * sin], axis=-1)
    return out.astype(x.dtype)


def sparse_attention(q, k, v, q_idx, k_idx, w_idx, rel_bias, k_top):
    B, L = q.shape[0], q.shape[1]
    n_blocks = L // Q_BLOCK
    key_pos = jnp.arange(L, dtype=jnp.int32)
    b_ix = jnp.arange(B)[:, None, None]
    idx_scale = IDX_DIM ** -0.5
    attn_scale = HEAD_DIM_A ** -0.5

    def block(i):
        start = i * Q_BLOCK
        qi = lax.dynamic_slice_in_dim(q, start, Q_BLOCK, axis=1)
        qi_idx = lax.dynamic_slice_in_dim(q_idx, start, Q_BLOCK, axis=1)
        wi = lax.dynamic_slice_in_dim(w_idx, start, Q_BLOCK, axis=1)
        q_pos = start + jnp.arange(Q_BLOCK, dtype=jnp.int32)
        dots = jnp.einsum('bqhd,bsd->bqhs', qi_idx, k_idx) * idx_scale
        score = jnp.einsum('bqh,bqhs->bqs', wi, jax.nn.relu(dots)).astype(jnp.float32)
        causal = key_pos[None, :] <= q_pos[:, None]
        score = jnp.where(causal[None], score, -jnp.inf)
        _, sel = lax.top_k(score, k_top)
        k_sel = k[b_ix, sel]
        v_sel = v[b_ix, sel]
        logits = jnp.einsum('bqhd,bqkhd->bhqk', qi, k_sel).astype(jnp.float32) * attn_scale
        dist = q_pos[None, :, None] - sel
        bias = rel_bias[rel_bucket(dist)].astype(jnp.float32)
        logits = logits + jnp.transpose(bias, (0, 3, 1, 2))
        logits = jnp.where((dist >= 0)[:, None], logits, -jnp.inf)
        p = jax.nn.softmax(logits, axis=-1).astype(v.dtype)
        return jnp.einsum('bhqk,bqkhd->bqhd', p, v_sel)

    out = lax.map(block, jnp.arange(n_blocks))
    out = jnp.transpose(out, (1, 0, 2, 3, 4))
    return out.reshape(B, L, N_HEADS_A * HEAD_DIM_A)


def retention(q, k, v, g, gn_g):
    B, L, H, D = q.shape
    C = RET_CHUNK
    nc = L // C
    gamma = 1.0 - 2.0 ** (-5.0 - jnp.arange(H, dtype=jnp.float32))
    log_g = jnp.log(gamma)
    pos = jnp.arange(C, dtype=jnp.float32)
    diff = pos[:, None] - pos[None, :]
    inner_decay = jnp.where(diff >= 0, jnp.exp(log_g[:, None, None] * jnp.maximum(diff, 0.0)), 0.0)
    q_decay = jnp.exp(log_g[:, None] * (pos[None, :] + 1.0))
    k_decay = jnp.exp(log_g[:, None] * (C - 1.0 - pos[None, :]))
    chunk_decay = jnp.exp(log_g * C)
    dt = q.dtype
    inner_decay, q_decay, k_decay, chunk_decay = (a.astype(dt) for a in (inner_decay, q_decay, k_decay, chunk_decay))

    def to_chunks(t):
        return jnp.transpose(t.reshape(B, nc, C, H, D), (1, 0, 3, 2, 4))

    qc, kc, vc = to_chunks(q), to_chunks(k * (D ** -0.5)), to_chunks(v)

    def step(state, inp):
        qi, ki, vi = inp
        inner = jnp.einsum('bhid,bhjd->bhij', qi, ki) * inner_decay
        y = (jnp.einsum('bhij,bhje->bhie', inner, vi)
             + jnp.einsum('bhid,bhde->bhie', qi, state) * q_decay[None, :, :, None])
        state = (state * chunk_decay[None, :, None, None]
                 + jnp.einsum('bhjd,bhje->bhde', ki * k_decay[None, :, :, None], vi))
        return state, y

    state0 = jnp.zeros((B, H, D, D), dtype=dt)
    _, ys = lax.scan(step, state0, (qc, kc, vc))
    y = jnp.transpose(ys, (1, 0, 3, 2, 4)).reshape(B, L, H, D)
    y32 = y.astype(jnp.float32)
    y32 = y32 * lax.rsqrt(jnp.mean(y32 * y32, axis=-1, keepdims=True) + EPS)
    y = (y32.reshape(B, L, H * D) * gn_g.astype(jnp.float32)).astype(dt)
    return y * jax.nn.silu(g.reshape(B, L, H * D))


def setup_inputs(seed: int = 0) -> dict:
    key = jax.random.key(seed)
    ks = jax.random.split(key, 16)
    f32 = jnp.float32

    def nrm(k, shape, scale):
        return jax.random.normal(k, shape, f32) * scale

    return {
        "x": nrm(ks[0], (BATCH, SEQ, D_MODEL), 1.0),
        "norm_mix_g": 1.0 + nrm(ks[1], (DEPTH, D_MODEL), 0.02),
        "w_in": nrm(ks[2], (DEPTH, D_MODEL, D_IN), D_MODEL ** -0.5),
        "idx_k_ln_g": 1.0 + nrm(ks[3], (DEPTH, IDX_DIM), 0.02),
        "idx_k_ln_b": nrm(ks[4], (DEPTH, IDX_DIM), 0.02),
        "rel_bias": nrm(ks[5], (N_BUCKETS, N_HEADS_A), 0.5),
        "ret_gn_g": 1.0 + nrm(ks[6], (DEPTH, D_B), 0.02),
        "w_out": nrm(ks[7], (DEPTH, D_MIX, D_MODEL), D_MIX ** -0.5),
        "norm_ffn_g": 1.0 + nrm(ks[8], (DEPTH, D_MODEL), 0.02),
        "w_gate": nrm(ks[9], (DEPTH, D_MODEL, D_FF), D_MODEL ** -0.5),
        "w_up": nrm(ks[10], (DEPTH, D_MODEL, D_FF), D_MODEL ** -0.5),
        "w_down": nrm(ks[11], (DEPTH, D_FF, D_MODEL), D_FF ** -0.5),
        "norm_final_g": 1.0 + nrm(ks[12], (D_MODEL,), 0.02),
    }


def reference(x, norm_mix_g, w_in, idx_k_ln_g, idx_k_ln_b, rel_bias, ret_gn_g, w_out,
              norm_ffn_g, w_gate, w_up, w_down, norm_final_g):
    B, L, _ = x.shape
    k_top = min(TOPK_MAX, L // 4)
    pos = jnp.arange(L, dtype=jnp.int32)
    offsets = list(np.cumsum(SPLIT_SIZES)[:-1])
    for layer in range(DEPTH):
        h = rmsnorm(x, norm_mix_g[layer])
        proj = jnp.einsum('bld,de->ble', h, w_in[layer])
        (qa, ka, va, q_idx, k_idx, w_idx, qb, kb, vb, gb) = jnp.split(proj, offsets, axis=-1)
        qa = qa.reshape(B, L, N_HEADS_A, HEAD_DIM_A)
        ka = ka.reshape(B, L, N_HEADS_A, HEAD_DIM_A)
        va = va.reshape(B, L, N_HEADS_A, HEAD_DIM_A)
        q_idx = q_idx.reshape(B, L, N_IDX_HEADS, IDX_DIM)
        k_idx = layernorm(k_idx, idx_k_ln_g[layer], idx_k_ln_b[layer])
        w_idx = w_idx * (N_IDX_HEADS ** -0.5)
        out_a = sparse_attention(qa, ka, va, q_idx, k_idx, w_idx, rel_bias, k_top)
        qb = rotate(qb.reshape(B, L, N_HEADS_B, HEAD_DIM_B), pos)
        kb = rotate(kb.reshape(B, L, N_HEADS_B, HEAD_DIM_B), pos)
        vb = vb.reshape(B, L, N_HEADS_B, HEAD_DIM_B)
        gb = gb.reshape(B, L, N_HEADS_B, HEAD_DIM_B)
        out_b = retention(qb, kb, vb, gb, ret_gn_g[layer])
        mix = jnp.concatenate([out_a, out_b], axis=-1)
        x = x + jnp.einsum('ble,ed->bld', mix, w_out[layer])
        h2 = rmsnorm(x, norm_ffn_g[layer])
        u = jax.nn.silu(jnp.einsum('bld,df->blf', h2, w_gate[layer])) * jnp.einsum('bld,df->blf', h2, w_up[layer])
        x = x + jnp.einsum('blf,fd->bld', u, w_down[layer])
    return rmsnorm(x, norm_final_g)
```

```cpp
#include <hip/hip_runtime.h>
#include <hip/hip_bf16.h>
#include <cstdio>
#include <cstdint>
#include <cmath>

#define GAS __attribute__((address_space(1)))
#define LAS __attribute__((address_space(3)))
typedef unsigned short u16;
typedef _Float16 f16x8 __attribute__((ext_vector_type(8)));
typedef _Float16 f16x2 __attribute__((ext_vector_type(2)));
typedef float f32x2 __attribute__((ext_vector_type(2)));
typedef float f32x4 __attribute__((ext_vector_type(4)));
typedef float f32x16 __attribute__((ext_vector_type(16)));
typedef unsigned v4u __attribute__((ext_vector_type(4)));
typedef unsigned v2u __attribute__((ext_vector_type(2)));
typedef GAS unsigned gu32;
#define RLX_AGENT __ATOMIC_RELAXED, __HIP_MEMORY_SCOPE_AGENT
#define LDS_WAIT() asm volatile("s_waitcnt lgkmcnt(0)" ::: "memory")
#define VM_WAIT() asm volatile("s_waitcnt vmcnt(0)" ::: "memory")

__device__ __forceinline__ unsigned cvt_pk_f16(float lo, float hi) { f32x2 v = {lo, hi}; f16x2 h = __builtin_convertvector(v, f16x2); return __builtin_bit_cast(unsigned, h); }
__device__ __forceinline__ unsigned cvt_pk_bf16(float lo, float hi) { unsigned r; asm volatile("v_cvt_pk_bf16_f32 %0, %1, %2" : "=v"(r) : "v"(lo), "v"(hi)); return r; }
__device__ __forceinline__ float h2f(u16 h) { return (float)__builtin_bit_cast(_Float16, h); }
__device__ __forceinline__ float silu_f(float x) { return x * __builtin_amdgcn_rcpf(1.0f + __builtin_amdgcn_exp2f(-1.4426950408889634f * x)); }
__device__ __forceinline__ int crow(int r, int hi) { return (r & 3) + 8 * (r >> 2) + 4 * hi; }

constexpr int BATCH = 4, SEQ = 8192, DM = 1024, MTOK = BATCH * SEQ;
constexpr int NHA = 8, DHA = 64, NHB = 4, DHB = 128, DFF = 2816;
constexpr int N_IN = 4352;
constexpr float EPS = 1e-6f;
constexpr float C2 = 0.125f * 1.4426950408889634f;

namespace pg8 {
#define PG8_LAS __attribute__((address_space(3)))
constexpr int BM = 256, BK = 64, HALF = 128, HTB = HALF * BK * 2, STAGE_BYTES = 8 * HTB, NXCD = 8, WGM = 8;
__host__ __device__ __forceinline__ int lds_byte(int r, int c) { const int st = (r >> 4) * 2 + (c >> 5), rr = r & 15, cc = c & 31, ob = rr * 64 + cc * 2; return st * 1024 + (ob ^ (((ob >> 9) & 1) << 5)); }
__host__ __device__ __forceinline__ void stage_rc(int b, int& R, int& C) { const int st = b / 1024, sb = b % 1024, swz = sb ^ (((sb >> 9) & 1) << 5); R = (st >> 1) * 16 + swz / 64; C = (st & 1) * 32 + (swz % 64) / 2; }
__host__ __device__ __forceinline__ int perm32(int rho) { const int n = rho >> 4, i = rho & 15; return 8 * (i >> 2) + 4 * n + (i & 3); }
struct Unit { int pm, pn; };
struct Gemm { const u16* A; const u16* Bt; int M, N, K; };
struct StaticOrder {
    int nM, nN, nwg, G, c;
    __host__ __device__ void init(int M, int N, int G_, int c_) { nM = M / BM; nN = N / BM; nwg = nM * nN; G = G_; c = c_; }
    __host__ __device__ bool next(int i, Unit& u) const {
        const long L = (long)i * G + c; if (L >= nwg) return false;
        int wgid = (int)L; { const int q = nwg / NXCD, r = nwg % NXCD, xcd = wgid % NXCD, off = wgid / NXCD; wgid = (xcd < r ? xcd * (q + 1) : r * (q + 1) + (xcd - r) * q) + off; }
        const int nig = WGM * nN, gid = wgid / nig, fm = gid * WGM, gsz = (nM - fm) < WGM ? (nM - fm) : WGM;
        u.pm = fm + ((wgid % nig) % gsz); u.pn = (wgid % nig) / gsz; return true;
    }
    __device__ __forceinline__ void a_ready(const Unit&) const {}
    __device__ __forceinline__ void done(const Unit&) const {}
};

struct EpiProj {
    static constexpr bool PERM = true, AFTER_DRAIN = false;
    unsigned char* tbase; float* kiraw; float* wi; const float* rinv;
    __device__ __forceinline__ void operator()(const f32x4 (&acc)[2][2][4][2], const Unit& u, int wr, int wc, int fr, int fq) const {
        const int row0 = u.pm * BM + wr * 64 + fr; const int pn = u.pn;
        if (pn < 16) {
            const int tsel = pn >> 1; u16* T = (u16*)(tbase + (size_t)tsel * (32u << 20));
            const int colt = (pn & 1) * 256 + wc * 32 + 8 * fq;
            const float sc = (tsel == 0) ? C2 : ((tsel == 5) ? 0.08838834764831845f : 1.0f);
#pragma unroll
            for (int ai = 0; ai < 2; ++ai)
#pragma unroll
                for (int m = 0; m < 4; ++m) { const int row = row0 + ai * HALF + m * 16; const float r = rinv[row] * sc; u16* rowp = T + (size_t)row * 512 + colt;
#pragma unroll
                    for (int bj = 0; bj < 2; ++bj) { f32x4 v0 = acc[ai][bj][m][0] * r, v1 = acc[ai][bj][m][1] * r;
                        if (tsel == 7) {
#pragma unroll
                            for (int j = 0; j < 4; ++j) { v0[j] = silu_f(v0[j]); v1[j] = silu_f(v1[j]); } }
                        v4u w;
                        if (tsel < 3) { w.x = cvt_pk_bf16(v0[0], v0[1]); w.y = cvt_pk_bf16(v0[2], v0[3]); w.z = cvt_pk_bf16(v1[0], v1[1]); w.w = cvt_pk_bf16(v1[2], v1[3]); }
                        else { w.x = cvt_pk_f16(v0[0], v0[1]); w.y = cvt_pk_f16(v0[2], v0[3]); w.z = cvt_pk_f16(v1[0], v1[1]); w.w = cvt_pk_f16(v1[2], v1[3]); }
                        *(v4u*)(rowp + bj * HALF) = w; } }
        } else {
            const int c0 = wc * 32 + 8 * fq;
#pragma unroll
            for (int ai = 0; ai < 2; ++ai)
#pragma unroll
                for (int m = 0; m < 4; ++m) { const int row = row0 + ai * HALF + m * 16; const float r = rinv[row];
                    if (c0 < 64) { *(f32x4*)(kiraw + (size_t)row * 64 + c0) = acc[ai][0][m][0] * r; *(f32x4*)(kiraw + (size_t)row * 64 + c0 + 4) = acc[ai][0][m][1] * r; }
                    else if (c0 == 64) { const float s = r * 0.35355339059327373f; *(f32x4*)(wi + (size_t)row * 8) = acc[ai][0][m][0] * s; *(f32x4*)(wi + (size_t)row * 8 + 4) = acc[ai][0][m][1] * s; } }
        }
    }
};
struct EpiX2 {
    static constexpr bool PERM = false, AFTER_DRAIN = false;
    const float* x; float* x2; u16* x2h; float* part;
    __device__ __forceinline__ void operator()(const f32x4 (&acc)[2][2][4][2], const Unit& u, int wr, int wc, int fr, int fq) const {
        const int row0 = u.pm * BM + wr * 64 + fr, col0 = u.pn * BM + wc * 32 + 4 * fq;
#pragma unroll
        for (int ai = 0; ai < 2; ++ai)
#pragma unroll
            for (int m = 0; m < 4; ++m) { const int row = row0 + ai * HALF + m * 16; const size_t off = (size_t)row * DM + col0; float ss = 0.f;
#pragma unroll
                for (int bj = 0; bj < 2; ++bj)
#pragma unroll
                    for (int n = 0; n < 2; ++n) { const size_t o = off + bj * HALF + n * 16; const f32x4 v = *(const f32x4*)(x + o) + acc[ai][bj][m][n];
                        *(f32x4*)(x2 + o) = v; v2u h; h.x = cvt_pk_f16(v[0], v[1]); h.y = cvt_pk_f16(v[2], v[3]); *(v2u*)(x2h + o) = h;
                        ss += (v[0] * v[0] + v[1] * v[1]) + (v[2] * v[2] + v[3] * v[3]); }
                ss += __shfl_xor(ss, 16); ss += __shfl_xor(ss, 32);
                if (fq == 0) part[(size_t)row * 16 + u.pn * 4 + wc] = ss; }
    }
};
struct EpiGU {
    static constexpr bool PERM = true, AFTER_DRAIN = false;
    u16* U; const float* part;
    __device__ __forceinline__ void operator()(const f32x4 (&acc)[2][2][4][2], const Unit& u, int wr, int wc, int fr, int fq) const {
        const int row0 = u.pm * BM + wr * 64 + fr, colt = u.pn * HALF + wc * 32 + 8 * fq;
#pragma unroll
        for (int ai = 0; ai < 2; ++ai)
#pragma unroll
            for (int m = 0; m < 4; ++m) { const int row = row0 + ai * HALF + m * 16; const f32x4* pp = (const f32x4*)(part + (size_t)row * 16);
                const f32x4 p0 = pp[0], p1 = pp[1], p2 = pp[2], p3 = pp[3];
                const float ssq = ((p0[0] + p0[1]) + (p0[2] + p0[3])) + ((p1[0] + p1[1]) + (p1[2] + p1[3])) + ((p2[0] + p2[1]) + (p2[2] + p2[3])) + ((p3[0] + p3[1]) + (p3[2] + p3[3]));
                const float r = __builtin_amdgcn_rsqf(ssq * (1.0f / DM) + EPS);
                float o[8];
#pragma unroll
                for (int n = 0; n < 2; ++n)
#pragma unroll
                    for (int j = 0; j < 4; ++j) o[4 * n + j] = silu_f(acc[ai][0][m][n][j] * r) * (acc[ai][1][m][n][j] * r);
                v4u w; w.x = cvt_pk_f16(o[0], o[1]); w.y = cvt_pk_f16(o[2], o[3]); w.z = cvt_pk_f16(o[4], o[5]); w.w = cvt_pk_f16(o[6], o[7]);
                *(v4u*)(U + (size_t)row * DFF + colt) = w; }
    }
};
struct EpiDown {
    static constexpr bool PERM = false, AFTER_DRAIN = false;
    float* x2; float* part;
    __device__ __forceinline__ void operator()(const f32x4 (&acc)[2][2][4][2], const Unit& u, int wr, int wc, int fr, int fq) const {
        const int row0 = u.pm * BM + wr * 64 + fr, col0 = u.pn * BM + wc * 32 + 4 * fq;
#pragma unroll
        for (int ai = 0; ai < 2; ++ai)
#pragma unroll
            for (int m = 0; m < 4; ++m) { const int row = row0 + ai * HALF + m * 16; const size_t off = (size_t)row * DM + col0; float ss = 0.f;
#pragma unroll
                for (int bj = 0; bj < 2; ++bj)
#pragma unroll
                    for (int n = 0; n < 2; ++n) { const size_t o = off + bj * HALF + n * 16; const f32x4 v = *(const f32x4*)(x2 + o) + acc[ai][bj][m][n];
                        *(f32x4*)(x2 + o) = v; ss += (v[0] * v[0] + v[1] * v[1]) + (v[2] * v[2] + v[3] * v[3]); }
                ss += __shfl_xor(ss, 16); ss += __shfl_xor(ss, 32);
                if (fq == 0) part[(size_t)row * 16 + u.pn * 4 + wc] = ss; }
    }
};

template <class Epi, class Sched, bool ALIGN_EPI = false, bool SP2 = false>
__device__ __forceinline__ void gemm_phase(PG8_LAS unsigned char* lds, const Gemm g, const Sched& S, const Epi& E) {
    const int tid = threadIdx.x, wid = __builtin_amdgcn_readfirstlane(tid >> 6), lane = tid & 63, wr = wid >> 2, wc = wid & 3, fr = lane & 15, fq = lane >> 4;
    const int K = g.K, nt = K / BK;
    unsigned voffA[2], voffB[2];
#pragma unroll
    for (int i = 0; i < 2; ++i) { int R, C; stage_rc(tid * 16 + i * 8192, R, C); const int Rb = Epi::PERM ? ((R & ~31) + perm32(R & 31)) : R;
        voffA[i] = (unsigned)(R * K + C) * 2u; voffB[i] = (unsigned)(Rb * K + C) * 2u; }
    const size_t kstep = (size_t)(BK * 2);
    const size_t hstep = (size_t)HALF * K * 2;
    const size_t tstep = 2 * hstep;
    const unsigned ldsw = (unsigned)wid * 1024u;
    const int aoff = lds_byte(wr * 64 + fr, fq * 8), boff = lds_byte(wc * 32 + fr, fq * 8);
#define PG8_SA(b, h) (((b) * 2 + (h)) * HTB)
#define PG8_SB(b, h) ((4 + (b) * 2 + (h)) * HTB)
#define PG8_STAGE(bufoff, gbase, voff) do { _Pragma("unroll") for (int _i = 0; _i < 2; ++_i) \
        __builtin_amdgcn_global_load_lds((const unsigned*)((const char*)(gbase) + (voff)[_i]), (PG8_LAS unsigned*)(lds + (bufoff) + ldsw + _i * 8192), 16, 0, 0); } while (0)
#define PG8_LDA(dst, b, h) do { _Pragma("unroll") for (int m = 0; m < 4; ++m) _Pragma("unroll") for (int k = 0; k < 2; ++k) dst[m][k] = *(const PG8_LAS f16x8*)(lds + PG8_SA(b, h) + aoff + m * 2048 + k * 1024); } while (0)
#define PG8_LDB(dst, b, h) do { _Pragma("unroll") for (int n = 0; n < 2; ++n) _Pragma("unroll") for (int k = 0; k < 2; ++k) dst[n][k] = *(const PG8_LAS f16x8*)(lds + PG8_SB(b, h) + boff + n * 2048 + k * 1024); } while (0)
#define PG8_MMA(ai, bj, At, Bt) do { __builtin_amdgcn_s_setprio(1); _Pragma("unroll") for (int m = 0; m < 4; ++m) _Pragma("unroll") for (int n = 0; n < 2; ++n) _Pragma("unroll") for (int k = 0; k < 2; ++k) \
        acc[ai][bj][m][n] = __builtin_amdgcn_mfma_f32_16x16x32_f16(Bt[n][k], At[m][k], acc[ai][bj][m][n], 0, 0, 0); __builtin_amdgcn_s_setprio(0); } while (0)
#define PG8_WAIT_V(n) asm volatile("s_waitcnt vmcnt(" #n ")" ::: "memory")
#define PG8_WAIT_L(n) asm volatile("s_waitcnt lgkmcnt(" #n ")" ::: "memory")
#define PG8_BAR __builtin_amdgcn_s_barrier()
#define PG8_SCHED __builtin_amdgcn_sched_barrier(0)
    Unit cur, nxt; int ui = 0;
    if (!S.next(0, cur)) return;
    f32x4 acc[2][2][4][2];
#pragma unroll
    for (int a = 0; a < 2; ++a)
#pragma unroll
        for (int b = 0; b < 2; ++b)
#pragma unroll
            for (int m = 0; m < 4; ++m)
#pragma unroll
                for (int n = 0; n < 2; ++n) acc[a][b][m][n] = (f32x4){0.f, 0.f, 0.f, 0.f};
    f16x8 At[4][2], B0[2][2], B1[2][2];
    const char* cA = (const char*)g.A + (size_t)cur.pm * tstep; const char* cB = (const char*)g.Bt + (size_t)cur.pn * tstep;
    S.a_ready(cur);
    if constexpr (SP2) {
        PG8_STAGE(PG8_SB(0, 0), cB, voffB); PG8_STAGE(PG8_SB(0, 1), cB + hstep, voffB); PG8_STAGE(PG8_SA(0, 0), cA, voffA); PG8_STAGE(PG8_SA(0, 1), cA + hstep, voffA);
        if (wr == 1) PG8_BAR;
        PG8_WAIT_V(2); PG8_BAR;
        PG8_STAGE(PG8_SB(1, 0), cB + kstep, voffB); PG8_STAGE(PG8_SA(1, 0), cA + kstep, voffA); PG8_STAGE(PG8_SB(1, 1), cB + hstep + kstep, voffB);
        PG8_WAIT_V(6); PG8_BAR;
    } else {
        PG8_STAGE(PG8_SB(0, 0), cB, voffB); PG8_STAGE(PG8_SA(0, 0), cA, voffA); PG8_STAGE(PG8_SB(0, 1), cB + hstep, voffB); PG8_STAGE(PG8_SA(0, 1), cA + hstep, voffA);
        if (wr == 1) PG8_BAR;
        PG8_WAIT_V(4); PG8_BAR;
        PG8_STAGE(PG8_SB(1, 0), cB + kstep, voffB); PG8_STAGE(PG8_SA(1, 0), cA + kstep, voffA); PG8_STAGE(PG8_SB(1, 1), cB + hstep + kstep, voffB);
        PG8_WAIT_V(6); PG8_BAR;
    }
    for (;;) {
        const bool has_next = S.next(ui + 1, nxt);
        const char* nA = has_next ? (const char*)g.A + (size_t)nxt.pm * tstep : cA; const char* nB = has_next ? (const char*)g.Bt + (size_t)nxt.pn * tstep : cB;
        for (int t = 0; t < nt; t += 2) {
            const bool last = (t == nt - 2);
            const char* a1 = cA + (size_t)(t + 1) * kstep;
            const char* a2 = last ? nA : cA + (size_t)(t + 2) * kstep; const char* b2 = last ? nB : cB + (size_t)(t + 2) * kstep;
            const char* a3 = a2 + kstep; const char* b3 = b2 + kstep;
            if (last && has_next) S.a_ready(nxt);
            if constexpr (SP2) {
            PG8_LDB(B0, 0, 0); PG8_LDB(B1, 0, 1); PG8_SCHED; PG8_LDA(At, 0, 0); PG8_STAGE(PG8_SA(1, 1), a1 + hstep, voffA);
            PG8_WAIT_V(8); PG8_WAIT_L(0); PG8_BAR; PG8_MMA(0, 0, At, B0); PG8_MMA(0, 1, At, B1); PG8_BAR; PG8_SCHED;
            PG8_LDA(At, 0, 1); PG8_STAGE(PG8_SB(0, 0), b2, voffB); PG8_STAGE(PG8_SB(0, 1), b2 + hstep, voffB); PG8_STAGE(PG8_SA(0, 0), a2, voffA);
            PG8_WAIT_V(8); PG8_WAIT_L(0); PG8_BAR; PG8_MMA(1, 0, At, B0); PG8_MMA(1, 1, At, B1); PG8_BAR; PG8_SCHED;
            PG8_LDB(B0, 1, 0); PG8_LDB(B1, 1, 1); PG8_SCHED; PG8_LDA(At, 1, 0); PG8_STAGE(PG8_SA(0, 1), a2 + hstep, voffA);
            PG8_WAIT_V(8); PG8_WAIT_L(0); PG8_BAR; PG8_MMA(0, 0, At, B0); PG8_MMA(0, 1, At, B1); PG8_BAR; PG8_SCHED;
            PG8_LDA(At, 1, 1); PG8_STAGE(PG8_SB(1, 0), b3, voffB); PG8_STAGE(PG8_SB(1, 1), b3 + hstep, voffB); PG8_STAGE(PG8_SA(1, 0), a3, voffA);
            PG8_WAIT_V(8); PG8_WAIT_L(0); PG8_BAR; PG8_MMA(1, 0, At, B0); PG8_MMA(1, 1, At, B1); PG8_BAR; PG8_SCHED;
            } else {
            PG8_LDB(B0, 0, 0); PG8_SCHED; PG8_LDA(At, 0, 0); PG8_STAGE(PG8_SA(1, 1), a1 + hstep, voffA);
            PG8_WAIT_L(8); PG8_BAR; PG8_WAIT_L(0); PG8_MMA(0, 0, At, B0); PG8_BAR; PG8_SCHED;
            PG8_LDB(B1, 0, 1); PG8_STAGE(PG8_SB(0, 0), b2, voffB);
            PG8_BAR; PG8_WAIT_L(0); PG8_MMA(0, 1, At, B1); PG8_BAR;
            PG8_LDA(At, 0, 1); PG8_STAGE(PG8_SA(0, 0), a2, voffA);
            PG8_BAR; PG8_WAIT_L(0); PG8_MMA(1, 0, At, B0); PG8_BAR; PG8_SCHED;
            PG8_STAGE(PG8_SB(0, 1), b2 + hstep, voffB);
            PG8_WAIT_V(6); PG8_BAR; PG8_MMA(1, 1, At, B1); PG8_BAR;
            PG8_LDB(B0, 1, 0); PG8_SCHED; PG8_LDA(At, 1, 0); PG8_STAGE(PG8_SA(0, 1), a2 + hstep, voffA);
            PG8_WAIT_L(8); PG8_BAR; PG8_WAIT_L(0); PG8_MMA(0, 0, At, B0); PG8_BAR; PG8_SCHED;
            PG8_LDB(B1, 1, 1); PG8_STAGE(PG8_SB(1, 0), b3, voffB);
            PG8_BAR; PG8_WAIT_L(0); PG8_MMA(0, 1, At, B1); PG8_BAR;
            PG8_LDA(At, 1, 1); PG8_STAGE(PG8_SA(1, 0), a3, voffA);
            PG8_BAR; PG8_WAIT_L(0); PG8_MMA(1, 0, At, B0); PG8_BAR; PG8_SCHED;
            PG8_STAGE(PG8_SB(1, 1), b3 + hstep, voffB);
            PG8_WAIT_V(6); PG8_BAR; PG8_MMA(1, 1, At, B1); PG8_BAR;
            }
        }
        if constexpr (ALIGN_EPI) { if (wr == 0) PG8_BAR; }
        if constexpr (!Epi::AFTER_DRAIN) { E(acc, cur, wr, wc, fr, fq); S.done(cur); }
        if (!has_next) break;
#pragma unroll
        for (int a = 0; a < 2; ++a)
#pragma unroll
            for (int b = 0; b < 2; ++b)
#pragma unroll
                for (int m = 0; m < 4; ++m)
#pragma unroll
                    for (int n = 0; n < 2; ++n) acc[a][b][m][n] = (f32x4){0.f, 0.f, 0.f, 0.f};
        cur = nxt; cA = nA; cB = nB; ++ui;
        if constexpr (ALIGN_EPI) { if (wr == 1) PG8_BAR; }
    }
    PG8_WAIT_V(0);
    if constexpr (!ALIGN_EPI) { if (wr == 0) PG8_BAR; }
    PG8_BAR;
    if constexpr (Epi::AFTER_DRAIN) { E.fused(acc, cur, wr, wc, fr, fq, lds, wid, lane); S.done(cur); }
#undef PG8_SA
#undef PG8_SB
#undef PG8_STAGE
#undef PG8_LDA
#undef PG8_LDB
#undef PG8_MMA
#undef PG8_WAIT_V
#undef PG8_WAIT_L
#undef PG8_BAR
#undef PG8_SCHED
}

}

namespace attn_body {
using bf16=__hip_bfloat16;
using bf16x8=__attribute__((ext_vector_type(8)))short;
using s16x4=__attribute__((ext_vector_type(4)))short;
using f32x16=__attribute__((ext_vector_type(16)))float;
using u32x4=__attribute__((ext_vector_type(4)))unsigned;
constexpr int BATCH=4,NHEAD=8,SEQ=8192,D=64,DM=NHEAD*D,OPITCH=1024;
constexpr int NW=8,QBLK=32,QB=QBLK*NW,KVBLK=64,NQB=SEQ/QB;
constexpr int ATTN_PITCH=DM, ATTN_UNIT_ROWS=QB;
__device__ __forceinline__ int crow(int r,int hi){return (r&3)+8*(r>>2)+4*hi;}
#define SBAR() __builtin_amdgcn_sched_barrier(0)
__device__ __forceinline__ void bmask(f32x16&p0,f32x16&p1,unsigned mw){
  const float NEG=-INFINITY;
  #pragma unroll
  for(int r=0;r<16;++r){ if(!((mw>>r)&1u))p0[r]=NEG; if(!((mw>>(16+r))&1u))p1[r]=NEG; }
}
__device__ __forceinline__ void addbias(f32x16&p0,f32x16&p1,const float*btab,int dbase){
  #pragma unroll
  for(int r=0;r<16;++r){ int d0=dbase-((r&3)+8*(r>>2)); int d1=d0-32; d0=d0<0?0:(d0>127?127:d0); d1=d1<0?0:(d1>127?127:d1); p0[r]+=btab[d0]; p1[r]+=btab[d1]; }
}

constexpr int NSLOT=3, SLOTB=8192;
constexpr int LDS_K=0, LDS_V=NSLOT*SLOTB, LDS_WS=2*NSLOT*SLOTB, LDS_OST=LDS_WS+NW*64*4, LDS_BIAS=LDS_OST+NW*4096, LDS_BYTES=LDS_BIAS+512;
constexpr float C2=0.125f*1.4426950408889634f;
__device__ __forceinline__ void glds16(const void*gsrc,unsigned lds_dst){unsigned keep;
  asm volatile("s_mov_b32 %0, m0\n\ts_mov_b32 m0, %2\n\ts_nop 0\n\tglobal_load_lds_dwordx4 %1, off\n\ts_mov_b32 m0, %0":"=&s"(keep):"v"(gsrc),"s"(lds_dst):"memory");}
__device__ __forceinline__ float max3f(float a,float b,float c){float r;asm("v_max3_f32 %0, %1, %2, %3":"=v"(r):"v"(a),"v"(b),"v"(c));return r;}
__device__ __forceinline__ float max2f(float a,float b){float r;asm("v_max_f32_e32 %0, %1, %2":"=v"(r):"v"(a),"v"(b));return r;}
__device__ __forceinline__ float fadd_s(float a,float b){float r;asm("v_add_f32_e32 %0, %1, %2":"=v"(r):"v"(a),"v"(b));return r;}
__device__ __forceinline__ float fsub_s(float a,float b){float r;asm("v_sub_f32_e32 %0, %1, %2":"=v"(r):"v"(a),"v"(b));return r;}
typedef float f32x2_t __attribute__((ext_vector_type(2))); typedef __bf16 bf16x2_t __attribute__((ext_vector_type(2)));
__device__ __forceinline__ unsigned cvtpk_s(float lo,float hi){f32x2_t v={lo,hi};bf16x2_t b=__builtin_convertvector(v,bf16x2_t);return __builtin_bit_cast(unsigned,b);}
#define WAIT_BAR(N) asm volatile("s_waitcnt vmcnt(" #N ") lgkmcnt(0)\n\ts_barrier":"+v"(mwc),"+v"(mwn)::"memory")
#define MLOADN(tt) asm volatile("global_load_dword %0, %1, off":"=v"(mwn):"v"(bmw+(size_t)(tt)*64):"memory")

__device__ __forceinline__ void qkt(f32x16&p0,f32x16&p1,const char*Kslot,const bf16x8*qr,const f32x16&negm,int r32,int hi){
  const char*kb=Kslot+hi*1024+r32*16;
  #pragma unroll
  for(int d0=0;d0<4;++d0){
    const bf16x8 b0=*reinterpret_cast<const bf16x8*>(kb+d0*2048);
    const bf16x8 b1=*reinterpret_cast<const bf16x8*>(kb+d0*2048+512);
    if(d0==0){p0=__builtin_amdgcn_mfma_f32_32x32x16_bf16(b0,qr[0],negm,0,0,0);p1=__builtin_amdgcn_mfma_f32_32x32x16_bf16(b1,qr[0],negm,0,0,0);}
    else{p0=__builtin_amdgcn_mfma_f32_32x32x16_bf16(b0,qr[d0],p0,0,0,0);p1=__builtin_amdgcn_mfma_f32_32x32x16_bf16(b1,qr[d0],p1,0,0,0);}}
}
typedef __attribute__((address_space(3))) const char* lds_cptr;
typedef short v4i16_t __attribute__((ext_vector_type(4)));
__device__ __forceinline__ void kload8(bf16x8*kf,lds_cptr kp){
  kf[0]=*(const __attribute__((address_space(3))) bf16x8*)(kp);      kf[1]=*(const __attribute__((address_space(3))) bf16x8*)(kp+512);
  kf[2]=*(const __attribute__((address_space(3))) bf16x8*)(kp+2048); kf[3]=*(const __attribute__((address_space(3))) bf16x8*)(kp+2560);
  kf[4]=*(const __attribute__((address_space(3))) bf16x8*)(kp+4096); kf[5]=*(const __attribute__((address_space(3))) bf16x8*)(kp+4608);
  kf[6]=*(const __attribute__((address_space(3))) bf16x8*)(kp+6144); kf[7]=*(const __attribute__((address_space(3))) bf16x8*)(kp+6656);
}
__device__ __forceinline__ void kload2(bf16x8*kf,lds_cptr kp,int j){ kf[2*j]=*(const __attribute__((address_space(3))) bf16x8*)(kp+j*2048); kf[2*j+1]=*(const __attribute__((address_space(3))) bf16x8*)(kp+j*2048+512); }
__device__ __forceinline__ s16x4 vtr(lds_cptr p){ return __builtin_bit_cast(s16x4,__builtin_amdgcn_ds_read_tr16_b64_v4i16((__attribute__((address_space(3))) v4i16_t*)p)); }
__device__ __forceinline__ float rowmax(const f32x16&p0,const f32x16&p1){
  float a=max3f(p0[0],p0[1],p1[0]),b=max3f(p0[2],p0[3],p1[1]);a=max3f(a,p1[2],p1[3]);
  #pragma unroll
  for(int r=4;r<16;r+=4){a=max3f(a,p0[r],p0[r+1]);b=max3f(b,p0[r+2],p0[r+3]);a=max3f(a,p1[r],p1[r+1]);b=max3f(b,p1[r+2],p1[r+3]);}
  const float m=max2f(a,b);
  auto rr=__builtin_amdgcn_permlane32_swap(__float_as_uint(m),__float_as_uint(m),false,false);
  return max2f(__uint_as_float(rr[0]),__uint_as_float(rr[1]));
}
__device__ __forceinline__ void pv(f32x16*o,int vb,bf16x8 pa0,bf16x8 pa1,bf16x8 pa2,bf16x8 pa3){
  #pragma unroll
  for(int d0=0;d0<2;++d0){s16x4 lo[4],hi[4];
    #pragma unroll
    for(int ks=0;ks<4;++ks){
      asm volatile("ds_read_b64_tr_b16 %0,%1 offset:%c2":"=&v"(lo[ks]):"v"(vb),"i"(d0*4096+ks*1024):"memory");
      asm volatile("ds_read_b64_tr_b16 %0,%1 offset:%c2":"=&v"(hi[ks]):"v"(vb),"i"(d0*4096+ks*1024+512):"memory");}
    asm volatile("s_waitcnt lgkmcnt(0)":::"memory");SBAR();
    #define PK(k) (bf16x8){lo[k][0],lo[k][1],lo[k][2],lo[k][3],hi[k][0],hi[k][1],hi[k][2],hi[k][3]}
    o[d0]=__builtin_amdgcn_mfma_f32_32x32x16_bf16(pa0,PK(0),o[d0],0,0,0);
    o[d0]=__builtin_amdgcn_mfma_f32_32x32x16_bf16(pa1,PK(1),o[d0],0,0,0);
    o[d0]=__builtin_amdgcn_mfma_f32_32x32x16_bf16(pa2,PK(2),o[d0],0,0,0);
    o[d0]=__builtin_amdgcn_mfma_f32_32x32x16_bf16(pa3,PK(3),o[d0],0,0,0);
    #undef PK
  }
}

#ifndef ATTN_STORE16
#define ATTN_STORE16(p,v) (*(u32x4*)(p)=(v))
#endif
template<int THRL> __device__ __forceinline__ void attn_unit(int b,int h,int qb,const bf16*Q,const bf16*__restrict__ K,const bf16*__restrict__ V,unsigned short*O,const unsigned*__restrict__ BMK,const float*__restrict__ BIASG,char*shm){
  const int tid=threadIdx.x,lane=tid&63,r32=lane&31,hi=lane>>5; const int wid=__builtin_amdgcn_readfirstlane(tid>>6);
  const long rowbase=(long)b*SEQ; const int q0=qb*QB;
  const bf16*Qw=Q+(rowbase+q0+wid*QBLK)*DM+h*D;
  const bf16*Kh=K+rowbase*DM+h*D,*Vh=V+rowbase*DM+h*D;
  const unsigned lds0=(unsigned)(uintptr_t)shm;
  float*wsf=(float*)(shm+LDS_WS)+wid*64;
  float*btab=(float*)(shm+LDS_BIAS);
  if(tid<128)btab[tid]=BIASG[h*128+tid];
  const unsigned*bmw=BMK+((size_t)(b*256+qb*8+wid)*128)*64+lane;
  unsigned mwc,mwn;
  asm volatile("global_load_dword %0, %1, off":"=v"(mwc):"v"(bmw):"memory"); MLOADN(1);
  const bf16*ksrc=Kh+(long)lane*DM+wid*8;
  const bf16*vsrc=Vh+(long)(16*(wid&3)+(lane>>2))*DM+(wid>>2)*32+(lane&3)*8;
  const unsigned kdst=lds0+LDS_K+wid*1024, vdst=lds0+LDS_V+wid*1024;
  #define DMA_K(t,slot) glds16(ksrc+(long)(t)*KVBLK*DM,(unsigned)__builtin_amdgcn_readfirstlane(kdst+(slot)))
  #define DMA_V(t,slot) glds16(vsrc+(long)(t)*KVBLK*DM,(unsigned)__builtin_amdgcn_readfirstlane(vdst+(slot)))
  const int vb0=(int)(lds0+LDS_V)+((lane>>4)&1)*32+(lane&3)*8+(4*hi+((lane&15)>>2))*64;
  const char*Kbase=shm+LDS_K; bf16x8 kf[8];
  const lds_cptr shm3=(lds_cptr)shm; const lds_cptr kp0=shm3+LDS_K+hi*1024+r32*16; const lds_cptr vp0=shm3+LDS_V+((lane>>4)&1)*32+(lane&3)*8+(4*hi+((lane&15)>>2))*64;
  const int NT=(q0+QB)/KVBLK;
  DMA_K(0,0);DMA_V(0,0);DMA_K(1,SLOTB);
  bf16x8 qr[4];
  #pragma unroll
  for(int d0=0;d0<4;++d0)qr[d0]=*reinterpret_cast<const bf16x8*>(&Qw[(long)r32*DM+d0*16+hi*8]);
  float mhat=0.f,l_reg=0.f;f32x16 o[2];o[0]=f32x16{};o[1]=f32x16{};f32x16 negm=f32x16{};asm volatile("":"+v"(negm));
  const int qrel=wid*QBLK+r32;
  #define CMASK(P0,P1,t) do{ bmask(P0,P1,mwc); if((t)>=NT-7)addbias(P0,P1,btab,q0+qrel-64*(t)-4*hi); }while(0)
  bool resc=false;
  #define START(P0,P1) do{ const float rm=rowmax(P0,P1); resc=false; \
    { const float dl=(rm==-INFINITY)?0.f:rm; mhat=fadd_s(mhat,dl); \
      _Pragma("unroll") for(int r=0;r<16;++r){P0[r]=fsub_s(P0[r],dl);P1[r]=fsub_s(P1[r],dl);} \
      _Pragma("unroll") for(int r=0;r<16;++r)negm[r]=-mhat; asm volatile("":"+v"(negm)); } \
    _Pragma("unroll") for(int r=0;r<16;++r)P0[r]=__builtin_amdgcn_exp2f(P0[r]); }while(0)
  #define RESC() do{ if(resc){ asm volatile("s_waitcnt lgkmcnt(0)":::"memory"); \
      _Pragma("unroll") for(int d_=0;d_<2;++d_) _Pragma("unroll") for(int r=0;r<16;++r)o[d_][r]*=wsf[crow(r,hi)]; } }while(0)
  f32x16 pA0,pA1,pB0,pB1;
  int sl_prev=0,sl_cur=0,sl_next=SLOTB;
  #define ROT() do{sl_prev=sl_cur;sl_cur=sl_next;sl_next=(sl_next==(NSLOT-1)*SLOTB)?0:sl_next+SLOTB;}while(0)
  DMA_K(2,2*SLOTB);
  WAIT_BAR(3);
  qkt(pA0,pA1,Kbase,qr,negm,r32,hi);asm volatile("s_nop 15\n\ts_nop 7":"+v"(pA0),"+v"(pA1));CMASK(pA0,pA1,0);
  START(pA0,pA1);
  _Pragma("unroll") for(int r=0;r<16;++r)pA1[r]=__builtin_amdgcn_exp2f(pA1[r]);
  WAIT_BAR(0);
  DMA_K(3,0);DMA_V(1,SLOTB);
  ROT();
  kload8(kf,kp0+sl_cur);
  WAIT_BAR(2);
  s16x4 vlo[8],vhi[8]; u32x4 pw0,pw1,pw2,pw3;
  #define PKW(P,B) cvtpk_s(P[B],P[B+1])
  #define PAF(k) __builtin_bit_cast(bf16x8,pw##k)
  #define VFR(i) (bf16x8){vlo[i][0],vlo[i][1],vlo[i][2],vlo[i][3],vhi[i][0],vhi[i][1],vhi[i][2],vhi[i][3]}
  #define PIN(x) asm volatile("":"+v"(x))
  #define MX3(a,b,c) __builtin_fmaxf(__builtin_fmaxf((a),(b)),(c))
  #define GAPA(MF,A0,A1,A2,A3,W0,W1,PW) do{ MF; sacc+=A0; sacc+=A1; sacc+=A2; sacc+=A3; PIN(sacc); W0; W1; PIN(PW); SBAR(); }while(0)
  #define EX(v) __builtin_amdgcn_exp2f(v)
  #define GAPB(MF,X,B) do{ MF; X[B]=EX(X[B]); X[B+1]=EX(X[B+1]); X[B+2]=EX(X[B+2]); X[B+3]=EX(X[B+3]); PIN(X); SBAR(); }while(0)
  #define VRD(i) do{ vlo[i]=vtr(vp_+(((i)>>2)*4096+((i)&3)*1024)); vhi[i]=vtr(vp_+(((i)>>2)*4096+((i)&3)*1024+512)); }while(0)
  #define KRD(G,j) do{ if(G){ kload2(kf,kp0+sl_next,j); SBAR(); } }while(0)
  #define STEP(C0,C1,P0,P1,t,GK,GV,GL) do{ SBAR(); mwc=mwn; \
    const lds_cptr vp_=vp0+sl_prev; \
    VRD(0); SBAR(); float sacc=(P0[0]+P0[1]); \
    GAPA(C0=__builtin_amdgcn_mfma_f32_32x32x16_bf16(kf[0],qr[0],negm,0,0,0), P0[2],P0[3],P0[4],P0[5],     pw0[0]=PKW(P0,0), pw0[1]=PKW(P0,2), pw0); \
    VRD(4); SBAR(); GAPA(C1=__builtin_amdgcn_mfma_f32_32x32x16_bf16(kf[1],qr[0],negm,0,0,0), P0[6],P0[7],P0[8],P0[9],     pw0[2]=PKW(P0,4), pw0[3]=PKW(P0,6), pw0); \
    VRD(1); SBAR(); GAPA(C0=__builtin_amdgcn_mfma_f32_32x32x16_bf16(kf[2],qr[1],C0,0,0,0),   P0[10],P0[11],P0[12],P0[13], pw1[0]=PKW(P0,8), pw1[1]=PKW(P0,10), pw1); \
    VRD(5); SBAR(); GAPA(C1=__builtin_amdgcn_mfma_f32_32x32x16_bf16(kf[3],qr[1],C1,0,0,0),   P0[14],P0[15],P1[0],P1[1],   pw1[2]=PKW(P0,12),pw1[3]=PKW(P0,14), pw1); \
    VRD(2); SBAR(); GAPA(C0=__builtin_amdgcn_mfma_f32_32x32x16_bf16(kf[4],qr[2],C0,0,0,0),   P1[2],P1[3],P1[4],P1[5],     pw2[0]=PKW(P1,0), pw2[1]=PKW(P1,2), pw2); \
    VRD(6); SBAR(); GAPA(C1=__builtin_amdgcn_mfma_f32_32x32x16_bf16(kf[5],qr[2],C1,0,0,0),   P1[6],P1[7],P1[8],P1[9],     pw2[2]=PKW(P1,4), pw2[3]=PKW(P1,6), pw2); \
    VRD(3); SBAR(); GAPA(C0=__builtin_amdgcn_mfma_f32_32x32x16_bf16(kf[6],qr[3],C0,0,0,0),   P1[10],P1[11],P1[12],P1[13], pw3[0]=PKW(P1,8), pw3[1]=PKW(P1,10), pw3); \
    VRD(7); SBAR(); GAPA(C1=__builtin_amdgcn_mfma_f32_32x32x16_bf16(kf[7],qr[3],C1,0,0,0),   P1[14],P1[15],0.f,0.f,       pw3[2]=PKW(P1,12),pw3[3]=PKW(P1,14), pw3); \
    l_reg+=sacc; \
    if((t)+1<NT){MLOADN((t)+1);} if(GK){DMA_K((t)+3,sl_cur);} if(GV){DMA_V((t)+1,sl_next);} \
    CMASK(C0,C1,t); \
    { float a=MX3(C0[0],C0[1],C1[0]),b=MX3(C0[2],C0[3],C1[1]); a=MX3(a,C1[2],C1[3]); \
      _Pragma("unroll") for(int r=4;r<16;r+=4){a=MX3(a,C0[r],C0[r+1]);b=MX3(b,C0[r+2],C0[r+3]);a=MX3(a,C1[r],C1[r+1]);b=MX3(b,C1[r+2],C1[r+3]);} \
      float rm=__builtin_fmaxf(a,b); { auto rr=__builtin_amdgcn_permlane32_swap(__float_as_uint(rm),__float_as_uint(rm),false,false); rm=__builtin_fmaxf(__uint_as_float(rr[0]),__uint_as_float(rr[1])); } \
      resc=false; \
      if(__builtin_expect(__any(rm>(float)THRL),0)){ const float dl=__builtin_fmaxf(rm,0.f); mhat+=dl; \
        _Pragma("unroll") for(int r=0;r<16;++r){C0[r]-=dl;C1[r]-=dl;} \
        _Pragma("unroll") for(int r=0;r<16;++r)negm[r]=-mhat; asm volatile("":"+v"(negm)); \
        const float f=__builtin_amdgcn_exp2f(-dl); l_reg*=f; if(hi==0)wsf[r32]=f; resc=true; } } \
    SBAR(); \
    GAPB(o[0]=__builtin_amdgcn_mfma_f32_32x32x16_bf16(PAF(0),VFR(0),o[0],0,0,0), C0,0); \
    GAPB(o[1]=__builtin_amdgcn_mfma_f32_32x32x16_bf16(PAF(0),VFR(4),o[1],0,0,0), C0,4); \
    KRD(GL,0); GAPB(o[0]=__builtin_amdgcn_mfma_f32_32x32x16_bf16(PAF(1),VFR(1),o[0],0,0,0), C0,8); \
    KRD(GL,1); GAPB(o[1]=__builtin_amdgcn_mfma_f32_32x32x16_bf16(PAF(1),VFR(5),o[1],0,0,0), C0,12); \
    KRD(GL,2); GAPB(o[0]=__builtin_amdgcn_mfma_f32_32x32x16_bf16(PAF(2),VFR(2),o[0],0,0,0), C1,0); \
    KRD(GL,3); GAPB(o[1]=__builtin_amdgcn_mfma_f32_32x32x16_bf16(PAF(2),VFR(6),o[1],0,0,0), C1,4); \
    GAPB(o[0]=__builtin_amdgcn_mfma_f32_32x32x16_bf16(PAF(3),VFR(3),o[0],0,0,0), C1,8); \
    GAPB(o[1]=__builtin_amdgcn_mfma_f32_32x32x16_bf16(PAF(3),VFR(7),o[1],0,0,0), C1,12); \
    }while(0)
  int t=1;
  #undef CMASK
  #define CMASK(P0,P1,t) do{ bmask(P0,P1,mwc); }while(0)
  for(;t+7<NT;t+=2){
    STEP(pB0,pB1,pA0,pA1,t,true,true,true);     WAIT_BAR(2); RESC(); ROT();
    STEP(pA0,pA1,pB0,pB1,t+1,true,true,true);   WAIT_BAR(2); RESC(); ROT();
  }
  #undef CMASK
  #define CMASK(P0,P1,t) do{ bmask(P0,P1,mwc); addbias(P0,P1,btab,q0+qrel-64*(t)-4*hi); }while(0)
  #define ENDW(tt) do{ if((tt)+3<NT){WAIT_BAR(2);} else if((tt)+2<NT){WAIT_BAR(1);} else {WAIT_BAR(0);} }while(0)
  for(;t+1<NT;t+=2){
    STEP(pB0,pB1,pA0,pA1,t,(t+3<NT),(t+1<NT),(t+1<NT));       ENDW(t);   RESC(); ROT();
    STEP(pA0,pA1,pB0,pB1,t+1,(t+4<NT),(t+2<NT),(t+2<NT));     ENDW(t+1); RESC(); ROT();
  }
  STEP(pB0,pB1,pA0,pA1,NT-1,false,false,false); RESC();
  { float sacc=pB0[0]+pB0[1]; _Pragma("unroll") for(int r=2;r<16;++r)sacc+=pB0[r]; _Pragma("unroll") for(int r=0;r<16;++r)sacc+=pB1[r]; l_reg+=sacc;
    pw0=(u32x4){PKW(pB0,0),PKW(pB0,2),PKW(pB0,4),PKW(pB0,6)};pw1=(u32x4){PKW(pB0,8),PKW(pB0,10),PKW(pB0,12),PKW(pB0,14)};pw2=(u32x4){PKW(pB1,0),PKW(pB1,2),PKW(pB1,4),PKW(pB1,6)};pw3=(u32x4){PKW(pB1,8),PKW(pB1,10),PKW(pB1,12),PKW(pB1,14)};
    SBAR(); pv(o,vb0+sl_cur,PAF(0),PAF(1),PAF(2),PAF(3)); }
  #undef PKW
  #undef PAF
  #undef VFR
  #undef PIN
  #undef MX3
  #undef GAPA
  #undef GAPB
  #undef EX
  #undef VRD
  #undef KRD
  #undef STEP
  #undef ENDW
  {auto rr=__builtin_amdgcn_permlane32_swap(__float_as_uint(l_reg),__float_as_uint(l_reg),false,false);l_reg=__uint_as_float(rr[0])+__uint_as_float(rr[1]);}
  if(hi==0)wsf[32+r32]=l_reg;asm volatile("s_waitcnt lgkmcnt(0)":::"memory");
  float rli[16];
  #pragma unroll
  for(int r=0;r<16;++r)rli[r]=__builtin_amdgcn_rcpf(wsf[32+crow(r,hi)]);
  unsigned short*Ow=O+(rowbase+q0+wid*QBLK)*OPITCH+h*D;
  { _Float16*stg=(_Float16*)(shm+LDS_OST)+wid*2048;
    #pragma unroll
    for(int r=0;r<16;++r){const int orow=crow(r,hi);
      #pragma unroll
      for(int d0=0;d0<2;++d0)stg[orow*64+d0*32+r32]=(_Float16)(o[d0][r]*rli[r]);}
    asm volatile("s_waitcnt lgkmcnt(0)":::"memory");
    #pragma unroll
    for(int i=0;i<4;++i){const int row=i*8+(lane>>3),ch=lane&7; const u32x4 v=*(const u32x4*)(stg+row*64+ch*8); ATTN_STORE16(Ow+(long)row*OPITCH+ch*8,v);} }
  asm volatile("s_waitcnt lgkmcnt(0)\n\ts_barrier":::"memory");
  #undef DMA_K
  #undef DMA_V
  #undef CMASK
  #undef START
  #undef RESC
  #undef ROT
}
constexpr int ATTN_LDS_BYTES=LDS_BYTES;
struct AttnTensors { const bf16* Q; const bf16* K; const bf16* V; unsigned short* O; const unsigned* BMK; const float* BIASG; };
struct AttnUnit { int bh; int qb; };
struct StaticOrder {
  int vcu;
  __device__ __forceinline__ explicit StaticOrder(int grid,int block):vcu((block%8)*(grid/8)+block/8){}
  __device__ __forceinline__ bool next(int i,AttnUnit&u)const{ if(i>=4)return false; const int s=vcu&7; u.bh=vcu>>3; u.qb=(i==0)?s:(i==1)?15-s:(i==2)?16+s:31-s; return true; }
  __device__ __forceinline__ void a_ready(const AttnUnit&)const{}
  __device__ __forceinline__ void done(const AttnUnit&)const{}
};
struct StridedOrder {
  int G,c;
  __device__ __forceinline__ explicit StridedOrder(int grid,int block):G(grid),c(block){}
  __device__ __forceinline__ bool next(int i,AttnUnit&u)const{ const int L=i*G+c; if(L>=BATCH*NHEAD*NQB)return false; u.bh=L/NQB; u.qb=L%NQB; return true; }
  __device__ __forceinline__ void a_ready(const AttnUnit&)const{}
  __device__ __forceinline__ void done(const AttnUnit&)const{}
};
template<class Sched,int THRL=8> __device__ __forceinline__ void attn_phase(char*lds,const AttnTensors&T,const Sched&S){
  AttnUnit u;
  for(int i=0;S.next(i,u);++i){ S.a_ready(u); attn_unit<THRL>(u.bh/NHEAD,u.bh%NHEAD,u.qb,T.Q,T.K,T.V,T.O,T.BMK,T.BIASG,lds); S.done(u); }
}
#undef SBAR
#undef WAIT_BAR
}

constexpr int NWAVES = 8;
#ifndef MK_N_LAUNCHES
#define MK_N_LAUNCHES 1
#endif
constexpr int N_PHASES = 9;
constexpr int N_LAUNCHES = MK_N_LAUNCHES;

constexpr size_t MiB = 1u << 20;
constexpr size_t WS_CTL = 0, CTL_ZERO_BYTES = 1 * MiB;
constexpr size_t WS_WIN = 2 * MiB, WS_WOUT = 11 * MiB, WS_WGU = 13 * MiB, WS_WD = 24 * MiB;
constexpr size_t WS_CS = 30 * MiB;
constexpr size_t WS_RINV1 = 34 * MiB, WS_PART2 = 35 * MiB, WS_PART3 = 37 * MiB, WS_WI = 39 * MiB;
constexpr size_t WS_BIAS = 34 * MiB + 512 * 1024;
constexpr size_t WS_KIRAW = 40 * MiB, WS_KIH = 48 * MiB;
constexpr size_t WS_XH = 52 * MiB, WS_MIX = 52 * MiB;
constexpr size_t WS_QA = 116 * MiB;
constexpr size_t WS_KA = WS_QA + 32 * MiB, WS_VA = WS_QA + 64 * MiB, WS_QI = WS_QA + 96 * MiB, WS_QB = WS_QA + 128 * MiB, WS_KB = WS_QA + 160 * MiB, WS_VB = WS_QA + 192 * MiB, WS_GB = WS_QA + 224 * MiB;
constexpr size_t WS_DS = 372 * MiB;
constexpr size_t WS_ST = 436 * MiB;
constexpr size_t WS_BM = 468 * MiB;
constexpr size_t WS_X2H = 116 * MiB;
constexpr size_t WS_U = 180 * MiB;
constexpr size_t WS_END = 512 * MiB;
static_assert(WS_BM + 32 * MiB <= WS_END && WS_U + (size_t)MTOK * DFF * 2 <= WS_DS + 64 * MiB, "d_ws map");
constexpr int CW_BAR = 4096;

constexpr int LCTL_BYTES = 4096;
constexpr int RING_OFF = LCTL_BYTES, RING_BYTES = 139264;
constexpr int LDS_BYTES = RING_OFF + RING_BYTES;
static_assert(LDS_BYTES <= 160 * 1024 - 1024, "LDS");

#define XB_TMO      128
#define XB_XCNT(j)  (256  + 64 * (j))
#define XB_XSUB(j)  (1280 + 64 * (j))
#define XB_XGEN(j)  (2304 + 64 * (j))
#define XB_TOP      3328
#define XB_TOPGEN   3392
#define XCD_BAR_WORDS 3456
#define XB_SPIN_CAP (1u << 18)

__device__ __forceinline__ unsigned xb_ld(unsigned* p)              { return __hip_atomic_load(p, __ATOMIC_RELAXED, __HIP_MEMORY_SCOPE_AGENT); }
__device__ __forceinline__ unsigned xb_add(unsigned* p, unsigned v) { return __hip_atomic_fetch_add(p, v, __ATOMIC_RELAXED, __HIP_MEMORY_SCOPE_AGENT); }
__device__ __forceinline__ unsigned xb_xcc_id() { return (unsigned)__builtin_amdgcn_s_getreg((3 << 11) | 20) & 0xFu; }
#define XB_SPIN(cond, bar) do { unsigned _sp = 0; while (cond) { __builtin_amdgcn_s_sleep(1); \
    if ((++_sp & 255u) == 0u) { if (xb_ld(&(bar)[XB_TMO])) break; if (_sp > XB_SPIN_CAP) { atomicAdd(&(bar)[XB_TMO], 1u); break; } } } } while (0)

struct XcdBarrier {
    unsigned* bar; unsigned x;
    volatile LAS unsigned* st;
};

__device__ __forceinline__ XcdBarrier xcd_barrier_post(unsigned* bar, volatile LAS unsigned* st) {
    XcdBarrier b; b.bar = bar; b.x = xb_xcc_id(); b.st = st;
    if (threadIdx.x == 0) (void)xb_add(&bar[XB_XCNT(b.x)], 1u);
    return b;
}
__device__ __forceinline__ void xcd_barrier_complete(unsigned* bar, unsigned x, unsigned& nloc, unsigned& nx) {
    const unsigned G = gridDim.x * gridDim.y * gridDim.z;
    unsigned sum, cnt, mine, sp = 0u;
    for (;;) {
        sum = 0u; cnt = 0u; mine = 0u;
#pragma unroll
        for (unsigned j = 0; j < 16; ++j) { const unsigned c = xb_ld(&bar[XB_XCNT(j)]); sum += c; cnt += (c > 0u) ? 1u : 0u; mine = (j == x) ? c : mine; }
        if (sum == G) break;
        __builtin_amdgcn_s_sleep(1);
        if ((++sp & 255u) == 0u) { if (xb_ld(&bar[XB_TMO])) break; if (sp > XB_SPIN_CAP) { atomicAdd(&bar[XB_TMO], 1u); break; } }
    }
    nloc = mine > 0u ? mine : 1u; nx = cnt > 0u ? cnt : 1u;
}

__device__ __forceinline__ void xcd_barrier(const XcdBarrier& b) {
    asm volatile("s_waitcnt vmcnt(0)" ::: "memory");
    __syncthreads();
    if (threadIdx.x == 0) {
        unsigned* bar = b.bar;
        __builtin_amdgcn_s_waitcnt(0);
        unsigned nloc = b.st[0], nx = b.st[1];
        if (nloc == 0u) { xcd_barrier_complete(bar, b.x, nloc, nx); b.st[0] = nloc; b.st[1] = nx; }
        const unsigned old = xb_add(&bar[XB_XSUB(b.x)], 1u);
        const unsigned gen = old / nloc;
        if (old + 1u == (gen + 1u) * nloc) {
            __builtin_amdgcn_fence(__ATOMIC_RELEASE, "agent");
            asm volatile("s_waitcnt vmcnt(0)" ::: "memory");
            const unsigned og = xb_add(&bar[XB_TOP], 1u);
            const unsigned tg = og / nx;
            if (og + 1u == (tg + 1u) * nx) xb_add(&bar[XB_TOPGEN], 1u);
            else XB_SPIN(xb_ld(&bar[XB_TOPGEN]) == tg, bar);
            __builtin_amdgcn_fence(__ATOMIC_ACQUIRE, "agent");
            xb_add(&bar[XB_XGEN(b.x)], 1u);
            asm volatile("s_waitcnt vmcnt(0)" ::: "memory");
        } else {
            XB_SPIN(xb_ld(&bar[XB_XGEN(b.x)]) == gen, bar);
            __builtin_amdgcn_fence(__ATOMIC_ACQUIRE, "agent");
            asm volatile("s_waitcnt vmcnt(0)" ::: "memory");
        }
    }
    __syncthreads();
}

struct Frame {
    LAS unsigned char* lds;
    unsigned char* ws;
    int tid, lane, wave;
    int vcu, G;
};
__device__ __forceinline__ float wave_sum(float v) {
#pragma unroll
    for (int o = 1; o < 64; o <<= 1) v += __shfl_xor(v, o);
    return v;
}

__device__ __forceinline__ void p0_tr_item(const float* W, int ldw, int scol0, int nvalid, const float* gain, u16* WT, int K, int drow0, int k0, LAS float* scr, int lane) {
#pragma unroll 8
    for (int i = 0; i < 32; ++i) { const int kk = 2 * i + (lane >> 5), n = lane & 31;
        float v = 0.f; if (n < nvalid) v = W[(size_t)(k0 + kk) * ldw + scol0 + n];
        if (gain) v *= gain[k0 + kk];
        scr[kk * 33 + n] = v; }
    LDS_WAIT(); asm volatile("" ::: "memory");
    const int c = lane & 7;
#pragma unroll
    for (int j = 0; j < 4; ++j) { const int n = (lane >> 3) + 8 * j; const LAS float* s = scr + (8 * c) * 33 + n;
        v4u o; o.x = cvt_pk_f16(s[0 * 33], s[1 * 33]); o.y = cvt_pk_f16(s[2 * 33], s[3 * 33]); o.z = cvt_pk_f16(s[4 * 33], s[5 * 33]); o.w = cvt_pk_f16(s[6 * 33], s[7 * 33]);
        *(v4u*)(WT + (size_t)(drow0 + n) * K + k0 + 8 * c) = o; }
    LDS_WAIT(); asm volatile("" ::: "memory");
}
__constant__ unsigned char T5_BUCKET[128] = {0, 1, 2, 3, 4, 5, 6, 7, 8, 9, 10, 11, 12, 13, 14, 15, 16, 16, 16, 17, 17, 18, 18, 18, 19, 19, 19, 20, 20, 20, 20, 21, 21, 21, 21, 22, 22, 22, 22, 22, 23, 23, 23, 23, 23, 23, 24, 24, 24, 24, 24, 24, 25, 25, 25, 25, 25, 25, 25, 26, 26, 26, 26, 26, 26, 26, 26, 27, 27, 27, 27, 27, 27, 27, 27, 27, 27, 28, 28, 28, 28, 28, 28, 28, 28, 28, 28, 29, 29, 29, 29, 29, 29, 29, 29, 29, 29, 29, 29, 30, 30, 30, 30, 30, 30, 30, 30, 30, 30, 30, 30, 30, 30, 31, 31, 31, 31, 31, 31, 31, 31, 31, 31, 31, 31, 31, 31, 31};
struct P0Args { const float *x, *g_mix, *w_in, *rel_bias, *w_out, *g_ffn, *w_gate, *w_up, *w_down; };
__device__ __forceinline__ void p0_prologue(Frame& F, const P0Args& A) {
    LAS float* scr = (LAS float*)(F.lds + RING_OFF + F.wave * 16384);
    const int gw = F.vcu * NWAVES + F.wave, NGW = F.G * NWAVES;
    u16* WinT = (u16*)(F.ws + WS_WIN); u16* WoutT = (u16*)(F.ws + WS_WOUT); u16* WguT = (u16*)(F.ws + WS_WGU); u16* WdT = (u16*)(F.ws + WS_WD);
    constexpr int I_IN = 16 * (N_IN / 32), I_OUT = 16 * 32, I_GU = 16 * 176, I_D = 44 * 32, NITEMS = I_IN + I_OUT + I_GU + I_D;
    for (int it = gw; it < NITEMS; it += NGW) {
        int r = it;
        if (r < I_IN) { const int kb = r / (N_IN / 32), nb = r % (N_IN / 32), drow0 = 32 * nb; int scol0, nvalid = 32;
            if (drow0 < 2048) scol0 = drow0; else if (drow0 < 4096) scol0 = 2120 + (drow0 - 2048); else { const int off = drow0 - 4096; scol0 = 2048 + off; nvalid = 72 - off; nvalid = nvalid < 0 ? 0 : (nvalid > 32 ? 32 : nvalid); }
            p0_tr_item(A.w_in, 4168, scol0, nvalid, A.g_mix, WinT, 1024, drow0, 64 * kb, scr, F.lane); continue; }
        r -= I_IN;
        if (r < I_OUT) { const int kb = r / 32, nb = r % 32; p0_tr_item(A.w_out, 1024, 32 * nb, 32, nullptr, WoutT, 1024, 32 * nb, 64 * kb, scr, F.lane); continue; }
        r -= I_OUT;
        if (r < I_GU) { const int kb = r / 176, nb = r % 176, t = nb >> 3, w = nb & 7;
            p0_tr_item(w < 4 ? A.w_gate : A.w_up, DFF, 128 * t + 32 * (w & 3), 32, A.g_ffn, WguT, 1024, 256 * t + 32 * w, 64 * kb, scr, F.lane); continue; }
        r -= I_GU;
        { const int kb = r / 32, nb = r % 32; p0_tr_item(A.w_down, 1024, 32 * nb, 32, nullptr, WdT, DFF, 32 * nb, 64 * kb, scr, F.lane); }
    }
    u16* XH = (u16*)(F.ws + WS_XH); float* rinv1 = (float*)(F.ws + WS_RINV1);
    for (int m = gw; m < MTOK; m += NGW) {
        const f32x4* xr = (const f32x4*)(A.x + (size_t)m * DM) + F.lane; f32x4 v[4]; float s = 0.f;
#pragma unroll
        for (int j = 0; j < 4; ++j) { v[j] = xr[64 * j]; s += (v[j][0] * v[j][0] + v[j][1] * v[j][1]) + (v[j][2] * v[j][2] + v[j][3] * v[j][3]); }
        s = wave_sum(s);
        if (F.lane == 0) rinv1[m] = 1.0f / sqrtf(s * (1.0f / DM) + EPS);
        v2u* o = (v2u*)(XH + (size_t)m * DM) + F.lane;
#pragma unroll
        for (int j = 0; j < 4; ++j) { v2u h; h.x = cvt_pk_f16(v[j][0], v[j][1]); h.y = cvt_pk_f16(v[j][2], v[j][3]); o[64 * j] = h; }
    }
    f32x2* CS = (f32x2*)(F.ws + WS_CS);
    for (int e = F.vcu * (NWAVES * 64) + F.tid; e < SEQ * 64; e += F.G * NWAVES * 64) {
        const int pos = e >> 6, i = e & 63;
        const float theta = (float)(1.0 / exp2((double)i * (13.287712379549449 / 63.0)));
        const float ang = (float)pos * theta;
        const double rev = (double)ang * 0.15915494309189535; const double fr = rev - rint(rev);
        const double a = fr * 6.283185307179586;
        CS[e] = (f32x2){(float)cos(a), (float)sin(a)};
    }
    if (blockIdx.x == 0) { float* BT = (float*)(F.ws + WS_BIAS);
        for (int e = F.tid; e < 8 * 128; e += NWAVES * 64) { const int h = e >> 7, d = e & 127; BT[e] = (A.rel_bias[(int)T5_BUCKET[d] * 8 + h] - A.rel_bias[31 * 8 + h]) * 1.4426950408889634f; } }
}

__device__ __forceinline__ void ki_layernorm(Frame& F, const float* ln_g, const float* ln_b) {
    const float* KIR = (const float*)(F.ws + WS_KIRAW); u16* KIH = (u16*)(F.ws + WS_KIH);
    for (int e = F.vcu * (NWAVES * 64) + F.tid; e < MTOK * 4; e += F.G * NWAVES * 64) {
        const int tok = e >> 2, part = e & 3; const f32x4* src = (const f32x4*)(KIR + (size_t)tok * 64 + part * 16);
        f32x4 v[4]; float s = 0.f;
#pragma unroll
        for (int j = 0; j < 4; ++j) { v[j] = src[j]; s += (v[j][0] + v[j][1]) + (v[j][2] + v[j][3]); }
        s += __shfl_xor(s, 1); s += __shfl_xor(s, 2);
        const float mu = s * (1.0f / 64.0f); float q = 0.f;
#pragma unroll
        for (int j = 0; j < 4; ++j) { v[j] = v[j] - mu; q += (v[j][0] * v[j][0] + v[j][1] * v[j][1]) + (v[j][2] * v[j][2] + v[j][3] * v[j][3]); }
        q += __shfl_xor(q, 1); q += __shfl_xor(q, 2);
        const float rs = 1.0f / sqrtf(q * (1.0f / 64.0f) + EPS);
        v2u* dst = (v2u*)(KIH + (size_t)tok * 64 + part * 16);
#pragma unroll
        for (int j = 0; j < 4; ++j) { const f32x4 g = *(const f32x4*)(ln_g + part * 16 + 4 * j), bb = *(const f32x4*)(ln_b + part * 16 + 4 * j); const f32x4 y = v[j] * rs * g + bb;
            v2u h; h.x = cvt_pk_f16(y[0], y[1]); h.y = cvt_pk_f16(y[2], y[3]); dst[j] = h; }
    }
}

constexpr int RP = 136;
constexpr int RT_BYTES = 128 * RP * 2;
__device__ __forceinline__ float ret_log2g(int h) { return log2f(1.0f - exp2f(-5.0f - (float)h)); }
template <bool TR, bool DECAY> __device__ __forceinline__ void ret_stage_rot(Frame& F, const u16* src  , int row0, int pos0, int h, LAS _Float16* dst, float lg) {
    const f32x2* CS = (const f32x2*)(F.ws + WS_CS);
#pragma unroll
    for (int it = 0; it < 2; ++it) { const int ch = F.tid + 512 * it, j = ch >> 3, fc = ch & 7;
        const u16* p = src + (size_t)(row0 + j) * 512 + h * 128 + 8 * fc;
        const v4u a = *(const v4u*)p, b = *(const v4u*)(p + 64);
        const f32x4* cs = (const f32x4*)(CS + (size_t)(pos0 + j) * 64 + 8 * fc);
        const f32x4 c0 = cs[0], c1 = cs[1], c2 = cs[2], c3 = cs[3];
        const float co[8] = {c0[0], c0[2], c1[0], c1[2], c2[0], c2[2], c3[0], c3[2]}, si[8] = {c0[1], c0[3], c1[1], c1[3], c2[1], c2[3], c3[1], c3[3]};
        const unsigned aw[4] = {a.x, a.y, a.z, a.w}, bw[4] = {b.x, b.y, b.z, b.w};
        const float sc = DECAY ? exp2f(lg * (float)(127 - j)) : 1.0f;
#pragma unroll
        for (int i = 0; i < 8; ++i) { const float x1 = h2f((u16)(aw[i >> 1] >> (16 * (i & 1)))), x2 = h2f((u16)(bw[i >> 1] >> (16 * (i & 1))));
            const float o1 = (x1 * co[i] - x2 * si[i]) * sc, o2 = (x2 * co[i] + x1 * si[i]) * sc;
            if (TR) { dst[(8 * fc + i) * RP + j] = (_Float16)o1; dst[(64 + 8 * fc + i) * RP + j] = (_Float16)o2; }
            else { dst[j * RP + 8 * fc + i] = (_Float16)o1; dst[j * RP + 64 + 8 * fc + i] = (_Float16)o2; } }
    }
}
__device__ __forceinline__ void ret_stage_vt(Frame& F, const u16* src, int row0, int h, LAS _Float16* dst) {
#pragma unroll
    for (int it = 0; it < 4; ++it) { const int ch = F.tid + 512 * it, j = ch >> 4, fc = ch & 15;
        const v4u a = *(const v4u*)(src + (size_t)(row0 + j) * 512 + h * 128 + 8 * fc); const unsigned aw[4] = {a.x, a.y, a.z, a.w};
#pragma unroll
        for (int i = 0; i < 8; ++i) dst[(8 * fc + i) * RP + j] = __builtin_bit_cast(_Float16, (u16)(aw[i >> 1] >> (16 * (i & 1)))); }
}
__device__ __forceinline__ void ret_r1_unit(Frame& F, int u) {
    const int bh = u >> 6, c = u & 63, b = bh >> 2, h = bh & 3, row0 = b * SEQ + c * 128, r32 = F.lane & 31, hi = F.lane >> 5;
    LAS _Float16* KT = (LAS _Float16*)(F.lds + RING_OFF); LAS _Float16* VT = (LAS _Float16*)(F.lds + RING_OFF + RT_BYTES);
    ret_stage_rot<true, true>(F, (const u16*)(F.ws + WS_KB), row0, c * 128, h, KT, ret_log2g(h));
    ret_stage_vt(F, (const u16*)(F.ws + WS_VB), row0, h, VT);
    __syncthreads();
    const int eb = F.wave >> 1, db0 = 2 * (F.wave & 1);
    f32x16 acc0 = {}, acc1 = {};
#pragma unroll
    for (int s = 0; s < 8; ++s) {
        const f16x8 a = *(const LAS f16x8*)(VT + (32 * eb + r32) * RP + 16 * s + 8 * hi);
        const f16x8 b0 = *(const LAS f16x8*)(KT + (32 * db0 + r32) * RP + 16 * s + 8 * hi);
        const f16x8 b1 = *(const LAS f16x8*)(KT + (32 * (db0 + 1) + r32) * RP + 16 * s + 8 * hi);
        acc0 = __builtin_amdgcn_mfma_f32_32x32x16_f16(a, b0, acc0, 0, 0, 0);
        acc1 = __builtin_amdgcn_mfma_f32_32x32x16_f16(a, b1, acc1, 0, 0, 0);
    }
    float* DS = (float*)(F.ws + WS_DS) + (size_t)u * 16384;
#pragma unroll
    for (int r = 0; r < 16; ++r) { const int e = 32 * eb + crow(r, hi); DS[e * 128 + 32 * db0 + r32] = acc0[r]; DS[e * 128 + 32 * (db0 + 1) + r32] = acc1[r]; }
    __syncthreads();
}
__device__ __forceinline__ void ret_r2_scan(Frame& F) {
    const float* DS = (const float*)(F.ws + WS_DS); u16* ST = (u16*)(F.ws + WS_ST);
    for (int e = F.vcu * (NWAVES * 64) + F.tid; e < 16 * 8192; e += F.G * NWAVES * 64) {
        const int bh = e >> 13, off = (e & 8191) * 2; const float dec = exp2f(128.0f * ret_log2g(bh & 3));
        float s0 = 0.f, s1 = 0.f;
#pragma unroll 8
        for (int c = 0; c < 64; ++c) { const size_t o = ((size_t)(bh * 64 + c)) * 16384 + off;
            *(unsigned*)(ST + o) = cvt_pk_f16(s0, s1);
            const f32x2 d = *(const f32x2*)(DS + o); s0 = dec * s0 + d[0]; s1 = dec * s1 + d[1]; }
    }
}
__device__ __forceinline__ void ret_r3_unit(Frame& F, int u, const float* gn_g) {
    const int bh = u >> 6, c = u & 63, b = bh >> 2, h = bh & 3, row0 = b * SEQ + c * 128, r32 = F.lane & 31, hi = F.lane >> 5;
    LAS _Float16* Qs = (LAS _Float16*)(F.lds + RING_OFF); LAS _Float16* Ks = (LAS _Float16*)(F.lds + RING_OFF + RT_BYTES);
    LAS _Float16* VT = (LAS _Float16*)(F.lds + RING_OFF + 2 * RT_BYTES); LAS _Float16* Ps = (LAS _Float16*)(F.lds + RING_OFF + 3 * RT_BYTES);
    LAS float* rowpart = (LAS float*)(F.lds + 2048);
    const float lg = ret_log2g(h);
    ret_stage_rot<false, false>(F, (const u16*)(F.ws + WS_QB), row0, c * 128, h, Qs, lg);
    ret_stage_rot<false, false>(F, (const u16*)(F.ws + WS_KB), row0, c * 128, h, Ks, lg);
    ret_stage_vt(F, (const u16*)(F.ws + WS_VB), row0, h, VT);
    __syncthreads();
    const int ib = F.wave >> 1, xb0 = 2 * (F.wave & 1);
#pragma unroll
    for (int t = 0; t < 2; ++t) { const int jb = xb0 + t; f32x16 acc = {};
        if (jb <= ib) {
#pragma unroll
            for (int s = 0; s < 8; ++s) { const f16x8 a = *(const LAS f16x8*)(Qs + (32 * ib + r32) * RP + 16 * s + 8 * hi); const f16x8 bb = *(const LAS f16x8*)(Ks + (32 * jb + r32) * RP + 16 * s + 8 * hi);
                acc = __builtin_amdgcn_mfma_f32_32x32x16_f16(a, bb, acc, 0, 0, 0); } }
        const int j = 32 * jb + r32;
#pragma unroll
        for (int r = 0; r < 16; ++r) { const int i = 32 * ib + crow(r, hi); const float v = (i >= j) ? acc[r] * exp2f(lg * (float)(i - j)) : 0.f; Ps[i * RP + j] = (_Float16)v; } }
    __syncthreads();
    const u16* ST = (const u16*)(F.ws + WS_ST) + (size_t)u * 16384;
    f32x16 y[2];
#pragma unroll
    for (int t = 0; t < 2; ++t) { const int eb = xb0 + t; f32x16 intra = {}, cross = {};
#pragma unroll
        for (int s = 0; s < 8; ++s) { if (s < 2 * (ib + 1)) { const f16x8 a = *(const LAS f16x8*)(Ps + (32 * ib + r32) * RP + 16 * s + 8 * hi); const f16x8 bb = *(const LAS f16x8*)(VT + (32 * eb + r32) * RP + 16 * s + 8 * hi);
                intra = __builtin_amdgcn_mfma_f32_32x32x16_f16(a, bb, intra, 0, 0, 0); } }
#pragma unroll
        for (int s = 0; s < 8; ++s) { const f16x8 a = *(const LAS f16x8*)(Qs + (32 * ib + r32) * RP + 16 * s + 8 * hi); const f16x8 bb = *(const f16x8*)(ST + (32 * eb + r32) * 128 + 16 * s + 8 * hi);
            cross = __builtin_amdgcn_mfma_f32_32x32x16_f16(a, bb, cross, 0, 0, 0); }
#pragma unroll
        for (int r = 0; r < 16; ++r) { const int i = 32 * ib + crow(r, hi); y[t][r] = intra[r] + exp2f(lg * (float)(i + 1)) * cross[r]; } }
    float ss[16];
#pragma unroll
    for (int r = 0; r < 16; ++r) { float v = y[0][r] * y[0][r] + y[1][r] * y[1][r];
#pragma unroll
        for (int o = 1; o < 32; o <<= 1) v += __shfl_xor(v, o);
        ss[r] = v; }
    if (r32 == 0) {
#pragma unroll
        for (int r = 0; r < 16; ++r) rowpart[(F.wave & 1) * 128 + 32 * ib + crow(r, hi)] = ss[r]; }
    __syncthreads();
    const u16* GBp = (const u16*)(F.ws + WS_GB); u16* MIX = (u16*)(F.ws + WS_MIX);
#pragma unroll
    for (int r = 0; r < 16; ++r) { const int i = 32 * ib + crow(r, hi); const float rinv = 1.0f / sqrtf((rowpart[i] + rowpart[128 + i]) * (1.0f / 128.0f) + EPS);
#pragma unroll
        for (int t = 0; t < 2; ++t) { const int e = 32 * (xb0 + t) + r32; const float g = h2f(GBp[(size_t)(row0 + i) * 512 + h * 128 + e]);
            MIX[(size_t)(row0 + i) * 1024 + 512 + h * 128 + e] = __builtin_bit_cast(u16, (_Float16)(y[t][r] * rinv * gn_g[h * 128 + e] * g)); } }
    __syncthreads();
}

constexpr int IDX_CAP = 384;
struct IdxSt { unsigned lo, hi, need, shift, cnt, above, ready, pad; };
__device__ __forceinline__ unsigned ok_key(float s) { const unsigned u = __builtin_bit_cast(unsigned, s); return u ^ ((unsigned)((int)u >> 31) | 0x80000000u); }

__device__ __forceinline__ void lds_add(LAS unsigned* p, unsigned v) { (void)__hip_atomic_fetch_add(p, v, __ATOMIC_RELAXED, __HIP_MEMORY_SCOPE_WORKGROUP); }
__device__ __forceinline__ unsigned lds_add_rtn(LAS unsigned* p, unsigned v) { return __hip_atomic_fetch_add(p, v, __ATOMIC_RELAXED, __HIP_MEMORY_SCOPE_WORKGROUP); }
__device__ __forceinline__ void idx_unit(Frame& F, int b, int g) {
    const int lane = F.lane, wid = F.wave, l15 = lane & 15, fq = lane >> 4, set = wid >> 2, wsub = wid & 3;
    const int q0 = 32 * g, NT64 = 4 * (g >> 3) + 4, qloc = 16 * set + l15, qpos = q0 + qloc;
    unsigned* BMu = (unsigned*)(F.ws + WS_BM) + ((size_t)(b * 256 + g) * 128) * 64;
    if (g < 8) {
        const int r32 = lane & 31, hi = lane >> 5;
        for (int T = wid; T < NT64; T += 8) { unsigned w = 0u; const int lim = q0 + r32 - 64 * T - 4 * hi;
#pragma unroll 1
            for (int gi = 0; gi < 8; ++gi) { int c = lim - 8 * (gi & 3) - 32 * (gi >> 2) + 1; c = c < 0 ? 0 : (c > 4 ? 4 : c); w |= ((1u << c) - 1u) << (4 * gi); }
            BMu[T * 64 + lane] = w; }
        return;
    }
    LAS unsigned* hist = (LAS unsigned*)(F.lds + RING_OFF);
    volatile LAS IdxSt* st = (volatile LAS IdxSt*)(F.lds + 1024);
    volatile LAS unsigned* flag = (volatile LAS unsigned*)(F.lds + 512);
    for (int i = F.tid; i < 32768; i += NWAVES * 64) hist[i] = 0u;
    if (F.tid < 32) { st[F.tid].lo = 0xBC800000u; st[F.tid].hi = 0xC47FFFFFu; st[F.tid].need = 256u; st[F.tid].shift = 16u; st[F.tid].cnt = 0u; st[F.tid].above = 0u; st[F.tid].ready = 0u; }
    if (F.tid == 0) flag[0] = 0u;
    const size_t row = (size_t)b * SEQ + qpos;
    const u16* QI = (const u16*)(F.ws + WS_QI) + row * 512; const float* WI = (const float*)(F.ws + WS_WI) + row * 8;
    const u16* KIb = (const u16*)(F.ws + WS_KIH) + (size_t)b * SEQ * 64;
    float ch[8];
    { const f32x4 w0 = *(const f32x4*)WI, w1 = *(const f32x4*)(WI + 4);
#pragma unroll
      for (int j = 0; j < 4; ++j) { ch[j] = w0[j] * 0.0625f; ch[4 + j] = w1[j] * 0.0625f; } }
    f16x8 qf[8][2], qt[2];
#pragma unroll
    for (int h = 0; h < 8; ++h)
#pragma unroll
        for (int s = 0; s < 2; ++s) qf[h][s] = *(const f16x8*)(QI + h * 64 + 32 * s + 8 * fq);
#pragma unroll
    for (int s = 0; s < 2; ++s) {
#pragma unroll
        for (int i = 0; i < 8; ++i) { float a = 0.f;
#pragma unroll
            for (int h = 0; h < 8; ++h) a += ch[h] * (float)qf[h][s][i];
            qt[s][i] = (_Float16)a; } }
    __syncthreads();
    const int nT = (g >> 1) + 1;
#define IDX_TILE(kt, sc) do { const f16x8 k0_ = *(const f16x8*)(KIb + (size_t)((kt) + l15) * 64 + 8 * fq), k1_ = *(const f16x8*)(KIb + (size_t)((kt) + l15) * 64 + 32 + 8 * fq); \
        sc = __builtin_amdgcn_mfma_f32_16x16x32_f16(k0_, qt[0], (f32x4){0.f, 0.f, 0.f, 0.f}, 0, 0, 0); sc = __builtin_amdgcn_mfma_f32_16x16x32_f16(k1_, qt[1], sc, 0, 0, 0); \
        _Pragma("unroll") for (int h = 0; h < 8; ++h) { f32x4 dh_ = __builtin_amdgcn_mfma_f32_16x16x32_f16(k0_, qf[h][0], (f32x4){0.f, 0.f, 0.f, 0.f}, 0, 0, 0); dh_ = __builtin_amdgcn_mfma_f32_16x16x32_f16(k1_, qf[h][1], dh_, 0, 0, 0); \
            _Pragma("unroll") for (int i = 0; i < 4; ++i) sc[i] = __builtin_fmaf(__builtin_fabsf(dh_[i]), ch[h], sc[i]); } } while (0)

    bool first = true;
    LAS unsigned* hq = hist + qloc * 1024;
    for (int level = 0; level < 8; ++level) {
        const unsigned lo = st[qloc].ready ? 1u : st[qloc].lo, hiK = st[qloc].ready ? 0u : st[qloc].hi, sh = st[qloc].shift;
        for (int T = wsub; T < nT; T += 4) {
#pragma unroll 2
            for (int m = 0; m < 4; ++m) { const int kt = 64 * T + 16 * m;
                f32x4 sc; IDX_TILE(kt, sc);
                const int lim = qpos - kt - 4 * fq;
#pragma unroll
                for (int i = 0; i < 4; ++i) { const unsigned ok = ok_key(sc[i]);
                    if (i <= lim) { if (ok >= lo && ok <= hiK) { const unsigned bin = (ok - lo) >> sh; lds_add(hq + (bin >> 1), 1u << (16 * (bin & 1))); }
                                    else if (first && ok > hiK) lds_add((LAS unsigned*)&st[qloc].above, 1u); } } }
        }
        __syncthreads();
#pragma unroll 1
        for (int qq = 0; qq < 4; ++qq) { const int q = 4 * wid + qq; if (st[q].ready) continue;
            LAS unsigned* hw = hist + q * 1024 + 16 * lane; unsigned wv[16]; unsigned s = 0u;
#pragma unroll
            for (int i = 0; i < 16; ++i) { wv[i] = hw[i]; s += (wv[i] & 0xffffu) + (wv[i] >> 16); }
            unsigned suf = s;
#pragma unroll
            for (int o = 1; o < 64; o <<= 1) { const unsigned t = __shfl_down(suf, o); if (lane + o < 64) suf += t; }
            const unsigned total = __shfl(suf, 0), aboveL = suf - s;
            const unsigned qlo = st[q].lo, qhi = st[q].hi, qsh = st[q].shift, qneed = st[q].need, A0 = first ? st[q].above : 0u;
            if (A0 >= qneed) { if (lane == 0) { st[q].lo = qhi + 1u; st[q].hi = 0xFFFFFFFFu; st[q].above = 0u; } }
            else if (qneed - A0 > total) { if (lane == 0) { st[q].hi = qlo - 1u; st[q].lo = 0u; st[q].need = qneed - A0 - total; } }
            else { const unsigned need2 = qneed - A0;
                if (aboveL < need2 && need2 <= aboveL + s) {
                    unsigned accu = aboveL, bin = 0u, cbin = 0u; bool found = false;
#pragma unroll
                    for (int i = 15; i >= 0; --i) { const unsigned hc = wv[i] >> 16, lc = wv[i] & 0xffffu;
                        if (!found && accu + hc >= need2) { found = true; bin = 32u * lane + 2u * i + 1u; cbin = hc; } if (!found) accu += hc;
                        if (!found && accu + lc >= need2) { found = true; bin = 32u * lane + 2u * i; cbin = lc; } if (!found) accu += lc; }
                    const unsigned nlo = qlo + (bin << qsh); unsigned nhi = nlo + ((1u << qsh) - 1u); if (nhi < nlo || nhi > qhi) nhi = qhi;
                    st[q].lo = nlo; st[q].hi = nhi; st[q].need = need2 - accu;
                    if (cbin <= (unsigned)IDX_CAP || qsh == 0u) st[q].ready = 1u; }
            }
            LDS_WAIT();
            if (!st[q].ready) { const unsigned w_ = st[q].hi - st[q].lo; const unsigned nb = 32u - (unsigned)__builtin_clz(w_ | 1u); if (lane == 0) { st[q].shift = nb > 11u ? nb - 11u : 0u; flag[0] = 1u; }
#pragma unroll
                for (int i = 0; i < 16; ++i) hw[i] = 0u; }
        }
        __syncthreads();
        first = false;
        const unsigned again = flag[0];
        __syncthreads();
        if (F.tid == 0) flag[0] = 0u;
        if (!again) break;
    }
    {
        for (int i = F.tid; i < 32768; i += NWAVES * 64) hist[i] = 0u;
        __syncthreads();
        const unsigned lo = st[qloc].lo, hiK = st[qloc].hi;
        LAS unsigned* lq = hist + qloc * (2 * IDX_CAP);
        LAS unsigned* img = hist + 32 * 2 * IDX_CAP;
        for (int T = wsub; T < NT64; T += 4) { unsigned part = 0u;
            if (T < nT) {
#pragma unroll
                for (int m = 0; m < 4; ++m) { const int kt = 64 * T + 16 * m;
                    f32x4 sc; IDX_TILE(kt, sc);
                    const int lim = qpos - kt - 4 * fq;
#pragma unroll
                    for (int i = 0; i < 4; ++i) { const unsigned ok = ok_key(sc[i]);
                        if (i <= lim) { if (ok > hiK) part |= 1u << (16 * (m >> 1) + 8 * (m & 1) + 4 * (fq >> 1) + i);
                                        else if (ok >= lo) { const unsigned pos = lds_add_rtn((LAS unsigned*)&st[qloc].cnt, 1u); if (pos < (unsigned)IDX_CAP) { lq[2 * pos] = ok; lq[2 * pos + 1] = (unsigned)(kt + 4 * fq + i); } } } } }
            }
            const unsigned word = part | (unsigned)__shfl_xor((int)part, 32);
            if (fq < 2) img[T * 64 + qloc + 32 * (fq & 1)] = word; }
        __syncthreads();
#pragma unroll 1
        for (int qq = 0; qq < 4; ++qq) { const int q = 4 * wid + qq; const unsigned cnt = st[q].cnt < (unsigned)IDX_CAP ? st[q].cnt : (unsigned)IDX_CAP, need = st[q].need;
            const LAS unsigned* lw = hist + q * (2 * IDX_CAP);
            for (unsigned i = lane; i < cnt; i += 64) { const unsigned oki = lw[2 * i], ki = lw[2 * i + 1]; unsigned rank = 0u;
                for (unsigned j = 0; j < cnt; ++j) { const unsigned okj = lw[2 * j], kj = lw[2 * j + 1]; rank += (okj > oki || (okj == oki && kj < ki)) ? 1u : 0u; }
                if (rank < need) { const unsigned T = ki >> 6, k64 = ki & 63u, half = k64 >> 5, k32 = k64 & 31u, khi = (k32 >> 2) & 1u, r = (k32 & 3u) + 4u * (k32 >> 3);
                    (void)__hip_atomic_fetch_or(img + T * 64 + (unsigned)q + 32u * khi, 1u << (16u * half + r), __ATOMIC_RELAXED, __HIP_MEMORY_SCOPE_WORKGROUP); } } }
        __syncthreads();
        for (int i = F.tid; i < NT64 * 64; i += NWAVES * 64) BMu[i] = img[i];
    }
    __syncthreads();
#undef IDX_TILE
}

__device__ __forceinline__ void final_norm(Frame& F, float* out, const float* part, const float* gfin) {
    const int gw = F.vcu * NWAVES + F.wave, NGW = F.G * NWAVES;
    for (int m = gw; m < MTOK; m += NGW) {
        float p = (F.lane < 16) ? part[(size_t)m * 16 + F.lane] : 0.f; p = wave_sum(p);
        const float r = 1.0f / sqrtf(p * (1.0f / DM) + EPS);
        f32x4* xr = (f32x4*)(out + (size_t)m * DM) + F.lane; const f32x4* gr = (const f32x4*)gfin + F.lane;
#pragma unroll
        for (int j = 0; j < 4; ++j) { const f32x4 v = xr[64 * j] * r * gr[64 * j]; xr[64 * j] = v; }
    }
}

struct Args { const float* in[13]; float* out; unsigned char* ws; int ph_lo, ph_hi, li, pad; };
__global__ void __launch_bounds__(NWAVES * 64, 2) hymba_fwd(Args args) {
    extern __shared__ __attribute__((aligned(16))) unsigned char lds_raw[];
    Frame F;
    F.lds = (LAS unsigned char*)lds_raw; F.ws = args.ws;
    F.tid = threadIdx.x; F.lane = F.tid & 63; F.wave = __builtin_amdgcn_readfirstlane(F.tid >> 6);
    F.G = gridDim.x; { const int bx = blockIdx.x; F.vcu = (F.G % 8 == 0) ? (bx % 8) * (F.G / 8) + bx / 8 : bx; }
    for (int u = F.tid; u < LCTL_BYTES / 4; u += NWAVES * 64) ((LAS unsigned*)F.lds)[u] = 0u;
    __syncthreads();
    gu32* ctl = (gu32*)(args.ws + WS_CTL);
    XcdBarrier bar; bar.bar = (unsigned*)(ctl + CW_BAR) + args.li * XCD_BAR_WORDS; bar.x = 0; bar.st = nullptr;
    if (N_LAUNCHES != N_PHASES) bar = xcd_barrier_post((unsigned*)(ctl + CW_BAR) + args.li * XCD_BAR_WORDS, (volatile LAS unsigned*)(F.lds + 64));
#define GRID_BAR() do { if (N_LAUNCHES != N_PHASES) xcd_barrier(bar); } while (0)
    const int lo = args.ph_lo, hi = args.ph_hi;
#ifndef PHASE_MASK
#define PHASE_MASK 0x1ff
#endif
#define IN(k) (((PHASE_MASK >> (k)) & 1) && lo <= (k) && (k) < hi)
#define BOTH(k) (IN(k) && IN((k) + 1))
    const float* x = args.in[0];
    unsigned char* ws = args.ws;
    LAS unsigned char* ring = F.lds + RING_OFF;

    if (IN(0)) {
        P0Args A{x, args.in[1], args.in[2], args.in[5], args.in[7], args.in[8], args.in[9], args.in[10], args.in[11]};
        p0_prologue(F, A);
        if (BOTH(0)) GRID_BAR();
    }
    if (IN(1)) {
        pg8::Gemm g{(const u16*)(ws + WS_XH), (const u16*)(ws + WS_WIN), MTOK, N_IN, DM}; pg8::StaticOrder S; S.init(MTOK, N_IN, F.G, (int)blockIdx.x);
        pg8::EpiProj E{ws + WS_QA, (float*)(ws + WS_KIRAW), (float*)(ws + WS_WI), (const float*)(ws + WS_RINV1)};
        pg8::gemm_phase<pg8::EpiProj, pg8::StaticOrder, true, true>(ring, g, S, E);
        if (BOTH(1)) GRID_BAR();
    }
    if (IN(2)) {
        ki_layernorm(F, args.in[3], args.in[4]);
        for (int u = F.vcu; u < 1024; u += F.G) ret_r1_unit(F, u);
        if (BOTH(2)) GRID_BAR();
    }
    if (IN(3)) {
        ret_r2_scan(F);
        if (F.G == 256) { const int bb = F.vcu >> 6, s = F.vcu & 63;
            _Pragma("unroll 1") for (int i = 0; i < 4; ++i) { const int gq = (i == 0) ? 255 - s : (i == 1) ? 128 + s : (i == 2) ? 127 - s : s; idx_unit(F, bb, gq); } }
        else { _Pragma("unroll 1") for (int u = F.vcu; u < 1024; u += F.G) idx_unit(F, u >> 8, u & 255); }
        if (BOTH(3)) GRID_BAR();
    }
    if (IN(4)) {
        for (int u = F.vcu; u < 1024; u += F.G) ret_r3_unit(F, u, args.in[6]);
        const attn_body::AttnTensors AT{(const attn_body::bf16*)(ws + WS_QA), (const attn_body::bf16*)(ws + WS_KA), (const attn_body::bf16*)(ws + WS_VA), (u16*)(ws + WS_MIX), (const unsigned*)(ws + WS_BM), (const float*)(ws + WS_BIAS)};
        if (F.G == 256) { const attn_body::StaticOrder S((int)F.G, (int)blockIdx.x); attn_body::attn_phase<attn_body::StaticOrder>((char*)lds_raw + RING_OFF, AT, S); }
        else { const attn_body::StridedOrder S((int)F.G, (int)blockIdx.x); attn_body::attn_phase<attn_body::StridedOrder>((char*)lds_raw + RING_OFF, AT, S); }
        if (BOTH(4)) GRID_BAR();
    }
    if (IN(5)) {
        pg8::Gemm g{(const u16*)(ws + WS_MIX), (const u16*)(ws + WS_WOUT), MTOK, DM, DM}; pg8::StaticOrder S; S.init(MTOK, DM, F.G, (int)blockIdx.x);
        pg8::EpiX2 E{x, args.out, (u16*)(ws + WS_X2H), (float*)(ws + WS_PART2)};
        pg8::gemm_phase<pg8::EpiX2, pg8::StaticOrder, true, true>(ring, g, S, E);
        if (BOTH(5)) GRID_BAR();
    }
    if (IN(6)) {
        pg8::Gemm g{(const u16*)(ws + WS_X2H), (const u16*)(ws + WS_WGU), MTOK, 2 * DFF, DM}; pg8::StaticOrder S; S.init(MTOK, 2 * DFF, F.G, (int)blockIdx.x);
        pg8::EpiGU E{(u16*)(ws + WS_U), (const float*)(ws + WS_PART2)};
        pg8::gemm_phase<pg8::EpiGU, pg8::StaticOrder, true, true>(ring, g, S, E);
        if (BOTH(6)) GRID_BAR();
    }
    if (IN(7)) {
        pg8::Gemm g{(const u16*)(ws + WS_U), (const u16*)(ws + WS_WD), MTOK, DM, DFF}; pg8::StaticOrder S; S.init(MTOK, DM, F.G, (int)blockIdx.x);
        pg8::EpiDown E{args.out, (float*)(ws + WS_PART3)};
        pg8::gemm_phase<pg8::EpiDown, pg8::StaticOrder, true, true>(ring, g, S, E);
        if (BOTH(7)) GRID_BAR();
    }
    if (IN(8)) final_norm(F, args.out, (const float*)(ws + WS_PART3), args.in[12]);
#undef IN
#undef BOTH
#undef GRID_BAR
}

extern "C" void kernel_launch(void* const* d_in, const int* in_sizes, int n_in, void* d_out, int out_size, void* d_ws, size_t ws_size, hipStream_t stream) {
    static int grid = 0;
    if (grid == 0) {
        if (n_in != 13 || in_sizes[0] != MTOK * DM || out_size != MTOK * DM || ws_size < WS_END) { fprintf(stderr, "kernel_launch: unexpected shapes / workspace (%d inputs, ws %zu)\n", n_in, ws_size); grid = -1; return; }
        int dev = 0, cus = 0, per_cu = 0;
        if (hipGetDevice(&dev) != hipSuccess || hipDeviceGetAttribute(&cus, hipDeviceAttributeMultiprocessorCount, dev) != hipSuccess) { grid = -1; return; }
        if (hipFuncSetAttribute((const void*)hymba_fwd, hipFuncAttributeMaxDynamicSharedMemorySize, LDS_BYTES) != hipSuccess) { fprintf(stderr, "kernel_launch: hipFuncSetAttribute failed\n"); grid = -1; return; }
        if (hipOccupancyMaxActiveBlocksPerMultiprocessor(&per_cu, (const void*)hymba_fwd, NWAVES * 64, LDS_BYTES) != hipSuccess || per_cu < 1) { fprintf(stderr, "kernel_launch: occupancy query reports %d workgroups per CU\n", per_cu); }
        (void)hipGetLastError();
        grid = cus;
    }
    if (grid < 0) return;
    if (hipMemsetAsync((char*)d_ws + WS_CTL, 0, CTL_ZERO_BYTES, stream) != hipSuccess) return;
    Args a{};
    for (int i = 0; i < 13; ++i) a.in[i] = (const float*)d_in[i];
    a.out = (float*)d_out; a.ws = (unsigned char*)d_ws;
    for (int li = 0; li < N_LAUNCHES; ++li) {
        a.ph_lo = (N_LAUNCHES == N_PHASES) ? li : 0; a.ph_hi = (N_LAUNCHES == N_PHASES) ? li + 1 : N_PHASES; a.li = (N_LAUNCHES == N_PHASES) ? 0 : li; a.pad = 0;
        hipLaunchKernelGGL(hymba_fwd, dim3(grid), dim3(NWAVES * 64), LDS_BYTES, stream, a);
    }
}
```

```cpp
#include <hip/hip_runtime.h>
#include <hip/hip_bf16.h>
#include <cstdio>
#include <cstdint>
#include <cmath>

#define GAS __attribute__((address_space(1)))
#define LAS __attribute__((address_space(3)))
typedef unsigned short u16;
typedef _Float16 f16x8 __attribute__((ext_vector_type(8)));
typedef _Float16 f16x2 __attribute__((ext_vector_type(2)));
typedef float f32x2 __attribute__((ext_vector_type(2)));
typedef float f32x4 __attribute__((ext_vector_type(4)));
typedef float f32x16 __attribute__((ext_vector_type(16)));
typedef unsigned v4u __attribute__((ext_vector_type(4)));
typedef unsigned v2u __attribute__((ext_vector_type(2)));
typedef GAS unsigned gu32;
#define RLX_AGENT __ATOMIC_RELAXED, __HIP_MEMORY_SCOPE_AGENT
#define LDS_WAIT() asm volatile("s_waitcnt lgkmcnt(0)" ::: "memory")
#define VM_WAIT() asm volatile("s_waitcnt vmcnt(0)" ::: "memory")

__device__ __forceinline__ unsigned cvt_pk_f16(float lo, float hi) { f32x2 v = {lo, hi}; f16x2 h = __builtin_convertvector(v, f16x2); return __builtin_bit_cast(unsigned, h); }
__device__ __forceinline__ unsigned cvt_pk_bf16(float lo, float hi) { unsigned r; asm volatile("v_cvt_pk_bf16_f32 %0, %1, %2" : "=v"(r) : "v"(lo), "v"(hi)); return r; }
__device__ __forceinline__ float h2f(u16 h) { return (float)__builtin_bit_cast(_Float16, h); }
__device__ __forceinline__ float silu_f(float x) { return x * __builtin_amdgcn_rcpf(1.0f + __builtin_amdgcn_exp2f(-1.4426950408889634f * x)); }
__device__ __forceinline__ int crow(int r, int hi) { return (r & 3) + 8 * (r >> 2) + 4 * hi; }

constexpr int BATCH = 4, SEQ = 8192, DM = 1024, MTOK = BATCH * SEQ;
constexpr int NHA = 8, DHA = 64, NHB = 4, DHB = 128, DFF = 2816;
constexpr int N_IN = 4352;
constexpr float EPS = 1e-6f;
constexpr float C2 = 0.125f * 1.4426950408889634f;

namespace pg8 {
#define PG8_LAS __attribute__((address_space(3)))
constexpr int BM = 256, BK = 64, HALF = 128, HTB = HALF * BK * 2, STAGE_BYTES = 8 * HTB, NXCD = 8, WGM = 8;
__host__ __device__ __forceinline__ int lds_byte(int r, int c) { const int st = (r >> 4) * 2 + (c >> 5), rr = r & 15, cc = c & 31, ob = rr * 64 + cc * 2; return st * 1024 + (ob ^ (((ob >> 9) & 1) << 5)); }
__host__ __device__ __forceinline__ void stage_rc(int b, int& R, int& C) { const int st = b / 1024, sb = b % 1024, swz = sb ^ (((sb >> 9) & 1) << 5); R = (st >> 1) * 16 + swz / 64; C = (st & 1) * 32 + (swz % 64) / 2; }
__host__ __device__ __forceinline__ int perm32(int rho) { const int n = rho >> 4, i = rho & 15; return 8 * (i >> 2) + 4 * n + (i & 3); }
struct Unit { int pm, pn; };
struct Gemm { const u16* A; const u16* Bt; int M, N, K; };
struct StaticOrder {
    int nM, nN, nwg, G, c;
    __host__ __device__ void init(int M, int N, int G_, int c_) { nM = M / BM; nN = N / BM; nwg = nM * nN; G = G_; c = c_; }
    __host__ __device__ bool next(int i, Unit& u) const {
        const long L = (long)i * G + c; if (L >= nwg) return false;
        int wgid = (int)L; { const int q = nwg / NXCD, r = nwg % NXCD, xcd = wgid % NXCD, off = wgid / NXCD; wgid = (xcd < r ? xcd * (q + 1) : r * (q + 1) + (xcd - r) * q) + off; }
        const int nig = WGM * nN, gid = wgid / nig, fm = gid * WGM, gsz = (nM - fm) < WGM ? (nM - fm) : WGM;
        u.pm = fm + ((wgid % nig) % gsz); u.pn = (wgid % nig) / gsz; return true;
    }
    __device__ __forceinline__ void a_ready(const Unit&) const {}
    __device__ __forceinline__ void done(const Unit&) const {}
};

struct EpiProj {
    static constexpr int PROBE_ID = 40;
    static constexpr bool PERM = true, AFTER_DRAIN = false;
    unsigned char* tbase; float* kiraw; float* wi; const float* rinv;
    __device__ __forceinline__ void operator()(const f32x4 (&acc)[2][2][4][2], const Unit& u, int wr, int wc, int fr, int fq) const {
        const int row0 = u.pm * BM + wr * 64 + fr; const int pn = u.pn;
        if (pn < 16) {
            const int tsel = pn >> 1; u16* T = (u16*)(tbase + (size_t)tsel * (32u << 20));
            const int colt = (pn & 1) * 256 + wc * 32 + 8 * fq;
            const float sc = (tsel == 0) ? C2 : ((tsel == 5) ? 0.08838834764831845f : 1.0f);
#pragma unroll
            for (int ai = 0; ai < 2; ++ai)
#pragma unroll
                for (int m = 0; m < 4; ++m) { const int row = row0 + ai * HALF + m * 16; const float r = rinv[row] * sc; u16* rowp = T + (size_t)row * 512 + colt;
#pragma unroll
                    for (int bj = 0; bj < 2; ++bj) { f32x4 v0 = acc[ai][bj][m][0] * r, v1 = acc[ai][bj][m][1] * r;
                        if (tsel == 7) {
#pragma unroll
                            for (int j = 0; j < 4; ++j) { v0[j] = silu_f(v0[j]); v1[j] = silu_f(v1[j]); } }
                        v4u w;
                        if (tsel < 3) { w.x = cvt_pk_bf16(v0[0], v0[1]); w.y = cvt_pk_bf16(v0[2], v0[3]); w.z = cvt_pk_bf16(v1[0], v1[1]); w.w = cvt_pk_bf16(v1[2], v1[3]); }
                        else { w.x = cvt_pk_f16(v0[0], v0[1]); w.y = cvt_pk_f16(v0[2], v0[3]); w.z = cvt_pk_f16(v1[0], v1[1]); w.w = cvt_pk_f16(v1[2], v1[3]); }
                        *(v4u*)(rowp + bj * HALF) = w; } }
        } else {
            const int c0 = wc * 32 + 8 * fq;
#pragma unroll
            for (int ai = 0; ai < 2; ++ai)
#pragma unroll
                for (int m = 0; m < 4; ++m) { const int row = row0 + ai * HALF + m * 16; const float r = rinv[row];
                    if (c0 < 64) { *(f32x4*)(kiraw + (size_t)row * 64 + c0) = acc[ai][0][m][0] * r; *(f32x4*)(kiraw + (size_t)row * 64 + c0 + 4) = acc[ai][0][m][1] * r; }
                    else if (c0 == 64) { const float s = r * 0.35355339059327373f; *(f32x4*)(wi + (size_t)row * 8) = acc[ai][0][m][0] * s; *(f32x4*)(wi + (size_t)row * 8 + 4) = acc[ai][0][m][1] * s; } }
        }
    }
};
struct EpiX2 {
    static constexpr int PROBE_ID = 41;
    static constexpr bool PERM = false, AFTER_DRAIN = false;
    const u16* xh; u16* x2h; float* part;
    __device__ __forceinline__ void operator()(const f32x4 (&acc)[2][2][4][2], const Unit& u, int wr, int wc, int fr, int fq) const {
        const int row0 = u.pm * BM + wr * 64 + fr, col0 = u.pn * BM + wc * 32 + 4 * fq;
#pragma unroll
        for (int ai = 0; ai < 2; ++ai)
#pragma unroll
            for (int m = 0; m < 4; ++m) { const int row = row0 + ai * HALF + m * 16; const size_t off = (size_t)row * DM + col0; float ss = 0.f;
#pragma unroll
                for (int bj = 0; bj < 2; ++bj)
#pragma unroll
                    for (int n = 0; n < 2; ++n) { const size_t o = off + bj * HALF + n * 16; const v2u xx = *(const v2u*)(xh + o);
                        const f32x4 xr = {h2f((u16)(xx.x & 0xffffu)), h2f((u16)(xx.x >> 16)), h2f((u16)(xx.y & 0xffffu)), h2f((u16)(xx.y >> 16))}; const f32x4 v = xr + acc[ai][bj][m][n];
                        v2u h; h.x = cvt_pk_f16(v[0], v[1]); h.y = cvt_pk_f16(v[2], v[3]); *(v2u*)(x2h + o) = h;
                        ss += (v[0] * v[0] + v[1] * v[1]) + (v[2] * v[2] + v[3] * v[3]); }
                ss += __shfl_xor(ss, 16); ss += __shfl_xor(ss, 32);
                if (fq == 0) part[(size_t)row * 16 + u.pn * 4 + wc] = ss; }
    }
};
struct EpiGU {
    static constexpr int PROBE_ID = 42;
    static constexpr bool PERM = true, AFTER_DRAIN = false;
    u16* U; const float* part;
    __device__ __forceinline__ void operator()(const f32x4 (&acc)[2][2][4][2], const Unit& u, int wr, int wc, int fr, int fq) const {
        const int row0 = u.pm * BM + wr * 64 + fr, colt = u.pn * HALF + wc * 32 + 8 * fq;
#pragma unroll
        for (int ai = 0; ai < 2; ++ai)
#pragma unroll
            for (int m = 0; m < 4; ++m) { const int row = row0 + ai * HALF + m * 16; const f32x4* pp = (const f32x4*)(part + (size_t)row * 16);
                const f32x4 p0 = pp[0], p1 = pp[1], p2 = pp[2], p3 = pp[3];
                const float ssq = ((p0[0] + p0[1]) + (p0[2] + p0[3])) + ((p1[0] + p1[1]) + (p1[2] + p1[3])) + ((p2[0] + p2[1]) + (p2[2] + p2[3])) + ((p3[0] + p3[1]) + (p3[2] + p3[3]));
                const float r = __builtin_amdgcn_rsqf(ssq * (1.0f / DM) + EPS);
                float o[8];
#pragma unroll
                for (int n = 0; n < 2; ++n)
#pragma unroll
                    for (int j = 0; j < 4; ++j) o[4 * n + j] = silu_f(acc[ai][0][m][n][j] * r) * (acc[ai][1][m][n][j] * r);
                v4u w; w.x = cvt_pk_f16(o[0], o[1]); w.y = cvt_pk_f16(o[2], o[3]); w.z = cvt_pk_f16(o[4], o[5]); w.w = cvt_pk_f16(o[6], o[7]);
                *(v4u*)(U + (size_t)row * DFF + colt) = w; }
    }
};
struct EpiDownNorm {
    static constexpr int PROBE_ID = 43;
    static constexpr bool PERM = false, AFTER_DRAIN = false;
    const u16* x2h; float* out; float* part; unsigned* cnt; const float* gfin;
    __device__ __forceinline__ void operator()(f32x4 (&acc)[2][2][4][2], const Unit& u, int wr, int wc, int fr, int fq) const {
        const int row0 = u.pm * BM + wr * 64 + fr, col0 = u.pn * BM + wc * 32 + 4 * fq;
#pragma unroll
        for (int ai = 0; ai < 2; ++ai)
#pragma unroll
            for (int m = 0; m < 4; ++m) { const int row = row0 + ai * HALF + m * 16; const size_t off = (size_t)row * DM + col0; float ss = 0.f;
#pragma unroll
                for (int bj = 0; bj < 2; ++bj)
#pragma unroll
                    for (int n = 0; n < 2; ++n) { const size_t o = off + bj * HALF + n * 16; const v2u hh = *(const v2u*)(x2h + o);
                        const f32x4 r2 = {h2f((u16)(hh.x & 0xffffu)), h2f((u16)(hh.x >> 16)), h2f((u16)(hh.y & 0xffffu)), h2f((u16)(hh.y >> 16))}; const f32x4 v = r2 + acc[ai][bj][m][n];
                        acc[ai][bj][m][n] = v; ss += (v[0] * v[0] + v[1] * v[1]) + (v[2] * v[2] + v[3] * v[3]); }
                ss += __shfl_xor(ss, 16); ss += __shfl_xor(ss, 32);
                if (fq == 0) __hip_atomic_store((unsigned*)(part + (size_t)row * 16 + u.pn * 4 + wc), __builtin_bit_cast(unsigned, ss), __ATOMIC_RELAXED, __HIP_MEMORY_SCOPE_AGENT); }
        asm volatile("s_waitcnt vmcnt(0)" ::: "memory");
        __builtin_amdgcn_s_barrier(); asm volatile("" ::: "memory");
        unsigned* cw = cnt + 64 * u.pm;
        if (threadIdx.x == 0) (void)__hip_atomic_fetch_add(cw, 1u, __ATOMIC_RELAXED, __HIP_MEMORY_SCOPE_AGENT);
        if (threadIdx.x < 64) { unsigned spins = 0u;
            while ((unsigned)__builtin_amdgcn_readfirstlane(__hip_atomic_load(cw, __ATOMIC_RELAXED, __HIP_MEMORY_SCOPE_AGENT)) < 4u) { __builtin_amdgcn_s_sleep(2); if (++spins > (1u << 22)) break; }
            __builtin_amdgcn_fence(__ATOMIC_ACQUIRE, "agent");
            asm volatile("s_waitcnt vmcnt(0)" ::: "memory"); }
        asm volatile("" ::: "memory"); __builtin_amdgcn_s_barrier(); asm volatile("" ::: "memory");
        f32x4 gv[2][2];
#pragma unroll
        for (int bj = 0; bj < 2; ++bj)
#pragma unroll
            for (int n = 0; n < 2; ++n) gv[bj][n] = *(const f32x4*)(gfin + col0 + bj * HALF + n * 16);
#pragma unroll
        for (int ai = 0; ai < 2; ++ai)
#pragma unroll
            for (int m = 0; m < 4; ++m) { const int row = row0 + ai * HALF + m * 16; const size_t off = (size_t)row * DM + col0; const f32x4* pp = (const f32x4*)(part + (size_t)row * 16);
                const f32x4 p0 = pp[0], p1 = pp[1], p2 = pp[2], p3 = pp[3];
                const float ssq = ((p0[0] + p0[1]) + (p0[2] + p0[3])) + ((p1[0] + p1[1]) + (p1[2] + p1[3])) + ((p2[0] + p2[1]) + (p2[2] + p2[3])) + ((p3[0] + p3[1]) + (p3[2] + p3[3]));
                const float r = 1.0f / sqrtf(ssq * (1.0f / DM) + EPS);
#pragma unroll
                for (int bj = 0; bj < 2; ++bj)
#pragma unroll
                    for (int n = 0; n < 2; ++n) *(f32x4*)(out + off + bj * HALF + n * 16) = acc[ai][bj][m][n] * r * gv[bj][n]; }
    }
};
struct EpiDown {
    static constexpr int PROBE_ID = 44;
    static constexpr bool PERM = false, AFTER_DRAIN = false;
    const u16* x2h; float* x3; float* part;
    __device__ __forceinline__ void operator()(const f32x4 (&acc)[2][2][4][2], const Unit& u, int wr, int wc, int fr, int fq) const {
        const int row0 = u.pm * BM + wr * 64 + fr, col0 = u.pn * BM + wc * 32 + 4 * fq;
#pragma unroll
        for (int ai = 0; ai < 2; ++ai)
#pragma unroll
            for (int m = 0; m < 4; ++m) { const int row = row0 + ai * HALF + m * 16; const size_t off = (size_t)row * DM + col0; float ss = 0.f;
#pragma unroll
                for (int bj = 0; bj < 2; ++bj)
#pragma unroll
                    for (int n = 0; n < 2; ++n) { const size_t o = off + bj * HALF + n * 16; const v2u hh = *(const v2u*)(x2h + o);
                        const f32x4 r2 = {h2f((u16)(hh.x & 0xffffu)), h2f((u16)(hh.x >> 16)), h2f((u16)(hh.y & 0xffffu)), h2f((u16)(hh.y >> 16))}; const f32x4 v = r2 + acc[ai][bj][m][n];
                        *(f32x4*)(x3 + o) = v; ss += (v[0] * v[0] + v[1] * v[1]) + (v[2] * v[2] + v[3] * v[3]); }
                ss += __shfl_xor(ss, 16); ss += __shfl_xor(ss, 32);
                if (fq == 0) part[(size_t)row * 16 + u.pn * 4 + wc] = ss; }
    }
};

template <class Epi, class Sched, bool ALIGN_EPI = false, bool SP2 = false>
__device__ __forceinline__ void gemm_phase(PG8_LAS unsigned char* lds, const Gemm g, const Sched& S, const Epi& E) {
    const int tid = threadIdx.x, wid = __builtin_amdgcn_readfirstlane(tid >> 6), lane = tid & 63, wr = wid >> 2, wc = wid & 3, fr = lane & 15, fq = lane >> 4;
    const int K = g.K, nt = K / BK;
    unsigned voffA[2], voffB[2];
#pragma unroll
    for (int i = 0; i < 2; ++i) { int R, C; stage_rc(tid * 16 + i * 8192, R, C); const int Rb = Epi::PERM ? ((R & ~31) + perm32(R & 31)) : R;
        voffA[i] = (unsigned)(R * K + C) * 2u; voffB[i] = (unsigned)(Rb * K + C) * 2u; }
    const size_t kstep = (size_t)(BK * 2);
    const size_t hstep = (size_t)HALF * K * 2;
    const size_t tstep = 2 * hstep;
    const unsigned ldsw = (unsigned)wid * 1024u;
    const int aoff = lds_byte(wr * 64 + fr, fq * 8), boff = lds_byte(wc * 32 + fr, fq * 8);
#define PG8_SA(b, h) (((b) * 2 + (h)) * HTB)
#define PG8_SB(b, h) ((4 + (b) * 2 + (h)) * HTB)
#define PG8_STAGE(bufoff, gbase, voff) do { _Pragma("unroll") for (int _i = 0; _i < 2; ++_i) \
        __builtin_amdgcn_global_load_lds((const unsigned*)((const char*)(gbase) + (voff)[_i]), (PG8_LAS unsigned*)(lds + (bufoff) + ldsw + _i * 8192), 16, 0, 0); } while (0)
#define PG8_LDA(dst, b, h) do { _Pragma("unroll") for (int m = 0; m < 4; ++m) _Pragma("unroll") for (int k = 0; k < 2; ++k) dst[m][k] = *(const PG8_LAS f16x8*)(lds + PG8_SA(b, h) + aoff + m * 2048 + k * 1024); } while (0)
#define PG8_LDB(dst, b, h) do { _Pragma("unroll") for (int n = 0; n < 2; ++n) _Pragma("unroll") for (int k = 0; k < 2; ++k) dst[n][k] = *(const PG8_LAS f16x8*)(lds + PG8_SB(b, h) + boff + n * 2048 + k * 1024); } while (0)
#define PG8_MMA(ai, bj, At, Bt) do { __builtin_amdgcn_s_setprio(1); _Pragma("unroll") for (int m = 0; m < 4; ++m) _Pragma("unroll") for (int n = 0; n < 2; ++n) _Pragma("unroll") for (int k = 0; k < 2; ++k) \
        acc[ai][bj][m][n] = __builtin_amdgcn_mfma_f32_16x16x32_f16(Bt[n][k], At[m][k], acc[ai][bj][m][n], 0, 0, 0); __builtin_amdgcn_s_setprio(0); } while (0)
#define PG8_WAIT_V(n) asm volatile("s_waitcnt vmcnt(" #n ")" ::: "memory")
#define PG8_WAIT_L(n) asm volatile("s_waitcnt lgkmcnt(" #n ")" ::: "memory")
#define PG8_BAR __builtin_amdgcn_s_barrier()
#define PG8_SCHED __builtin_amdgcn_sched_barrier(0)
    Unit cur, nxt; int ui = 0;
    if (!S.next(0, cur)) return;
    f32x4 acc[2][2][4][2];
#pragma unroll
    for (int a = 0; a < 2; ++a)
#pragma unroll
        for (int b = 0; b < 2; ++b)
#pragma unroll
            for (int m = 0; m < 4; ++m)
#pragma unroll
                for (int n = 0; n < 2; ++n) acc[a][b][m][n] = (f32x4){0.f, 0.f, 0.f, 0.f};
    f16x8 At[4][2], B0[2][2], B1[2][2];
    const char* cA = (const char*)g.A + (size_t)cur.pm * tstep; const char* cB = (const char*)g.Bt + (size_t)cur.pn * tstep;
    S.a_ready(cur);
    if constexpr (SP2) {
        PG8_STAGE(PG8_SB(0, 0), cB, voffB); PG8_STAGE(PG8_SB(0, 1), cB + hstep, voffB); PG8_STAGE(PG8_SA(0, 0), cA, voffA); PG8_STAGE(PG8_SA(0, 1), cA + hstep, voffA);
        if (wr == 1) PG8_BAR;
        PG8_WAIT_V(2); PG8_BAR;
        PG8_STAGE(PG8_SB(1, 0), cB + kstep, voffB); PG8_STAGE(PG8_SA(1, 0), cA + kstep, voffA); PG8_STAGE(PG8_SB(1, 1), cB + hstep + kstep, voffB);
        PG8_WAIT_V(6); PG8_BAR;
    } else {
        PG8_STAGE(PG8_SB(0, 0), cB, voffB); PG8_STAGE(PG8_SA(0, 0), cA, voffA); PG8_STAGE(PG8_SB(0, 1), cB + hstep, voffB); PG8_STAGE(PG8_SA(0, 1), cA + hstep, voffA);
        if (wr == 1) PG8_BAR;
        PG8_WAIT_V(4); PG8_BAR;
        PG8_STAGE(PG8_SB(1, 0), cB + kstep, voffB); PG8_STAGE(PG8_SA(1, 0), cA + kstep, voffA); PG8_STAGE(PG8_SB(1, 1), cB + hstep + kstep, voffB);
        PG8_WAIT_V(6); PG8_BAR;
    }
    for (;;) {
        const bool has_next = S.next(ui + 1, nxt);
        const char* nA = has_next ? (const char*)g.A + (size_t)nxt.pm * tstep : cA; const char* nB = has_next ? (const char*)g.Bt + (size_t)nxt.pn * tstep : cB;
        for (int t = 0; t < nt; t += 2) {
            const bool last = (t == nt - 2);
            const char* a1 = cA + (size_t)(t + 1) * kstep;
            const char* a2 = last ? nA : cA + (size_t)(t + 2) * kstep; const char* b2 = last ? nB : cB + (size_t)(t + 2) * kstep;
            const char* a3 = a2 + kstep; const char* b3 = b2 + kstep;
            if (last && has_next) S.a_ready(nxt);
            if constexpr (SP2) {
            PG8_LDB(B0, 0, 0); PG8_LDB(B1, 0, 1); PG8_SCHED; PG8_LDA(At, 0, 0); PG8_STAGE(PG8_SA(1, 1), a1 + hstep, voffA);
            PG8_WAIT_V(8); PG8_WAIT_L(0); PG8_BAR; PG8_MMA(0, 0, At, B0); PG8_MMA(0, 1, At, B1); PG8_BAR; PG8_SCHED;
            PG8_LDA(At, 0, 1); PG8_STAGE(PG8_SB(0, 0), b2, voffB); PG8_STAGE(PG8_SB(0, 1), b2 + hstep, voffB); PG8_STAGE(PG8_SA(0, 0), a2, voffA);
            PG8_WAIT_V(8); PG8_WAIT_L(0); PG8_BAR; PG8_MMA(1, 0, At, B0); PG8_MMA(1, 1, At, B1); PG8_BAR; PG8_SCHED;
            PG8_LDB(B0, 1, 0); PG8_LDB(B1, 1, 1); PG8_SCHED; PG8_LDA(At, 1, 0); PG8_STAGE(PG8_SA(0, 1), a2 + hstep, voffA);
            PG8_WAIT_V(8); PG8_WAIT_L(0); PG8_BAR; PG8_MMA(0, 0, At, B0); PG8_MMA(0, 1, At, B1); PG8_BAR; PG8_SCHED;
            PG8_LDA(At, 1, 1); PG8_STAGE(PG8_SB(1, 0), b3, voffB); PG8_STAGE(PG8_SB(1, 1), b3 + hstep, voffB); PG8_STAGE(PG8_SA(1, 0), a3, voffA);
            PG8_WAIT_V(8); PG8_WAIT_L(0); PG8_BAR; PG8_MMA(1, 0, At, B0); PG8_MMA(1, 1, At, B1); PG8_BAR; PG8_SCHED;
            } else {
            PG8_LDB(B0, 0, 0); PG8_SCHED; PG8_LDA(At, 0, 0); PG8_STAGE(PG8_SA(1, 1), a1 + hstep, voffA);
            PG8_WAIT_L(8); PG8_BAR; PG8_WAIT_L(0); PG8_MMA(0, 0, At, B0); PG8_BAR; PG8_SCHED;
            PG8_LDB(B1, 0, 1); PG8_STAGE(PG8_SB(0, 0), b2, voffB);
            PG8_BAR; PG8_WAIT_L(0); PG8_MMA(0, 1, At, B1); PG8_BAR;
            PG8_LDA(At, 0, 1); PG8_STAGE(PG8_SA(0, 0), a2, voffA);
            PG8_BAR; PG8_WAIT_L(0); PG8_MMA(1, 0, At, B0); PG8_BAR; PG8_SCHED;
            PG8_STAGE(PG8_SB(0, 1), b2 + hstep, voffB);
            PG8_WAIT_V(6); PG8_BAR; PG8_MMA(1, 1, At, B1); PG8_BAR;
            PG8_LDB(B0, 1, 0); PG8_SCHED; PG8_LDA(At, 1, 0); PG8_STAGE(PG8_SA(0, 1), a2 + hstep, voffA);
            PG8_WAIT_L(8); PG8_BAR; PG8_WAIT_L(0); PG8_MMA(0, 0, At, B0); PG8_BAR; PG8_SCHED;
            PG8_LDB(B1, 1, 1); PG8_STAGE(PG8_SB(1, 0), b3, voffB);
            PG8_BAR; PG8_WAIT_L(0); PG8_MMA(0, 1, At, B1); PG8_BAR;
            PG8_LDA(At, 1, 1); PG8_STAGE(PG8_SA(1, 0), a3, voffA);
            PG8_BAR; PG8_WAIT_L(0); PG8_MMA(1, 0, At, B0); PG8_BAR; PG8_SCHED;
            PG8_STAGE(PG8_SB(1, 1), b3 + hstep, voffB);
            PG8_WAIT_V(6); PG8_BAR; PG8_MMA(1, 1, At, B1); PG8_BAR;
            }
        }
        if constexpr (ALIGN_EPI) { if (wr == 0) PG8_BAR; }
#ifdef PROBE_PHASE
        const unsigned long long pe0_ = (Epi::PROBE_ID == PROBE_PHASE) ? __builtin_amdgcn_s_memrealtime() : 0ull;
#endif
        if constexpr (!Epi::AFTER_DRAIN) { E(acc, cur, wr, wc, fr, fq); S.done(cur); }
#ifdef PROBE_PHASE
        if (Epi::PROBE_ID == PROBE_PHASE) { const unsigned long long t1_ = __builtin_amdgcn_s_memrealtime(), dt_ = t1_ - pe0_; while (__builtin_amdgcn_s_memrealtime() - t1_ < (unsigned long long)(PROBE_MULT) * dt_) __builtin_amdgcn_s_sleep(8); }
#endif
        if (!has_next) break;
#pragma unroll
        for (int a = 0; a < 2; ++a)
#pragma unroll
            for (int b = 0; b < 2; ++b)
#pragma unroll
                for (int m = 0; m < 4; ++m)
#pragma unroll
                    for (int n = 0; n < 2; ++n) acc[a][b][m][n] = (f32x4){0.f, 0.f, 0.f, 0.f};
        cur = nxt; cA = nA; cB = nB; ++ui;
        if constexpr (ALIGN_EPI) { if (wr == 1) PG8_BAR; }
    }
    PG8_WAIT_V(0);
    if constexpr (!ALIGN_EPI) { if (wr == 0) PG8_BAR; }
    PG8_BAR;
    if constexpr (Epi::AFTER_DRAIN) { E.fused(acc, cur, wr, wc, fr, fq, lds, wid, lane); S.done(cur); }
#undef PG8_SA
#undef PG8_SB
#undef PG8_STAGE
#undef PG8_LDA
#undef PG8_LDB
#undef PG8_MMA
#undef PG8_WAIT_V
#undef PG8_WAIT_L
#undef PG8_BAR
#undef PG8_SCHED
}

}

namespace attn_body {
using bf16=__hip_bfloat16;
using bf16x8=__attribute__((ext_vector_type(8)))short;
using s16x4=__attribute__((ext_vector_type(4)))short;
using f32x16=__attribute__((ext_vector_type(16)))float;
using u32x4=__attribute__((ext_vector_type(4)))unsigned;
constexpr int BATCH=4,NHEAD=8,SEQ=8192,D=64,DM=NHEAD*D,OPITCH=1024;
constexpr int NW=8,QBLK=32,QB=QBLK*NW,KVBLK=64,NQB=SEQ/QB;
constexpr int ATTN_PITCH=DM, ATTN_UNIT_ROWS=QB;
__device__ __forceinline__ int crow(int r,int hi){return (r&3)+8*(r>>2)+4*hi;}
#define SBAR() __builtin_amdgcn_sched_barrier(0)
__device__ __forceinline__ float bsel(float x,unsigned m){ return __builtin_bit_cast(float,__builtin_amdgcn_bitop3_b32(__builtin_bit_cast(unsigned,x),0xFF800000u,m,0xE4)); }
__device__ __forceinline__ void bmask(f32x16&p0,f32x16&p1,unsigned mw){
  #pragma unroll
  for(int r=0;r<16;++r){
    const unsigned m0=(unsigned)__builtin_amdgcn_sbfe((int)mw,r,1), m1=(unsigned)__builtin_amdgcn_sbfe((int)mw,16+r,1);
    const float x0=p0[r], x1=p1[r]; p0[r]=bsel(x0,m0); p1[r]=bsel(x1,m1); }
}
__device__ __forceinline__ void addbias(f32x16&p0,f32x16&p1,const float*btab,int dbase){
  #pragma unroll
  for(int r=0;r<16;++r){ int d0=dbase-((r&3)+8*(r>>2)); int d1=d0-32; d0=d0<0?0:(d0>127?127:d0); d1=d1<0?0:(d1>127?127:d1); p0[r]+=btab[d0]; p1[r]+=btab[d1]; }
}

constexpr int NSLOT=3, SLOTB=8192;
constexpr int LDS_K=0, LDS_V=NSLOT*SLOTB, LDS_WS=2*NSLOT*SLOTB, LDS_OST=LDS_WS+NW*64*4, LDS_BIAS=LDS_OST+NW*4096, LDS_MASK=LDS_BIAS+512, LDS_BYTES=LDS_MASK+NW*512;
constexpr float C2=0.125f*1.4426950408889634f;
__device__ __forceinline__ void glds16(const void*gsrc,unsigned lds_dst){unsigned keep;
  asm volatile("s_mov_b32 %0, m0\n\ts_mov_b32 m0, %2\n\ts_nop 0\n\tglobal_load_lds_dwordx4 %1, off\n\ts_mov_b32 m0, %0":"=&s"(keep):"v"(gsrc),"s"(lds_dst):"memory");}
__device__ __forceinline__ void glds4(const void*gsrc,unsigned lds_dst){unsigned keep;
  asm volatile("s_mov_b32 %0, m0\n\ts_mov_b32 m0, %2\n\ts_nop 0\n\tglobal_load_lds_dword %1, off\n\ts_mov_b32 m0, %0":"=&s"(keep):"v"(gsrc),"s"(lds_dst):"memory");}
__device__ __forceinline__ void glds4s(const void*sbase,unsigned voff,unsigned lds_dst){unsigned keep;
  asm volatile("s_mov_b32 %0, m0\n\ts_mov_b32 m0, %3\n\ts_nop 0\n\tglobal_load_lds_dword %1, %2\n\ts_mov_b32 m0, %0":"=&s"(keep):"v"(voff),"s"(sbase),"s"(lds_dst):"memory");}
__device__ __forceinline__ float max3f(float a,float b,float c){float r;asm("v_max3_f32 %0, %1, %2, %3":"=v"(r):"v"(a),"v"(b),"v"(c));return r;}
__device__ __forceinline__ float max2f(float a,float b){float r;asm("v_max_f32_e32 %0, %1, %2":"=v"(r):"v"(a),"v"(b));return r;}
__device__ __forceinline__ float fadd_s(float a,float b){float r;asm("v_add_f32_e32 %0, %1, %2":"=v"(r):"v"(a),"v"(b));return r;}
__device__ __forceinline__ float fsub_s(float a,float b){float r;asm("v_sub_f32_e32 %0, %1, %2":"=v"(r):"v"(a),"v"(b));return r;}
typedef float f32x2_t __attribute__((ext_vector_type(2))); typedef __bf16 bf16x2_t __attribute__((ext_vector_type(2)));
__device__ __forceinline__ unsigned cvtpk_s(float lo,float hi){f32x2_t v={lo,hi};bf16x2_t b=__builtin_convertvector(v,bf16x2_t);return __builtin_bit_cast(unsigned,b);}
#define WAIT_BAR(N) asm volatile("s_waitcnt vmcnt(" #N ") lgkmcnt(0)\n\ts_barrier":::"memory")

__device__ __forceinline__ void qkt(f32x16&p0,f32x16&p1,const char*Kslot,const bf16x8*qr,const f32x16&negm,int r32,int hi){
  const char*kb=Kslot+hi*1024+r32*16;
  #pragma unroll
  for(int d0=0;d0<4;++d0){
    const bf16x8 b0=*reinterpret_cast<const bf16x8*>(kb+d0*2048);
    const bf16x8 b1=*reinterpret_cast<const bf16x8*>(kb+d0*2048+512);
    if(d0==0){p0=__builtin_amdgcn_mfma_f32_32x32x16_bf16(b0,qr[0],negm,0,0,0);p1=__builtin_amdgcn_mfma_f32_32x32x16_bf16(b1,qr[0],negm,0,0,0);}
    else{p0=__builtin_amdgcn_mfma_f32_32x32x16_bf16(b0,qr[d0],p0,0,0,0);p1=__builtin_amdgcn_mfma_f32_32x32x16_bf16(b1,qr[d0],p1,0,0,0);}}
}
typedef __attribute__((address_space(3))) const char* lds_cptr;
typedef short v4i16_t __attribute__((ext_vector_type(4)));
__device__ __forceinline__ void kload8(bf16x8*kf,lds_cptr kp){
  kf[0]=*(const __attribute__((address_space(3))) bf16x8*)(kp);      kf[1]=*(const __attribute__((address_space(3))) bf16x8*)(kp+512);
  kf[2]=*(const __attribute__((address_space(3))) bf16x8*)(kp+2048); kf[3]=*(const __attribute__((address_space(3))) bf16x8*)(kp+2560);
  kf[4]=*(const __attribute__((address_space(3))) bf16x8*)(kp+4096); kf[5]=*(const __attribute__((address_space(3))) bf16x8*)(kp+4608);
  kf[6]=*(const __attribute__((address_space(3))) bf16x8*)(kp+6144); kf[7]=*(const __attribute__((address_space(3))) bf16x8*)(kp+6656);
}
__device__ __forceinline__ void kload2(bf16x8*kf,lds_cptr kp,int j){ kf[2*j]=*(const __attribute__((address_space(3))) bf16x8*)(kp+j*2048); kf[2*j+1]=*(const __attribute__((address_space(3))) bf16x8*)(kp+j*2048+512); }
__device__ __forceinline__ s16x4 vtr(lds_cptr p){ return __builtin_bit_cast(s16x4,__builtin_amdgcn_ds_read_tr16_b64_v4i16((__attribute__((address_space(3))) v4i16_t*)p)); }
__device__ __forceinline__ float rowmax(const f32x16&p0,const f32x16&p1){
  float a=max3f(p0[0],p0[1],p1[0]),b=max3f(p0[2],p0[3],p1[1]);a=max3f(a,p1[2],p1[3]);
  #pragma unroll
  for(int r=4;r<16;r+=4){a=max3f(a,p0[r],p0[r+1]);b=max3f(b,p0[r+2],p0[r+3]);a=max3f(a,p1[r],p1[r+1]);b=max3f(b,p1[r+2],p1[r+3]);}
  const float m=max2f(a,b);
  auto rr=__builtin_amdgcn_permlane32_swap(__float_as_uint(m),__float_as_uint(m),false,false);
  return max2f(__uint_as_float(rr[0]),__uint_as_float(rr[1]));
}
__device__ __forceinline__ void pv(f32x16*o,int vb,bf16x8 pa0,bf16x8 pa1,bf16x8 pa2,bf16x8 pa3){
  #pragma unroll
  for(int d0=0;d0<2;++d0){s16x4 lo[4],hi[4];
    #pragma unroll
    for(int ks=0;ks<4;++ks){
      asm volatile("ds_read_b64_tr_b16 %0,%1 offset:%c2":"=&v"(lo[ks]):"v"(vb),"i"(d0*4096+ks*1024):"memory");
      asm volatile("ds_read_b64_tr_b16 %0,%1 offset:%c2":"=&v"(hi[ks]):"v"(vb),"i"(d0*4096+ks*1024+512):"memory");}
    asm volatile("s_waitcnt lgkmcnt(0)":::"memory");SBAR();
    #define PK(k) (bf16x8){lo[k][0],lo[k][1],lo[k][2],lo[k][3],hi[k][0],hi[k][1],hi[k][2],hi[k][3]}
    o[d0]=__builtin_amdgcn_mfma_f32_32x32x16_bf16(pa0,PK(0),o[d0],0,0,0);
    o[d0]=__builtin_amdgcn_mfma_f32_32x32x16_bf16(pa1,PK(1),o[d0],0,0,0);
    o[d0]=__builtin_amdgcn_mfma_f32_32x32x16_bf16(pa2,PK(2),o[d0],0,0,0);
    o[d0]=__builtin_amdgcn_mfma_f32_32x32x16_bf16(pa3,PK(3),o[d0],0,0,0);
    #undef PK
  }
}

#ifndef ATTN_STORE16
#define ATTN_STORE16(p,v) (*(u32x4*)(p)=(v))
#endif
template<int THRL> __device__ __forceinline__ void attn_unit(int b,int h,int qb,const bf16*Q,const bf16*__restrict__ K,const bf16*__restrict__ V,unsigned short*O,const unsigned*__restrict__ BMK,const float*__restrict__ BIASG,char*shm){
  const int tid=threadIdx.x,lane=tid&63,r32=lane&31,hi=lane>>5; const int wid=__builtin_amdgcn_readfirstlane(tid>>6);
  const long rowbase=(long)b*SEQ; const int q0=qb*QB;
  const bf16*Qw=Q+(rowbase+q0+wid*QBLK)*DM+h*D;
  const bf16*Kh=K+rowbase*DM+h*D,*Vh=V+rowbase*DM+h*D;
  const unsigned lds0=(unsigned)(uintptr_t)shm;
  float*wsf=(float*)(shm+LDS_WS)+wid*64;
  float*btab=(float*)(shm+LDS_BIAS);
  if(tid<128)btab[tid]=BIASG[h*128+tid];
  const unsigned*bmw=BMK+((size_t)(b*256+qb*8+wid)*128)*64;
  unsigned mwc;
  const unsigned mdst=lds0+LDS_MASK+wid*512;
  #define MDMA(tt) glds4s(bmw+(size_t)(tt)*64,(unsigned)lane*4u,(unsigned)__builtin_amdgcn_readfirstlane(mdst+(((tt)&1)<<8)))
  #define MREAD(tt) (*(const __attribute__((address_space(3))) unsigned*)((lds_cptr)shm+LDS_MASK+wid*512+(((tt)&1)<<8)+lane*4))
  MDMA(0); MDMA(1);
  const bf16*ksrc=Kh+(long)lane*DM+wid*8;
  const bf16*vsrc=Vh+(long)(16*(wid&3)+(lane>>2))*DM+(wid>>2)*32+(lane&3)*8;
  const unsigned kdst=lds0+LDS_K+wid*1024, vdst=lds0+LDS_V+wid*1024;
  #define DMA_K(t,slot) glds16(ksrc+(long)(t)*KVBLK*DM,(unsigned)__builtin_amdgcn_readfirstlane(kdst+(slot)))
  #define DMA_V(t,slot) glds16(vsrc+(long)(t)*KVBLK*DM,(unsigned)__builtin_amdgcn_readfirstlane(vdst+(slot)))
  const int vb0=(int)(lds0+LDS_V)+((lane>>4)&1)*32+(lane&3)*8+(4*hi+((lane&15)>>2))*64;
  const char*Kbase=shm+LDS_K; bf16x8 kf[8];
  const lds_cptr shm3=(lds_cptr)shm; const lds_cptr kp0=shm3+LDS_K+hi*1024+r32*16; const lds_cptr vp0=shm3+LDS_V+((lane>>4)&1)*32+(lane&3)*8+(4*hi+((lane&15)>>2))*64;
  const int NT=(q0+QB)/KVBLK;
  DMA_K(0,0);DMA_V(0,0);DMA_K(1,SLOTB);
  bf16x8 qr[4];
  #pragma unroll
  for(int d0=0;d0<4;++d0)qr[d0]=*reinterpret_cast<const bf16x8*>(&Qw[(long)r32*DM+d0*16+hi*8]);
  float mhat=0.f,l_reg=0.f;f32x16 o[2];o[0]=f32x16{};o[1]=f32x16{};f32x16 negm=f32x16{};asm volatile("":"+v"(negm));
  const int qrel=wid*QBLK+r32;
  #define CMASK(P0,P1,t) do{ bmask(P0,P1,mwc); if((t)>=NT-7)addbias(P0,P1,btab,q0+qrel-64*(t)-4*hi); }while(0)
  bool resc=false;
  #define START(P0,P1) do{ const float rm=rowmax(P0,P1); resc=false; \
    { const float dl=(rm==-INFINITY)?0.f:rm; mhat=fadd_s(mhat,dl); \
      _Pragma("unroll") for(int r=0;r<16;++r){P0[r]=fsub_s(P0[r],dl);P1[r]=fsub_s(P1[r],dl);} \
      _Pragma("unroll") for(int r=0;r<16;++r)negm[r]=-mhat; asm volatile("":"+v"(negm)); } \
    _Pragma("unroll") for(int r=0;r<16;++r)P0[r]=__builtin_amdgcn_exp2f(P0[r]); }while(0)
  #define RESC() do{ if(resc){ asm volatile("s_waitcnt lgkmcnt(0)":::"memory"); \
      _Pragma("unroll") for(int d_=0;d_<2;++d_) _Pragma("unroll") for(int r=0;r<16;++r)o[d_][r]*=wsf[crow(r,hi)]; } }while(0)
  f32x16 pA0,pA1,pB0,pB1;
  int sl_prev=0,sl_cur=0,sl_next=SLOTB;
  #define ROT() do{sl_prev=sl_cur;sl_cur=sl_next;sl_next=(sl_next==(NSLOT-1)*SLOTB)?0:sl_next+SLOTB;}while(0)
  DMA_K(2,2*SLOTB);
  WAIT_BAR(3);
  mwc=MREAD(0);
  qkt(pA0,pA1,Kbase,qr,negm,r32,hi);asm volatile("s_nop 15\n\ts_nop 7":"+v"(pA0),"+v"(pA1));CMASK(pA0,pA1,0);
  START(pA0,pA1);
  _Pragma("unroll") for(int r=0;r<16;++r)pA1[r]=__builtin_amdgcn_exp2f(pA1[r]);
  WAIT_BAR(0);
  DMA_K(3,0);DMA_V(1,SLOTB);
  ROT();
  kload8(kf,kp0+sl_cur);
  WAIT_BAR(2);
  s16x4 vlo[8],vhi[8]; u32x4 pw0,pw1,pw2,pw3;
  #define PKW(P,B) cvtpk_s(P[B],P[B+1])
  #define PAF(k) __builtin_bit_cast(bf16x8,pw##k)
  #define VFR(i) (bf16x8){vlo[i][0],vlo[i][1],vlo[i][2],vlo[i][3],vhi[i][0],vhi[i][1],vhi[i][2],vhi[i][3]}
  #define PIN(x) asm volatile("":"+v"(x))
  #define MX3(a,b,c) __builtin_fmaxf(__builtin_fmaxf((a),(b)),(c))
  #define GAPA(MF,A0,A1,A2,A3,W0,W1,PW) do{ MF; sacc+=A0; sacc+=A1; sacc+=A2; sacc+=A3; PIN(sacc); W0; W1; PIN(PW); SBAR(); }while(0)
  #define EX(v) __builtin_amdgcn_exp2f(v)
  #define GAPB(MF,X,B) do{ MF; X[B]=EX(X[B]); X[B+1]=EX(X[B+1]); X[B+2]=EX(X[B+2]); X[B+3]=EX(X[B+3]); PIN(X); SBAR(); }while(0)
  #define VRD(i) do{ vlo[i]=vtr(vp_+(((i)>>2)*4096+((i)&3)*1024)); vhi[i]=vtr(vp_+(((i)>>2)*4096+((i)&3)*1024+512)); }while(0)
  #define KRD(G,j) do{ if(G){ kload2(kf,kp0+sl_next,j); SBAR(); } }while(0)
  #define STEP(C0,C1,P0,P1,t,GK,GV,GL) do{ SBAR(); mwc=MREAD(t); \
    const lds_cptr vp_=vp0+sl_prev; \
    VRD(0); SBAR(); float sacc=(P0[0]+P0[1]); \
    GAPA(C0=__builtin_amdgcn_mfma_f32_32x32x16_bf16(kf[0],qr[0],negm,0,0,0), P0[2],P0[3],P0[4],P0[5],     pw0[0]=PKW(P0,0), pw0[1]=PKW(P0,2), pw0); \
    VRD(4); SBAR(); GAPA(C1=__builtin_amdgcn_mfma_f32_32x32x16_bf16(kf[1],qr[0],negm,0,0,0), P0[6],P0[7],P0[8],P0[9],     pw0[2]=PKW(P0,4), pw0[3]=PKW(P0,6), pw0); \
    VRD(1); SBAR(); GAPA(C0=__builtin_amdgcn_mfma_f32_32x32x16_bf16(kf[2],qr[1],C0,0,0,0),   P0[10],P0[11],P0[12],P0[13], pw1[0]=PKW(P0,8), pw1[1]=PKW(P0,10), pw1); \
    VRD(5); SBAR(); GAPA(C1=__builtin_amdgcn_mfma_f32_32x32x16_bf16(kf[3],qr[1],C1,0,0,0),   P0[14],P0[15],P1[0],P1[1],   pw1[2]=PKW(P0,12),pw1[3]=PKW(P0,14), pw1); \
    VRD(2); SBAR(); GAPA(C0=__builtin_amdgcn_mfma_f32_32x32x16_bf16(kf[4],qr[2],C0,0,0,0),   P1[2],P1[3],P1[4],P1[5],     pw2[0]=PKW(P1,0), pw2[1]=PKW(P1,2), pw2); \
    VRD(6); SBAR(); GAPA(C1=__builtin_amdgcn_mfma_f32_32x32x16_bf16(kf[5],qr[2],C1,0,0,0),   P1[6],P1[7],P1[8],P1[9],     pw2[2]=PKW(P1,4), pw2[3]=PKW(P1,6), pw2); \
    VRD(3); SBAR(); GAPA(C0=__builtin_amdgcn_mfma_f32_32x32x16_bf16(kf[6],qr[3],C0,0,0,0),   P1[10],P1[11],P1[12],P1[13], pw3[0]=PKW(P1,8), pw3[1]=PKW(P1,10), pw3); \
    VRD(7); SBAR(); GAPA(C1=__builtin_amdgcn_mfma_f32_32x32x16_bf16(kf[7],qr[3],C1,0,0,0),   P1[14],P1[15],0.f,0.f,       pw3[2]=PKW(P1,12),pw3[3]=PKW(P1,14), pw3); \
    l_reg+=sacc; \
    if((t)+1<NT){MDMA((t)+1);} if(GK){DMA_K((t)+3,sl_cur);} if(GV){DMA_V((t)+1,sl_next);} \
    CMASK(C0,C1,t); \
    { float a=MX3(C0[0],C0[1],C1[0]),b=MX3(C0[2],C0[3],C1[1]); a=MX3(a,C1[2],C1[3]); \
      _Pragma("unroll") for(int r=4;r<16;r+=4){a=MX3(a,C0[r],C0[r+1]);b=MX3(b,C0[r+2],C0[r+3]);a=MX3(a,C1[r],C1[r+1]);b=MX3(b,C1[r+2],C1[r+3]);} \
      float rm=__builtin_fmaxf(a,b); { auto rr=__builtin_amdgcn_permlane32_swap(__float_as_uint(rm),__float_as_uint(rm),false,false); rm=__builtin_fmaxf(__uint_as_float(rr[0]),__uint_as_float(rr[1])); } \
      resc=false; \
      if(__builtin_expect(__any(rm>(float)THRL),0)){ const float dl=__builtin_fmaxf(rm,0.f); mhat+=dl; \
        _Pragma("unroll") for(int r=0;r<16;++r){C0[r]-=dl;C1[r]-=dl;} \
        _Pragma("unroll") for(int r=0;r<16;++r)negm[r]=-mhat; asm volatile("":"+v"(negm)); \
        const float f=__builtin_amdgcn_exp2f(-dl); l_reg*=f; if(hi==0)wsf[r32]=f; resc=true; } } \
    SBAR(); \
    GAPB(o[0]=__builtin_amdgcn_mfma_f32_32x32x16_bf16(PAF(0),VFR(0),o[0],0,0,0), C0,0); \
    GAPB(o[1]=__builtin_amdgcn_mfma_f32_32x32x16_bf16(PAF(0),VFR(4),o[1],0,0,0), C0,4); \
    KRD(GL,0); GAPB(o[0]=__builtin_amdgcn_mfma_f32_32x32x16_bf16(PAF(1),VFR(1),o[0],0,0,0), C0,8); \
    KRD(GL,1); GAPB(o[1]=__builtin_amdgcn_mfma_f32_32x32x16_bf16(PAF(1),VFR(5),o[1],0,0,0), C0,12); \
    KRD(GL,2); GAPB(o[0]=__builtin_amdgcn_mfma_f32_32x32x16_bf16(PAF(2),VFR(2),o[0],0,0,0), C1,0); \
    KRD(GL,3); GAPB(o[1]=__builtin_amdgcn_mfma_f32_32x32x16_bf16(PAF(2),VFR(6),o[1],0,0,0), C1,4); \
    GAPB(o[0]=__builtin_amdgcn_mfma_f32_32x32x16_bf16(PAF(3),VFR(3),o[0],0,0,0), C1,8); \
    GAPB(o[1]=__builtin_amdgcn_mfma_f32_32x32x16_bf16(PAF(3),VFR(7),o[1],0,0,0), C1,12); \
    }while(0)
  int t=1;
  #undef CMASK
  #define CMASK(P0,P1,t) do{ bmask(P0,P1,mwc); }while(0)
  for(;t+7<NT;t+=2){
    STEP(pB0,pB1,pA0,pA1,t,true,true,true);     WAIT_BAR(2); RESC(); ROT();
    STEP(pA0,pA1,pB0,pB1,t+1,true,true,true);   WAIT_BAR(2); RESC(); ROT();
  }
  #undef CMASK
  #define CMASK(P0,P1,t) do{ bmask(P0,P1,mwc); addbias(P0,P1,btab,q0+qrel-64*(t)-4*hi); }while(0)
  #define ENDW(tt) do{ if((tt)+3<NT){WAIT_BAR(2);} else if((tt)+2<NT){WAIT_BAR(1);} else {WAIT_BAR(0);} }while(0)
  for(;t+1<NT;t+=2){
    STEP(pB0,pB1,pA0,pA1,t,(t+3<NT),(t+1<NT),(t+1<NT));       ENDW(t);   RESC(); ROT();
    STEP(pA0,pA1,pB0,pB1,t+1,(t+4<NT),(t+2<NT),(t+2<NT));     ENDW(t+1); RESC(); ROT();
  }
  STEP(pB0,pB1,pA0,pA1,NT-1,false,false,false); RESC();
  { float sacc=pB0[0]+pB0[1]; _Pragma("unroll") for(int r=2;r<16;++r)sacc+=pB0[r]; _Pragma("unroll") for(int r=0;r<16;++r)sacc+=pB1[r]; l_reg+=sacc;
    pw0=(u32x4){PKW(pB0,0),PKW(pB0,2),PKW(pB0,4),PKW(pB0,6)};pw1=(u32x4){PKW(pB0,8),PKW(pB0,10),PKW(pB0,12),PKW(pB0,14)};pw2=(u32x4){PKW(pB1,0),PKW(pB1,2),PKW(pB1,4),PKW(pB1,6)};pw3=(u32x4){PKW(pB1,8),PKW(pB1,10),PKW(pB1,12),PKW(pB1,14)};
    SBAR(); pv(o,vb0+sl_cur,PAF(0),PAF(1),PAF(2),PAF(3)); }
  #undef PKW
  #undef PAF
  #undef VFR
  #undef PIN
  #undef MX3
  #undef GAPA
  #undef GAPB
  #undef EX
  #undef VRD
  #undef KRD
  #undef STEP
  #undef ENDW
  {auto rr=__builtin_amdgcn_permlane32_swap(__float_as_uint(l_reg),__float_as_uint(l_reg),false,false);l_reg=__uint_as_float(rr[0])+__uint_as_float(rr[1]);}
  if(hi==0)wsf[32+r32]=l_reg;asm volatile("s_waitcnt lgkmcnt(0)":::"memory");
  float rli[16];
  #pragma unroll
  for(int r=0;r<16;++r)rli[r]=__builtin_amdgcn_rcpf(wsf[32+crow(r,hi)]);
  unsigned short*Ow=O+(rowbase+q0+wid*QBLK)*OPITCH+h*D;
  { _Float16*stg=(_Float16*)(shm+LDS_OST)+wid*2048;
    #pragma unroll
    for(int r=0;r<16;++r){const int orow=crow(r,hi);
      #pragma unroll
      for(int d0=0;d0<2;++d0)stg[orow*64+d0*32+r32]=(_Float16)(o[d0][r]*rli[r]);}
    asm volatile("s_waitcnt lgkmcnt(0)":::"memory");
    #pragma unroll
    for(int i=0;i<4;++i){const int row=i*8+(lane>>3),ch=lane&7; const u32x4 v=*(const u32x4*)(stg+row*64+ch*8); ATTN_STORE16(Ow+(long)row*OPITCH+ch*8,v);} }
  asm volatile("s_waitcnt lgkmcnt(0)\n\ts_barrier":::"memory");
  #undef DMA_K
  #undef MDMA
  #undef MREAD
  #undef DMA_V
  #undef CMASK
  #undef START
  #undef RESC
  #undef ROT
}
constexpr int ATTN_LDS_BYTES=LDS_BYTES;
struct AttnTensors { const bf16* Q; const bf16* K; const bf16* V; unsigned short* O; const unsigned* BMK; const float* BIASG; };
struct AttnUnit { int bh; int qb; };
struct StaticOrder {
  int vcu;
  __device__ __forceinline__ explicit StaticOrder(int grid,int block):vcu((block%8)*(grid/8)+block/8){}
  __device__ __forceinline__ bool next(int i,AttnUnit&u)const{ if(i>=4)return false; const int s=vcu&7; u.bh=vcu>>3; u.qb=(i==0)?s:(i==1)?15-s:(i==2)?16+s:31-s; return true; }
  __device__ __forceinline__ void a_ready(const AttnUnit&)const{}
  __device__ __forceinline__ void done(const AttnUnit&)const{}
};
struct StridedOrder {
  int G,c;
  __device__ __forceinline__ explicit StridedOrder(int grid,int block):G(grid),c(block){}
  __device__ __forceinline__ bool next(int i,AttnUnit&u)const{ const int L=i*G+c; if(L>=BATCH*NHEAD*NQB)return false; u.bh=L/NQB; u.qb=L%NQB; return true; }
  __device__ __forceinline__ void a_ready(const AttnUnit&)const{}
  __device__ __forceinline__ void done(const AttnUnit&)const{}
};
template<class Sched,int THRL=8> __device__ __forceinline__ void attn_phase(char*lds,const AttnTensors&T,const Sched&S){
  AttnUnit u;
  for(int i=0;S.next(i,u);++i){ S.a_ready(u); attn_unit<THRL>(u.bh/NHEAD,u.bh%NHEAD,u.qb,T.Q,T.K,T.V,T.O,T.BMK,T.BIASG,lds); S.done(u); }
}
#undef SBAR
#undef WAIT_BAR
}

constexpr int NWAVES = 8;
#ifndef MK_N_LAUNCHES
#define MK_N_LAUNCHES 1
#endif
constexpr int N_PHASES = 9;
constexpr int N_LAUNCHES = MK_N_LAUNCHES;

constexpr size_t MiB = 1u << 20;
constexpr size_t WS_CTL = 0, CTL_ZERO_BYTES = 128 * 1024;
constexpr size_t WS_WIN = 2 * MiB, WS_WOUT = 11 * MiB, WS_WGU = 13 * MiB, WS_WD = 24 * MiB;
constexpr size_t WS_CS = 30 * MiB;
constexpr size_t WS_RINV1 = 34 * MiB, WS_PART2 = 35 * MiB, WS_PART3 = 37 * MiB, WS_WI = 39 * MiB;
constexpr size_t WS_BIAS = 34 * MiB + 512 * 1024;
constexpr size_t WS_KIRAW = 40 * MiB, WS_KIH = 48 * MiB;
constexpr size_t WS_XH = 52 * MiB, WS_MIX = 52 * MiB;
constexpr size_t WS_QA = 116 * MiB;
constexpr size_t WS_KA = WS_QA + 32 * MiB, WS_VA = WS_QA + 64 * MiB, WS_QI = WS_QA + 96 * MiB, WS_QB = WS_QA + 128 * MiB, WS_KB = WS_QA + 160 * MiB, WS_VB = WS_QA + 192 * MiB, WS_GB = WS_QA + 224 * MiB;
constexpr size_t WS_DS = 372 * MiB;
constexpr size_t WS_ST = 436 * MiB;
constexpr size_t WS_BM = 468 * MiB;
constexpr size_t WS_X2H = 372 * MiB;
constexpr size_t WS_U = 180 * MiB;
constexpr size_t WS_END = 512 * MiB;
static_assert(WS_BM + 32 * MiB <= WS_END && WS_U + (size_t)MTOK * DFF * 2 <= WS_DS + 64 * MiB, "d_ws map");
constexpr int CW_BAR = 4096;

constexpr int LCTL_BYTES = 4096;
constexpr int RING_OFF = LCTL_BYTES, RING_BYTES = 139264;
constexpr int LDS_BYTES = RING_OFF + RING_BYTES;
static_assert(LDS_BYTES <= 160 * 1024 - 1024, "LDS");

#define XB_TMO      128
#define XB_XCNT(j)  (256  + 64 * (j))
#define XB_XSUB(j)  (1280 + 64 * (j))
#define XB_XGEN(j)  (2304 + 64 * (j))
#define XB_TOP      3328
#define XB_TOPGEN   3392
#define XCD_BAR_WORDS 3456
#define XB_SPIN_CAP (1u << 18)

__device__ __forceinline__ unsigned xb_ld(unsigned* p)              { return __hip_atomic_load(p, __ATOMIC_RELAXED, __HIP_MEMORY_SCOPE_AGENT); }
__device__ __forceinline__ unsigned xb_add(unsigned* p, unsigned v) { return __hip_atomic_fetch_add(p, v, __ATOMIC_RELAXED, __HIP_MEMORY_SCOPE_AGENT); }
__device__ __forceinline__ unsigned xb_xcc_id() { return (unsigned)__builtin_amdgcn_s_getreg((3 << 11) | 20) & 0xFu; }
#define XB_SPIN(cond, bar) do { unsigned _sp = 0; while (cond) { __builtin_amdgcn_s_sleep(1); \
    if ((++_sp & 255u) == 0u) { if (xb_ld(&(bar)[XB_TMO])) break; if (_sp > XB_SPIN_CAP) { atomicAdd(&(bar)[XB_TMO], 1u); break; } } } } while (0)

struct XcdBarrier {
    unsigned* bar; unsigned x;
    volatile LAS unsigned* st;
};

__device__ __forceinline__ XcdBarrier xcd_barrier_post(unsigned* bar, volatile LAS unsigned* st) {
    XcdBarrier b; b.bar = bar; b.x = xb_xcc_id(); b.st = st;
    if (threadIdx.x == 0) (void)xb_add(&bar[XB_XCNT(b.x)], 1u);
    return b;
}
__device__ __forceinline__ void xcd_barrier_complete(unsigned* bar, unsigned x, unsigned& nloc, unsigned& nx) {
    const unsigned G = gridDim.x * gridDim.y * gridDim.z;
    unsigned sum, cnt, mine, sp = 0u;
    for (;;) {
        sum = 0u; cnt = 0u; mine = 0u;
#pragma unroll
        for (unsigned j = 0; j < 16; ++j) { const unsigned c = xb_ld(&bar[XB_XCNT(j)]); sum += c; cnt += (c > 0u) ? 1u : 0u; mine = (j == x) ? c : mine; }
        if (sum == G) break;
        __builtin_amdgcn_s_sleep(1);
        if ((++sp & 255u) == 0u) { if (xb_ld(&bar[XB_TMO])) break; if (sp > XB_SPIN_CAP) { atomicAdd(&bar[XB_TMO], 1u); break; } }
    }
    nloc = mine > 0u ? mine : 1u; nx = cnt > 0u ? cnt : 1u;
}

__device__ __forceinline__ void xcd_barrier(const XcdBarrier& b) {
    asm volatile("s_waitcnt vmcnt(0)" ::: "memory");
    __syncthreads();
    if (threadIdx.x == 0) {
        unsigned* bar = b.bar;
        __builtin_amdgcn_s_waitcnt(0);
        unsigned nloc = b.st[0], nx = b.st[1];
        if (nloc == 0u) { xcd_barrier_complete(bar, b.x, nloc, nx); b.st[0] = nloc; b.st[1] = nx; }
        const unsigned old = xb_add(&bar[XB_XSUB(b.x)], 1u);
        const unsigned gen = old / nloc;
        if (old + 1u == (gen + 1u) * nloc) {
            __builtin_amdgcn_fence(__ATOMIC_RELEASE, "agent");
            asm volatile("s_waitcnt vmcnt(0)" ::: "memory");
            const unsigned og = xb_add(&bar[XB_TOP], 1u);
            const unsigned tg = og / nx;
            if (og + 1u == (tg + 1u) * nx) xb_add(&bar[XB_TOPGEN], 1u);
            else XB_SPIN(xb_ld(&bar[XB_TOPGEN]) == tg, bar);
            __builtin_amdgcn_fence(__ATOMIC_ACQUIRE, "agent");
            xb_add(&bar[XB_XGEN(b.x)], 1u);
            asm volatile("s_waitcnt vmcnt(0)" ::: "memory");
        } else {
            XB_SPIN(xb_ld(&bar[XB_XGEN(b.x)]) == gen, bar);
            __builtin_amdgcn_fence(__ATOMIC_ACQUIRE, "agent");
            asm volatile("s_waitcnt vmcnt(0)" ::: "memory");
        }
    }
    __syncthreads();
}

struct Frame {
    LAS unsigned char* lds;
    unsigned char* ws;
    u16* mix;
    int tid, lane, wave;
    int vcu, G;
};
__device__ __forceinline__ float wave_sum(float v) {
#pragma unroll
    for (int o = 1; o < 64; o <<= 1) v += __shfl_xor(v, o);
    return v;
}

#ifdef PROBE_PHASE
#define SUB_BEGIN(k) const unsigned long long sb0_##k = ((k) == PROBE_PHASE) ? __builtin_amdgcn_s_memrealtime() : 0ull
#define SUB_END(k) do { if ((k) == PROBE_PHASE) { const unsigned long long t1_ = __builtin_amdgcn_s_memrealtime(), dt_ = t1_ - sb0_##k; while (__builtin_amdgcn_s_memrealtime() - t1_ < (unsigned long long)(PROBE_MULT) * dt_) __builtin_amdgcn_s_sleep(8); } } while (0)
#else
#define SUB_BEGIN(k) do {} while (0)
#define SUB_END(k) do {} while (0)
#endif
__device__ __forceinline__ void p0_tr_item(const float* W, int ldw, int scol0, int nvalid, const float* gain, u16* WT, int K, int drow0, int k0, LAS float* scr, int lane) {
    f32x4 v[8];
#pragma unroll
    for (int i = 0; i < 8; ++i) { const int kk = 8 * i + (lane >> 3), n4 = 4 * (lane & 7);
        v[i] = (n4 + 3 < nvalid) ? *(const f32x4*)(W + (size_t)(k0 + kk) * ldw + scol0 + n4) : (f32x4){0.f, 0.f, 0.f, 0.f}; }
#pragma unroll
    for (int i = 0; i < 8; ++i) { const int kk = 8 * i + (lane >> 3), n4 = 4 * (lane & 7); const float gk = gain ? gain[k0 + kk] : 1.0f;
        scr[kk * 33 + n4 + 0] = v[i][0] * gk; scr[kk * 33 + n4 + 1] = v[i][1] * gk; scr[kk * 33 + n4 + 2] = v[i][2] * gk; scr[kk * 33 + n4 + 3] = v[i][3] * gk; }
    LDS_WAIT(); asm volatile("" ::: "memory");
    const int c = lane & 7;
#pragma unroll
    for (int j = 0; j < 4; ++j) { const int n = (lane >> 3) + 8 * j; const LAS float* s = scr + (8 * c) * 33 + n;
        v4u o; o.x = cvt_pk_f16(s[0 * 33], s[1 * 33]); o.y = cvt_pk_f16(s[2 * 33], s[3 * 33]); o.z = cvt_pk_f16(s[4 * 33], s[5 * 33]); o.w = cvt_pk_f16(s[6 * 33], s[7 * 33]);
        *(v4u*)(WT + (size_t)(drow0 + n) * K + k0 + 8 * c) = o; }
    LDS_WAIT(); asm volatile("" ::: "memory");
}
__constant__ unsigned char T5_BUCKET[128] = {0, 1, 2, 3, 4, 5, 6, 7, 8, 9, 10, 11, 12, 13, 14, 15, 16, 16, 16, 17, 17, 18, 18, 18, 19, 19, 19, 20, 20, 20, 20, 21, 21, 21, 21, 22, 22, 22, 22, 22, 23, 23, 23, 23, 23, 23, 24, 24, 24, 24, 24, 24, 25, 25, 25, 25, 25, 25, 25, 26, 26, 26, 26, 26, 26, 26, 26, 27, 27, 27, 27, 27, 27, 27, 27, 27, 27, 28, 28, 28, 28, 28, 28, 28, 28, 28, 28, 29, 29, 29, 29, 29, 29, 29, 29, 29, 29, 29, 29, 30, 30, 30, 30, 30, 30, 30, 30, 30, 30, 30, 30, 30, 30, 31, 31, 31, 31, 31, 31, 31, 31, 31, 31, 31, 31, 31, 31, 31};
struct P0Args { const float *x, *g_mix, *w_in, *rel_bias, *w_out, *g_ffn, *w_gate, *w_up, *w_down; };
template <int PART> __device__ __forceinline__ void p0_prologue(Frame& F, const P0Args& A, int widx, int wg0, int nwg) {
    LAS float* scr = (LAS float*)(F.lds + RING_OFF + F.wave * 16384);
    const int gw = (widx - wg0) * NWAVES + F.wave, NGW = nwg * NWAVES;
    if (widx < wg0 || widx >= wg0 + nwg) return;
    u16* WinT = (u16*)(F.ws + WS_WIN); u16* WoutT = (u16*)(F.ws + WS_WOUT); u16* WguT = (u16*)(F.ws + WS_WGU); u16* WdT = (u16*)(F.ws + WS_WD);
    constexpr int I_IN = 16 * (N_IN / 32), I_OUT = 16 * 32, I_GU = 16 * 176, I_D = 44 * 32, NITEMS = I_IN + I_OUT + I_GU + I_D;
    SUB_BEGIN(20);
    for (int it = (PART == 0 ? gw : I_IN + gw); it < (PART == 0 ? I_IN : NITEMS); it += NGW) {
        int r = it;
        if (r < I_IN) { const int kb = r / (N_IN / 32), nb = r % (N_IN / 32), drow0 = 32 * nb; int scol0, nvalid = 32;
            if (drow0 < 2048) scol0 = drow0; else if (drow0 < 4096) scol0 = 2120 + (drow0 - 2048); else { const int off = drow0 - 4096; scol0 = 2048 + off; nvalid = 72 - off; nvalid = nvalid < 0 ? 0 : (nvalid > 32 ? 32 : nvalid); }
            p0_tr_item(A.w_in, 4168, scol0, nvalid, A.g_mix, WinT, 1024, drow0, 64 * kb, scr, F.lane); continue; }
        r -= I_IN;
        if (r < I_OUT) { const int kb = r / 32, nb = r % 32; p0_tr_item(A.w_out, 1024, 32 * nb, 32, nullptr, WoutT, 1024, 32 * nb, 64 * kb, scr, F.lane); continue; }
        r -= I_OUT;
        if (r < I_GU) { const int kb = r / 176, nb = r % 176, t = nb >> 3, w = nb & 7;
            p0_tr_item(w < 4 ? A.w_gate : A.w_up, DFF, 128 * t + 32 * (w & 3), 32, A.g_ffn, WguT, 1024, 256 * t + 32 * w, 64 * kb, scr, F.lane); continue; }
        r -= I_GU;
        { const int kb = r / 32, nb = r % 32; p0_tr_item(A.w_down, 1024, 32 * nb, 32, nullptr, WdT, DFF, 32 * nb, 64 * kb, scr, F.lane); }
    }
    SUB_END(20);
    SUB_BEGIN(21);
    if (PART == 0) {
    u16* XH = (u16*)(F.ws + WS_XH); float* rinv1 = (float*)(F.ws + WS_RINV1);
    for (int m0 = gw; m0 < MTOK; m0 += 4 * NGW) {
        f32x4 v[4][4]; float ss[4];
#pragma unroll
        for (int r = 0; r < 4; ++r) { const int m = m0 + r * NGW < MTOK ? m0 + r * NGW : m0; const f32x4* xr = (const f32x4*)(A.x + (size_t)m * DM) + F.lane;
#pragma unroll
            for (int j = 0; j < 4; ++j) v[r][j] = xr[64 * j]; }
#pragma unroll
        for (int r = 0; r < 4; ++r) { float s = 0.f;
#pragma unroll
            for (int j = 0; j < 4; ++j) s += (v[r][j][0] * v[r][j][0] + v[r][j][1] * v[r][j][1]) + (v[r][j][2] * v[r][j][2] + v[r][j][3] * v[r][j][3]);
            ss[r] = wave_sum(s); }
#pragma unroll
        for (int r = 0; r < 4; ++r) { const int m = m0 + r * NGW; if (m < MTOK) {
            if (F.lane == 0) rinv1[m] = 1.0f / sqrtf(ss[r] * (1.0f / DM) + EPS);
            v2u* o = (v2u*)(XH + (size_t)m * DM) + F.lane;
#pragma unroll
            for (int j = 0; j < 4; ++j) { v2u h; h.x = cvt_pk_f16(v[r][j][0], v[r][j][1]); h.y = cvt_pk_f16(v[r][j][2], v[r][j][3]); o[64 * j] = h; } } }
    }
    }
    SUB_END(21);
    SUB_BEGIN(22);
    if (PART == 1) {
    f32x2* CS = (f32x2*)(F.ws + WS_CS);
    for (int e = (widx - wg0) * (NWAVES * 64) + F.tid; e < SEQ * 64; e += nwg * NWAVES * 64) {
        const int pos = e >> 6, i = e & 63;
        const float theta = (float)(1.0 / exp2((double)i * (13.287712379549449 / 63.0)));
        const float ang = (float)pos * theta;
        const double rev = (double)ang * 0.15915494309189535; const double fr = rev - rint(rev);
        const double a = fr * 6.283185307179586;
        CS[e] = (f32x2){(float)cos(a), (float)sin(a)};
    }
    }
    SUB_END(22);
    if (PART == 0 && blockIdx.x == 0) { float* BT = (float*)(F.ws + WS_BIAS);
        for (int e = F.tid; e < 8 * 128; e += NWAVES * 64) { const int h = e >> 7, d = e & 127; BT[e] = (A.rel_bias[(int)T5_BUCKET[d] * 8 + h] - A.rel_bias[31 * 8 + h]) * 1.4426950408889634f; } }
}

__device__ __forceinline__ void ki_layernorm(Frame& F, const float* ln_g, const float* ln_b) {
    const float* KIR = (const float*)(F.ws + WS_KIRAW); u16* KIH = (u16*)(F.ws + WS_KIH);
    for (int e = F.vcu * (NWAVES * 64) + F.tid; e < MTOK * 4; e += F.G * NWAVES * 64) {
        const int tok = e >> 2, part = e & 3; const f32x4* src = (const f32x4*)(KIR + (size_t)tok * 64 + part * 16);
        f32x4 v[4]; float s = 0.f;
#pragma unroll
        for (int j = 0; j < 4; ++j) { v[j] = src[j]; s += (v[j][0] + v[j][1]) + (v[j][2] + v[j][3]); }
        s += __shfl_xor(s, 1); s += __shfl_xor(s, 2);
        const float mu = s * (1.0f / 64.0f); float q = 0.f;
#pragma unroll
        for (int j = 0; j < 4; ++j) { v[j] = v[j] - mu; q += (v[j][0] * v[j][0] + v[j][1] * v[j][1]) + (v[j][2] * v[j][2] + v[j][3] * v[j][3]); }
        q += __shfl_xor(q, 1); q += __shfl_xor(q, 2);
        const float rs = 1.0f / sqrtf(q * (1.0f / 64.0f) + EPS);
        v2u* dst = (v2u*)(KIH + (size_t)tok * 64 + part * 16);
#pragma unroll
        for (int j = 0; j < 4; ++j) { const f32x4 g = *(const f32x4*)(ln_g + part * 16 + 4 * j), bb = *(const f32x4*)(ln_b + part * 16 + 4 * j); const f32x4 y = v[j] * rs * g + bb;
            v2u h; h.x = cvt_pk_f16(y[0], y[1]); h.y = cvt_pk_f16(y[2], y[3]); dst[j] = h; }
    }
}

constexpr int RP = 136;
constexpr int RT_BYTES = 128 * RP * 2;
__device__ __forceinline__ float ret_log2g(int h) { return log2f(1.0f - exp2f(-5.0f - (float)h)); }
template <bool TR, bool DECAY> __device__ __forceinline__ void ret_stage_rot(Frame& F, const u16* src  , int row0, int pos0, int h, LAS _Float16* dst, float lg) {
    const f32x2* CS = (const f32x2*)(F.ws + WS_CS);
#pragma unroll
    for (int it = 0; it < 2; ++it) { const int ch = F.tid + 512 * it;
        const int j = TR ? (ch & 127) : (ch >> 3), fc = TR ? (ch >> 7) : (ch & 7);
        const u16* p = src + (size_t)(row0 + j) * 512 + h * 128 + 8 * fc;
        const v4u a = *(const v4u*)p, b = *(const v4u*)(p + 64);
        const f32x4* cs = (const f32x4*)(CS + (size_t)(pos0 + j) * 64 + 8 * fc);
        const f32x4 c0 = cs[0], c1 = cs[1], c2 = cs[2], c3 = cs[3];
        const float co[8] = {c0[0], c0[2], c1[0], c1[2], c2[0], c2[2], c3[0], c3[2]}, si[8] = {c0[1], c0[3], c1[1], c1[3], c2[1], c2[3], c3[1], c3[3]};
        const unsigned aw[4] = {a.x, a.y, a.z, a.w}, bw[4] = {b.x, b.y, b.z, b.w};
        const float sc = DECAY ? exp2f(lg * (float)(127 - j)) : 1.0f;
        float o1[8], o2[8];
#pragma unroll
        for (int i = 0; i < 8; ++i) { const float x1 = h2f((u16)(aw[i >> 1] >> (16 * (i & 1)))), x2 = h2f((u16)(bw[i >> 1] >> (16 * (i & 1))));
            o1[i] = (x1 * co[i] - x2 * si[i]) * sc; o2[i] = (x2 * co[i] + x1 * si[i]) * sc; }
        if (TR) {
#pragma unroll
            for (int i = 0; i < 8; ++i) { dst[(8 * fc + i) * RP + j] = (_Float16)o1[i]; dst[(64 + 8 * fc + i) * RP + j] = (_Float16)o2[i]; }
        } else {
            v4u w1, w2; w1.x = cvt_pk_f16(o1[0], o1[1]); w1.y = cvt_pk_f16(o1[2], o1[3]); w1.z = cvt_pk_f16(o1[4], o1[5]); w1.w = cvt_pk_f16(o1[6], o1[7]);
            w2.x = cvt_pk_f16(o2[0], o2[1]); w2.y = cvt_pk_f16(o2[2], o2[3]); w2.z = cvt_pk_f16(o2[4], o2[5]); w2.w = cvt_pk_f16(o2[6], o2[7]);
            *(LAS v4u*)(dst + j * RP + 8 * fc) = w1; *(LAS v4u*)(dst + j * RP + 64 + 8 * fc) = w2; }
    }
}
__device__ __forceinline__ void ret_stage_vt(Frame& F, const u16* src, int row0, int h, LAS _Float16* dst) {
#pragma unroll
    for (int it = 0; it < 4; ++it) { const int ch = F.tid + 512 * it, j = ch & 127, fc = ch >> 7;
        const v4u a = *(const v4u*)(src + (size_t)(row0 + j) * 512 + h * 128 + 8 * fc); const unsigned aw[4] = {a.x, a.y, a.z, a.w};
#pragma unroll
        for (int i = 0; i < 8; ++i) dst[(8 * fc + i) * RP + j] = __builtin_bit_cast(_Float16, (u16)(aw[i >> 1] >> (16 * (i & 1)))); }
}
__device__ __forceinline__ void ret_r1_unit(Frame& F, int u) {
    const int bh = u >> 6, c = u & 63, b = bh >> 2, h = bh & 3, row0 = b * SEQ + c * 128, r32 = F.lane & 31, hi = F.lane >> 5;
    LAS _Float16* KT = (LAS _Float16*)(F.lds + RING_OFF); LAS _Float16* VT = (LAS _Float16*)(F.lds + RING_OFF + RT_BYTES);
    ret_stage_rot<true, true>(F, (const u16*)(F.ws + WS_KB), row0, c * 128, h, KT, ret_log2g(h));
    ret_stage_vt(F, (const u16*)(F.ws + WS_VB), row0, h, VT);
    __syncthreads();
    const int eb = F.wave >> 1, db0 = 2 * (F.wave & 1);
    f32x16 acc0 = {}, acc1 = {};
#pragma unroll
    for (int s = 0; s < 8; ++s) {
        const f16x8 a = *(const LAS f16x8*)(VT + (32 * eb + r32) * RP + 16 * s + 8 * hi);
        const f16x8 b0 = *(const LAS f16x8*)(KT + (32 * db0 + r32) * RP + 16 * s + 8 * hi);
        const f16x8 b1 = *(const LAS f16x8*)(KT + (32 * (db0 + 1) + r32) * RP + 16 * s + 8 * hi);
        acc0 = __builtin_amdgcn_mfma_f32_32x32x16_f16(a, b0, acc0, 0, 0, 0);
        acc1 = __builtin_amdgcn_mfma_f32_32x32x16_f16(a, b1, acc1, 0, 0, 0);
    }
    float* DS = (float*)(F.ws + WS_DS) + (size_t)u * 16384;
#pragma unroll
    for (int r = 0; r < 16; ++r) { const int e = 32 * eb + crow(r, hi); DS[e * 128 + 32 * db0 + r32] = acc0[r]; DS[e * 128 + 32 * (db0 + 1) + r32] = acc1[r]; }
    __syncthreads();
}
__device__ __forceinline__ void ret_r2_scan(Frame& F) {
    const float* DS = (const float*)(F.ws + WS_DS); u16* ST = (u16*)(F.ws + WS_ST);
    for (int e = F.vcu * (NWAVES * 64) + F.tid; e < 16 * 8192; e += F.G * NWAVES * 64) {
        const int bh = e >> 13, off = (e & 8191) * 2; const float dec = exp2f(128.0f * ret_log2g(bh & 3));
        float s0 = 0.f, s1 = 0.f;
#pragma unroll 8
        for (int c = 0; c < 64; ++c) { const size_t o = ((size_t)(bh * 64 + c)) * 16384 + off;
            *(unsigned*)(ST + o) = cvt_pk_f16(s0, s1);
            const f32x2 d = *(const f32x2*)(DS + o); s0 = dec * s0 + d[0]; s1 = dec * s1 + d[1]; }
    }
}
__device__ __forceinline__ void ret_r3_unit(Frame& F, int u, const float* gn_g) {
    const int bh = u >> 6, c = u & 63, b = bh >> 2, h = bh & 3, row0 = b * SEQ + c * 128, r32 = F.lane & 31, hi = F.lane >> 5;
    LAS _Float16* Qs = (LAS _Float16*)(F.lds + RING_OFF); LAS _Float16* Ks = (LAS _Float16*)(F.lds + RING_OFF + RT_BYTES);
    LAS _Float16* VT = (LAS _Float16*)(F.lds + RING_OFF + 2 * RT_BYTES); LAS _Float16* Ps = (LAS _Float16*)(F.lds + RING_OFF + 3 * RT_BYTES);
    LAS float* rowpart = (LAS float*)(F.lds + 2048);
    const float lg = ret_log2g(h);
    const int ib = F.wave >> 1, xb0 = 2 * (F.wave & 1);
    SUB_BEGIN(30);
    ret_stage_rot<false, false>(F, (const u16*)(F.ws + WS_QB), row0, c * 128, h, Qs, lg);
    ret_stage_rot<false, false>(F, (const u16*)(F.ws + WS_KB), row0, c * 128, h, Ks, lg);
    ret_stage_vt(F, (const u16*)(F.ws + WS_VB), row0, h, VT);
    __syncthreads();
    SUB_END(30);
    SUB_BEGIN(31);
#pragma unroll
    for (int t = 0; t < 2; ++t) { const int jb = xb0 + t; f32x16 acc = {};
        if (jb <= ib) {
#pragma unroll
            for (int s = 0; s < 8; ++s) { const f16x8 a = *(const LAS f16x8*)(Qs + (32 * ib + r32) * RP + 16 * s + 8 * hi); const f16x8 bb = *(const LAS f16x8*)(Ks + (32 * jb + r32) * RP + 16 * s + 8 * hi);
                acc = __builtin_amdgcn_mfma_f32_32x32x16_f16(a, bb, acc, 0, 0, 0); } }
        const int j = 32 * jb + r32;
#pragma unroll
        for (int r = 0; r < 16; ++r) { const int i = 32 * ib + crow(r, hi); const float v = (i >= j) ? acc[r] * exp2f(lg * (float)(i - j)) : 0.f; Ps[i * RP + j] = (_Float16)v; } }
    __syncthreads();
    SUB_END(31);
    SUB_BEGIN(32);
    const u16* ST = (const u16*)(F.ws + WS_ST) + (size_t)u * 16384;
    f32x16 y[2];
#pragma unroll
    for (int t = 0; t < 2; ++t) { const int eb = xb0 + t; f32x16 intra = {}, cross = {};
#pragma unroll
        for (int s = 0; s < 8; ++s) { if (s < 2 * (ib + 1)) { const f16x8 a = *(const LAS f16x8*)(Ps + (32 * ib + r32) * RP + 16 * s + 8 * hi); const f16x8 bb = *(const LAS f16x8*)(VT + (32 * eb + r32) * RP + 16 * s + 8 * hi);
                intra = __builtin_amdgcn_mfma_f32_32x32x16_f16(a, bb, intra, 0, 0, 0); } }
#pragma unroll
        for (int s = 0; s < 8; ++s) { const f16x8 a = *(const LAS f16x8*)(Qs + (32 * ib + r32) * RP + 16 * s + 8 * hi); const f16x8 bb = *(const f16x8*)(ST + (32 * eb + r32) * 128 + 16 * s + 8 * hi);
            cross = __builtin_amdgcn_mfma_f32_32x32x16_f16(a, bb, cross, 0, 0, 0); }
#pragma unroll
        for (int r = 0; r < 16; ++r) { const int i = 32 * ib + crow(r, hi); y[t][r] = intra[r] + exp2f(lg * (float)(i + 1)) * cross[r]; } }
    SUB_END(32);
    SUB_BEGIN(33);
    float ss[16];
#pragma unroll
    for (int r = 0; r < 16; ++r) { float v = y[0][r] * y[0][r] + y[1][r] * y[1][r];
#pragma unroll
        for (int o = 1; o < 32; o <<= 1) v += __shfl_xor(v, o);
        ss[r] = v; }
    __syncthreads();
#pragma unroll
    for (int r = 0; r < 16; ++r) { const int i = 32 * ib + crow(r, hi);
#pragma unroll
        for (int t = 0; t < 2; ++t) Ps[i * RP + 32 * (xb0 + t) + r32] = (_Float16)y[t][r]; }
    if (r32 == 0) {
#pragma unroll
        for (int r = 0; r < 16; ++r) rowpart[(F.wave & 1) * 128 + 32 * ib + crow(r, hi)] = ss[r]; }
    __syncthreads();
    { const u16* GBp = (const u16*)(F.ws + WS_GB); u16* MIX = F.mix;
#pragma unroll
      for (int it = 0; it < 4; ++it) { const int ch = F.tid + 512 * it, i = ch >> 4, ec = ch & 15;
          const float rinv = 1.0f / sqrtf((rowpart[i] + rowpart[128 + i]) * (1.0f / 128.0f) + EPS);
          const v4u yv = *(const LAS v4u*)(Ps + i * RP + 8 * ec), gv = *(const v4u*)(GBp + (size_t)(row0 + i) * 512 + h * 128 + 8 * ec);
          const f32x4 g0 = *(const f32x4*)(gn_g + h * 128 + 8 * ec), g1 = *(const f32x4*)(gn_g + h * 128 + 8 * ec + 4);
          const unsigned yw[4] = {yv.x, yv.y, yv.z, yv.w}, gw[4] = {gv.x, gv.y, gv.z, gv.w}; float o[8];
#pragma unroll
          for (int k = 0; k < 8; ++k) o[k] = h2f((u16)(yw[k >> 1] >> (16 * (k & 1)))) * rinv * (k < 4 ? g0[k & 3] : g1[k & 3]) * h2f((u16)(gw[k >> 1] >> (16 * (k & 1))));
          v4u w; w.x = cvt_pk_f16(o[0], o[1]); w.y = cvt_pk_f16(o[2], o[3]); w.z = cvt_pk_f16(o[4], o[5]); w.w = cvt_pk_f16(o[6], o[7]);
          *(v4u*)(MIX + (size_t)(row0 + i) * 1024 + 512 + h * 128 + 8 * ec) = w; } }
    SUB_END(33);
    __syncthreads();
}

constexpr int IDX_CAP = 64, IDX_SEG = 28, IDX_LCAP = 16 * IDX_SEG, IDX_OVF = 64;
struct IdxSt { unsigned lo, hi, need, shift, cnt, above, ready, pad; };
__device__ __forceinline__ unsigned ok_key(float s) { const unsigned u = __builtin_bit_cast(unsigned, s); return u ^ ((unsigned)((int)u >> 31) | 0x80000000u); }

__device__ __forceinline__ void lds_add(LAS unsigned* p, unsigned v) { (void)__hip_atomic_fetch_add(p, v, __ATOMIC_RELAXED, __HIP_MEMORY_SCOPE_WORKGROUP); }
__device__ __forceinline__ unsigned lds_add_rtn(LAS unsigned* p, unsigned v) { return __hip_atomic_fetch_add(p, v, __ATOMIC_RELAXED, __HIP_MEMORY_SCOPE_WORKGROUP); }
__device__ __forceinline__ void idx_unit(Frame& F, int b, int g) {
    int lane_u = F.lane; asm volatile("" : "+v"(lane_u));
    const int lane = lane_u, wid = F.wave, l15 = lane & 15, fq = lane >> 4, set = wid >> 2, wsub = wid & 3;
    const int q0 = 32 * g, NT64 = 4 * (g >> 3) + 4, qloc = 16 * set + l15, qpos = q0 + qloc;
    unsigned* BMu = (unsigned*)(F.ws + WS_BM) + ((size_t)(b * 256 + g) * 128) * 64;
    if (g < 8) {
        const int r32 = lane & 31, hi = lane >> 5;
        for (int T = wid; T < NT64; T += 8) { unsigned w = 0u; const int lim = q0 + r32 - 64 * T - 4 * hi;
#pragma unroll 1
            for (int gi = 0; gi < 8; ++gi) { int c = lim - 8 * (gi & 3) - 32 * (gi >> 2) + 1; c = c < 0 ? 0 : (c > 4 ? 4 : c); w |= ((1u << c) - 1u) << (4 * gi); }
            BMu[T * 64 + lane] = w; }
        return;
    }
    LAS unsigned* hist = (LAS unsigned*)(F.lds + RING_OFF);
    LAS unsigned* okarr = hist;
    LAS u16* keyarr = (LAS u16*)(hist + 32 * IDX_LCAP);
#define LIDX(q_, s_, e_) (((((q_) >> 4) * 4 + ((s_) >> 2)) * IDX_SEG + (e_)) * 64 + ((q_) & 15) + 16 * ((s_) & 3))
    LAS unsigned* ovf = hist + 32 * IDX_LCAP + 16 * IDX_LCAP;
    LAS unsigned* img = ovf + 32 * IDX_OVF * 2;
    volatile LAS unsigned* segcnt = (volatile LAS unsigned*)(F.lds + 2048);
    volatile LAS IdxSt* st = (volatile LAS IdxSt*)(F.lds + 1024);
    volatile LAS unsigned* flag = (volatile LAS unsigned*)(F.lds + 512);
    const size_t row = (size_t)b * SEQ + qpos;
    const u16* QI = (const u16*)(F.ws + WS_QI) + row * 512; const float* WI = (const float*)(F.ws + WS_WI) + row * 8;
    const u16* KIb = (const u16*)(F.ws + WS_KIH) + (size_t)b * SEQ * 64;
    float ch[8];
    { const f32x4 w0 = *(const f32x4*)WI, w1 = *(const f32x4*)(WI + 4);
      const float ssq_ = ((w0[0] * w0[0] + w0[1] * w0[1]) + (w0[2] * w0[2] + w0[3] * w0[3])) + ((w1[0] * w1[0] + w1[1] * w1[1]) + (w1[2] * w1[2] + w1[3] * w1[3]));
      const float fac_ = 0.0625f * 90.5f / sqrtf(ssq_ > 1e-30f ? ssq_ : 1e-30f);
      for (int j = 0; j < 4; ++j) { ch[j] = w0[j] * fac_; ch[4 + j] = w1[j] * fac_; } }
    f16x8 qf[8][2], qt[2];
#pragma unroll
    for (int h = 0; h < 8; ++h)
#pragma unroll
        for (int s = 0; s < 2; ++s) qf[h][s] = *(const f16x8*)(QI + h * 64 + 32 * s + 8 * fq);
#pragma unroll
    for (int s = 0; s < 2; ++s) {
#pragma unroll
        for (int i = 0; i < 8; ++i) { float a = 0.f;
#pragma unroll
            for (int h = 0; h < 8; ++h) a += ch[h] * (float)qf[h][s][i];
            qt[s][i] = (_Float16)a; } }
    const int nT = (g >> 1) + 1;
#define IDX_TILE(k0_, k1_, sc) do { \
        sc = __builtin_amdgcn_mfma_f32_16x16x32_f16(k0_, qt[0], (f32x4){0.f, 0.f, 0.f, 0.f}, 0, 0, 0); sc = __builtin_amdgcn_mfma_f32_16x16x32_f16(k1_, qt[1], sc, 0, 0, 0); \
        _Pragma("unroll") for (int h = 0; h < 8; ++h) { f32x4 dh_ = __builtin_amdgcn_mfma_f32_16x16x32_f16(k0_, qf[h][0], (f32x4){0.f, 0.f, 0.f, 0.f}, 0, 0, 0); dh_ = __builtin_amdgcn_mfma_f32_16x16x32_f16(k1_, qf[h][1], dh_, 0, 0, 0); \
            _Pragma("unroll") for (int i = 0; i < 4; ++i) sc[i] = __builtin_fmaf(__builtin_fabsf(dh_[i]), ch[h], sc[i]); } } while (0)
#define IDX_TILE_NS(k0_, k1_, sc) do {   \
        sc = __builtin_amdgcn_mfma_f32_16x16x32_f16(k0_, qt[0], (f32x4){0.f, 0.f, 0.f, 0.f}, 0, 0, 0); sc = __builtin_amdgcn_mfma_f32_16x16x32_f16(k1_, qt[1], sc, 0, 0, 0); \
        _Pragma("unroll") for (int h = 0; h < 8; ++h) { f32x4 dh_ = __builtin_amdgcn_mfma_f32_16x16x32_f16(k0_, qf[h][0], (f32x4){0.f, 0.f, 0.f, 0.f}, 0, 0, 0); dh_ = __builtin_amdgcn_mfma_f32_16x16x32_f16(k1_, qf[h][1], dh_, 0, 0, 0); \
            _Pragma("unroll") for (int i = 0; i < 4; ++i) { float a_ = __builtin_fmaf(__builtin_fabsf(dh_[i]), ch[h], sc[i]); if (i) asm("" : "+v"(a_)); sc[i] = a_; } } } while (0)
#define IDX_KTILE(dst, T, m) do { const u16* kp_ = KIb + (size_t)(64 * (T) + 16 * (m) + l15_) * 64 + 8 * fq_; dst[0] = *(const f16x8*)kp_; dst[1] = *(const f16x8*)(kp_ + 32); } while (0)

    const int floorb = 0;
#pragma unroll 1
    for (int attempt = (g >= 16) ? 0 : 1; attempt < 2; ++attempt) {
        const bool sampled = (attempt == 0);
        for (int i = F.tid; i < 8192; i += NWAVES * 64) ((LAS v4u*)hist)[i] = (v4u){0u, 0u, 0u, 0u};
        if (F.tid < 32) { st[F.tid].lo = 0u; st[F.tid].hi = 0xFFFFFFFFu; st[F.tid].need = 256u; st[F.tid].shift = 0u; st[F.tid].cnt = 0u; st[F.tid].above = 0u; st[F.tid].ready = 0u; st[F.tid].pad = 0u; }
        if (F.tid < 2) flag[F.tid] = 0u;
        __syncthreads();
        for (int level = 0; level < 8; ++level) {
            int l15_ = l15, fq_ = fq; asm volatile("" : "+v"(l15_), "+v"(fq_)); const int qloc_ = 16 * set + l15_; LAS unsigned* hq = hist + qloc_ * 1024;
            const unsigned rdy = st[qloc_].ready, lo = rdy ? 1u : st[qloc_].lo, width = rdy ? 0u : st[qloc_].hi - lo, sh = st[qloc_].shift;
            LDS_WAIT();
            const int Tstep = sampled ? 16 : 4, fl_ = sampled ? 0 : floorb;
            f16x8 kc[4][2];
#pragma unroll
            for (int m = 0; m < 4; ++m) IDX_KTILE(kc[m], wsub < nT ? wsub : 0, m);
            if (level == 0) {
                for (int T = wsub; T < nT; T += Tstep) { const int Tn = T + Tstep < nT ? T + Tstep : T;
#pragma unroll
                    for (int m = 0; m < 4; ++m) { const int kt = 64 * T + 16 * m;
                        f32x4 sc; IDX_TILE(kc[m][0], kc[m][1], sc);
                        IDX_KTILE(kc[m], Tn, m);
                        const int lim = qpos - kt - 4 * fq_;
#pragma unroll
                        for (int i = 0; i < 4; ++i) { int bin = (int)__builtin_floorf(sc[i]) + 512; bin = bin < 0 ? 0 : (bin > 1023 ? 1023 : bin);
                            if ((bin >= fl_) & (i <= lim)) lds_add(hq + bin, 1u); } } }
            } else {
                for (int T = wsub; T < nT; T += 4) { const int Tn = T + 4 < nT ? T + 4 : T;
#pragma unroll
                    for (int m = 0; m < 4; ++m) { const int kt = 64 * T + 16 * m;
                        f32x4 sc; IDX_TILE(kc[m][0], kc[m][1], sc);
                        IDX_KTILE(kc[m], Tn, m);
                        const int lim = qpos - kt - 4 * fq_;
#pragma unroll
                        for (int i = 0; i < 4; ++i) { const unsigned d = ok_key(sc[i]) - lo; unsigned bin = d >> sh; bin = bin > 1023u ? 1023u : bin;
                            if ((d <= width) & (i <= lim)) lds_add(hq + bin, 1u); } } }
            }
            __syncthreads();
#pragma unroll 1
            for (int qq = 0; qq < 4; ++qq) { const int q = 4 * wid + qq; if (st[q].ready) continue;
                int ln = lane; asm volatile("" : "+v"(ln));
                LAS unsigned* hw = hist + q * 1024 + 16 * ln; unsigned wv[16]; unsigned s_ = 0u;
#pragma unroll
                for (int i = 0; i < 16; ++i) { wv[i] = hw[i]; s_ += wv[i]; }
                unsigned suf = s_;
#pragma unroll
                for (int o = 1; o < 64; o <<= 1) { const unsigned t = __shfl_down(suf, o); if (ln + o < 64) suf += t; }
                const unsigned total = __shfl(suf, 0), aboveL = suf - s_;
                const unsigned qlo = st[q].lo, qhi = st[q].hi, qsh = st[q].shift, qneed = st[q].need;
                if (sampled) {
                    const int p_ = q0 + q, tm_ = p_ >> 6; const int ns_ = 64 * (4 * (tm_ >> 4) + ((tm_ & 15) < 4 ? (tm_ & 15) : 4)) + (((tm_ & 15) < 4) ? (p_ & 63) + 1 : 0);
                    const float f_ = (float)ns_ / (float)(p_ + 1), mean_ = 256.0f * f_, sd_ = sqrtf(256.0f * f_ * (1.0f - f_));
                    const int rhi_ = (int)(mean_ - 4.0f * sd_), rlo_ = (int)(mean_ + 4.0f * sd_) + 1; const unsigned thi_ = rhi_ < 1 ? 1u : (unsigned)rhi_, tlo_ = (unsigned)rlo_;
                    if (total < tlo_) { if (ln == 0) flag[1] = 1u; }
                    else {
#pragma unroll 1
                        for (int which = 0; which < 2; ++which) { const unsigned tgt = which ? tlo_ : thi_;
                            if (aboveL < tgt && tgt <= aboveL + s_) { unsigned accu = aboveL, bin = 0u; bool found = false;
#pragma unroll
                                for (int i = 15; i >= 0; --i) { if (!found && accu + wv[i] >= tgt) { found = true; bin = 16u * (unsigned)ln + i; } if (!found) accu += wv[i]; }
                                if (which) st[q].lo = ok_key((float)((int)bin - 512)); else st[q].hi = (bin == 1023u) ? 0xFFFFFFFFu : ok_key((float)((int)bin - 511)) - 1u; } }
                    }
                    if (ln == 0) st[q].ready = 1u;
                } else if (qneed > total) {
                    if (ln == 0) { if (level == 0) { st[q].hi = ok_key((float)(floorb - 512)) - 1u; st[q].lo = 0u; } else { st[q].hi = qlo - 1u; st[q].lo = 0u; } st[q].need = qneed - total; } }
                else if (aboveL < qneed && qneed <= aboveL + s_) {
                    unsigned accu = aboveL, bin = 0u, cbin = 0u; bool found = false;
#pragma unroll
                    for (int i = 15; i >= 0; --i) { if (!found && accu + wv[i] >= qneed) { found = true; bin = 16u * (unsigned)ln + i; cbin = wv[i]; } if (!found) accu += wv[i]; }
                    unsigned nlo, nhi;
                    if (level == 0) { nlo = (bin == 0u) ? 0u : ok_key((float)((int)bin - 512)); nhi = (bin == 1023u) ? 0xFFFFFFFFu : ok_key((float)((int)bin - 511)) - 1u; }
                    else { nlo = qlo + (bin << qsh); nhi = nlo + ((1u << qsh) - 1u); if (nhi < nlo || nhi > qhi || bin == 1023u) nhi = qhi; }
                    st[q].lo = nlo; st[q].hi = nhi; st[q].need = qneed - accu;
                    if (cbin <= (unsigned)IDX_CAP || (level > 0 && qsh == 0u)) st[q].ready = 1u; }
                LDS_WAIT();
                if (!st[q].ready) { const unsigned w_ = st[q].hi - st[q].lo; const unsigned nb = 32u - (unsigned)__builtin_clz(w_ | 1u); if (ln == 0) { st[q].shift = nb > 10u ? nb - 10u : 0u; flag[0] = 1u; } }
#pragma unroll
                for (int i = 0; i < 16; ++i) hw[i] = 0u;
            }
            __syncthreads();
            const unsigned again = flag[0];
            __syncthreads();
            if (F.tid == 0) flag[0] = 0u;
            if (!again) break;
        }
        { const unsigned fail_ = flag[1]; __syncthreads(); if (sampled && fail_) continue; }
        {
            int l15_ = l15, fq_ = fq; asm volatile("" : "+v"(l15_), "+v"(fq_)); const int qloc_ = 16 * set + l15_;
            const unsigned lo = st[qloc_].lo, hiK = st[qloc_].hi, width = hiK - lo;
            LDS_WAIT();
            float flo = __builtin_bit_cast(float, (lo & 0x80000000u) ? (lo ^ 0x80000000u) : ~lo), fhi = __builtin_bit_cast(float, (hiK & 0x80000000u) ? (hiK ^ 0x80000000u) : ~hiK);
            if (!(flo == flo)) flo = -INFINITY; if (!(fhi == fhi)) fhi = INFINITY;
            const int seg_ = wsub * 4 + fq_; LAS unsigned* okl = okarr + LIDX(qloc_, seg_, 0); LAS u16* keyl = keyarr + LIDX(qloc_, seg_, 0);
            unsigned nabove = 0u, mycnt = 0u;
            f16x8 kc[4][2];
#pragma unroll
            for (int m = 0; m < 4; ++m) IDX_KTILE(kc[m], wsub < nT ? wsub : 0, m);
            for (int T = wsub; T < NT64; T += 4) { unsigned part = 0u;
                if (T < nT) { const int Tn = T + 4 < nT ? T + 4 : T; const bool diag = (64 * T + 63 > q0);
#pragma unroll
                    for (int m = 0; m < 4; ++m) { const int kt = 64 * T + 16 * m;
                        f32x4 sc; IDX_TILE_NS(kc[m][0], kc[m][1], sc);
                        IDX_KTILE(kc[m], Tn, m);
                        if (diag) { const int lim = qpos - kt - 4 * fq_;
#pragma unroll
                            for (int i = 0; i < 4; ++i) sc[i] = (i <= lim) ? sc[i] : __builtin_nanf(""); }
                        const unsigned kb = (unsigned)(kt + 4 * fq_);
                        if (__builtin_amdgcn_ballot_w64(mycnt > (unsigned)(IDX_SEG - 4)) != 0ull) {
#pragma unroll
                            for (int i = 0; i < 4; ++i) { const bool sure = sc[i] > fhi;
                                part |= sure ? (1u << (16 * (m >> 1) + 8 * (m & 1) + i)) : 0u;
                                if ((sc[i] >= flo) & !sure) { if (mycnt < (unsigned)IDX_SEG) { okl[64u * mycnt] = ok_key(sc[i]); keyl[64u * mycnt] = (u16)(kb + i); }
                                    else { const unsigned pos = lds_add_rtn((LAS unsigned*)&st[qloc_].pad, 1u); if (pos < (unsigned)IDX_OVF) { ovf[(qloc_ * IDX_OVF + pos) * 2] = ok_key(sc[i]); ovf[(qloc_ * IDX_OVF + pos) * 2 + 1] = kb + i; } }
                                    mycnt += 1u; } }
                        } else {
#pragma unroll
                            for (int i = 0; i < 4; ++i) { const bool sure = sc[i] > fhi;
                                part |= sure ? (1u << (16 * (m >> 1) + 8 * (m & 1) + i)) : 0u;
                                okl[64u * mycnt] = ok_key(sc[i]); keyl[64u * mycnt] = (u16)(kb + i);
                                mycnt += ((sc[i] >= flo) & !sure) ? 1u : 0u; } }
                    }
                    nabove += (unsigned)__builtin_popcount(part);
                }
                part <<= 4 * (fq_ >> 1);
                const unsigned word = part | (unsigned)__shfl_xor((int)part, 32);
                if (fq_ < 2) img[T * 64 + qloc_ + 32 * (fq_ & 1)] = word; }
            lds_add((LAS unsigned*)&st[qloc_].above, nabove); lds_add((LAS unsigned*)&st[qloc_].cnt, mycnt);
            segcnt[qloc_ * 16 + seg_] = mycnt < (unsigned)IDX_SEG ? mycnt : (unsigned)IDX_SEG;
        }
        __syncthreads();
        if (sampled) {
            if (F.tid < 32) { const unsigned a = st[F.tid].above, c = st[F.tid].cnt; if (!(a < 256u && a + c >= 256u && st[F.tid].pad <= (unsigned)IDX_OVF)) flag[1] = 1u; else st[F.tid].need = 256u - a; }
            __syncthreads();
            const unsigned fail_ = flag[1]; __syncthreads();
            if (fail_) continue;
        }
#pragma unroll 1
        for (int qq = 0; qq < 4; ++qq) { int ln = lane; asm volatile("" : "+v"(ln)); const int q = 4 * wid + qq;
            const unsigned need = st[q].need;
            const LAS unsigned* lw = okarr; const LAS u16* lk = keyarr;
            const LAS unsigned* lo_ = ovf + q * IDX_OVF * 2; const unsigned novf = st[q].pad < (unsigned)IDX_OVF ? st[q].pad : (unsigned)IDX_OVF;
            unsigned ek[8];
#pragma unroll
            for (int k = 0; k < 7; ++k) { const unsigned j = (unsigned)ln + 64u * k; ek[k] = ((j % IDX_SEG) < segcnt[q * 16 + (j / IDX_SEG)]) ? lw[LIDX(q, j / IDX_SEG, j % IDX_SEG)] : 0u; }
            ek[7] = ((unsigned)ln < novf) ? lo_[2 * ln] : 0u;
            const unsigned rlo_ = st[q].lo, rhi_ = st[q].hi; const int topbit = 31 - (int)__builtin_clz((rlo_ ^ rhi_) | 1u);
            unsigned Tv = (topbit >= 31) ? 0u : (rlo_ & ~((2u << topbit) - 1u));
#pragma unroll 1
            for (int bit = topbit; bit >= 0; --bit) { const unsigned cand = Tv | (1u << bit); unsigned c = 0u;
#pragma unroll
                for (int k = 0; k < 8; ++k) c += (unsigned)__popcll(__ballot(ek[k] >= cand));
                if (c >= need) Tv = cand; }
            unsigned cgt = 0u, ceq = 0u;
#pragma unroll
            for (int k = 0; k < 8; ++k) { cgt += (unsigned)__popcll(__ballot(ek[k] > Tv)); ceq += (unsigned)__popcll(__ballot(ek[k] == Tv && ek[k] != 0u)); }
            const unsigned need_eq = need > cgt ? need - cgt : 0u;
#pragma unroll
            for (int k = 0; k < 8; ++k) { bool sel = ek[k] > Tv; const unsigned myj = (unsigned)ln + 64u * k;
                const unsigned mykey = (k < 7) ? (unsigned)lk[myj < (unsigned)IDX_LCAP ? LIDX(q, myj / IDX_SEG, myj % IDX_SEG) : 0u] : lo_[2 * ln + 1];
                if (ek[k] == Tv && ek[k] != 0u) { if (need_eq >= ceq) sel = true; else { unsigned rk = 0u;
                        for (unsigned j = 0; j < (unsigned)IDX_LCAP; ++j) rk += ((j % IDX_SEG) < segcnt[q * 16 + (j / IDX_SEG)] && lw[LIDX(q, j / IDX_SEG, j % IDX_SEG)] == Tv && lk[LIDX(q, j / IDX_SEG, j % IDX_SEG)] < mykey) ? 1u : 0u;
                        for (unsigned j = 0; j < novf; ++j) rk += (lo_[2 * j] == Tv && lo_[2 * j + 1] < mykey) ? 1u : 0u; sel = rk < need_eq; } }
                if (sel) { const unsigned ki = mykey, T = ki >> 6, k64 = ki & 63u, half = k64 >> 5, k32 = k64 & 31u, khi = (k32 >> 2) & 1u, r = (k32 & 3u) + 4u * (k32 >> 3);
                    (void)__hip_atomic_fetch_or(img + T * 64 + (unsigned)q + 32u * khi, 1u << (16u * half + r), __ATOMIC_RELAXED, __HIP_MEMORY_SCOPE_WORKGROUP); } }
        }
        __syncthreads();
        { int t_ = F.tid; asm volatile("" : "+v"(t_)); for (int i = t_; i < NT64 * 16; i += NWAVES * 64) ((v4u*)BMu)[i] = ((const LAS v4u*)img)[i]; }
        break;
    }
    __syncthreads();
#undef IDX_TILE
#undef LIDX
#undef IDX_TILE_NS
#undef IDX_KTILE
}

__device__ __forceinline__ void final_norm(Frame& F, float* out, const float* part, const float* gfin) {
    const int gw = F.vcu * NWAVES + F.wave, NGW = F.G * NWAVES;
    for (int m = gw; m < MTOK; m += NGW) {
        float p = (F.lane < 16) ? part[(size_t)m * 16 + F.lane] : 0.f; p = wave_sum(p);
        const float r = 1.0f / sqrtf(p * (1.0f / DM) + EPS);
        f32x4* xr = (f32x4*)(out + (size_t)m * DM) + F.lane; const f32x4* gr = (const f32x4*)gfin + F.lane;
#pragma unroll
        for (int j = 0; j < 4; ++j) { const f32x4 v = xr[64 * j] * r * gr[64 * j]; xr[64 * j] = v; }
    }
}

struct Args { const float* in[13]; float* out; unsigned char* ws; int ph_lo, ph_hi, li, pad; };
__global__ void __launch_bounds__(NWAVES * 64, 2) hymba_fwd(Args args) {
    extern __shared__ __attribute__((aligned(16))) unsigned char lds_raw[];
    Frame F;
    F.lds = (LAS unsigned char*)lds_raw; F.ws = args.ws; F.mix = (u16*)args.out;
    F.tid = threadIdx.x; F.lane = F.tid & 63; F.wave = __builtin_amdgcn_readfirstlane(F.tid >> 6);
    F.G = gridDim.x; { const int bx = blockIdx.x; F.vcu = (F.G % 8 == 0) ? (bx % 8) * (F.G / 8) + bx / 8 : bx; }
    for (int u = F.tid; u < LCTL_BYTES / 4; u += NWAVES * 64) ((LAS unsigned*)F.lds)[u] = 0u;
    __syncthreads();
    gu32* ctl = (gu32*)(args.ws + WS_CTL);
    XcdBarrier bar; bar.bar = (unsigned*)(ctl + CW_BAR) + args.li * XCD_BAR_WORDS; bar.x = 0; bar.st = nullptr;
    if (N_LAUNCHES != N_PHASES) bar = xcd_barrier_post((unsigned*)(ctl + CW_BAR) + args.li * XCD_BAR_WORDS, (volatile LAS unsigned*)(F.lds + 64));
#define GRID_BAR() do { if (N_LAUNCHES != N_PHASES) xcd_barrier(bar); } while (0)
    const int lo = args.ph_lo, hi = args.ph_hi;
#ifndef PHASE_MASK
#define PHASE_MASK 0x1ff
#endif
#define IN(k) (((PHASE_MASK >> (k)) & 1) && lo <= (k) && (k) < hi)
#define BOTH(k) (IN(k) && IN((k) + 1))
#define PH_TID() do { int t_ = threadIdx.x; asm volatile("" : "+v"(t_)); F.tid = t_; F.lane = t_ & 63; F.wave = __builtin_amdgcn_readfirstlane(t_ >> 6); } while (0)
#ifdef PROBE_PHASE
#define PH_BEGIN(k) const unsigned long long t0_##k = ((k) == PROBE_PHASE) ? __builtin_amdgcn_s_memrealtime() : 0ull
#define PH_END(k) do { if ((k) == PROBE_PHASE) { const unsigned long long t1_ = __builtin_amdgcn_s_memrealtime(), dt_ = t1_ - t0_##k; while (__builtin_amdgcn_s_memrealtime() - t1_ < (unsigned long long)(PROBE_MULT) * dt_) __builtin_amdgcn_s_sleep(8); } } while (0)
#else
#define PH_BEGIN(k) do {} while (0)
#define PH_END(k) do {} while (0)
#endif
    const float* x = args.in[0];
    unsigned char* ws = args.ws;
    LAS unsigned char* ring = F.lds + RING_OFF;

    if (IN(0)) { PH_TID(); PH_BEGIN(0);
        P0Args A{x, args.in[1], args.in[2], args.in[5], args.in[7], args.in[8], args.in[9], args.in[10], args.in[11]};
        p0_prologue<0>(F, A, F.vcu, 0, F.G);
        if (F.G != 256) p0_prologue<1>(F, A, F.vcu, 0, F.G);
        PH_END(0);
        if (BOTH(0)) GRID_BAR();
    }
    if (IN(1)) { PH_TID(); PH_BEGIN(1);
        pg8::Gemm g{(const u16*)(ws + WS_XH), (const u16*)(ws + WS_WIN), MTOK, N_IN, DM}; pg8::StaticOrder S; S.init(MTOK, N_IN, F.G, (int)blockIdx.x);
        pg8::EpiProj E{ws + WS_QA, (float*)(ws + WS_KIRAW), (float*)(ws + WS_WI), (const float*)(ws + WS_RINV1)};
        pg8::gemm_phase<pg8::EpiProj, pg8::StaticOrder, true, true>(ring, g, S, E);
        if (F.G == 256) { P0Args A{x, args.in[1], args.in[2], args.in[5], args.in[7], args.in[8], args.in[9], args.in[10], args.in[11]}; __syncthreads(); p0_prologue<1>(F, A, (int)blockIdx.x, 128, 128); }
        PH_END(1);
        if (BOTH(1)) GRID_BAR();
    }
    if (IN(2)) { PH_TID(); PH_BEGIN(2);
        ki_layernorm(F, args.in[3], args.in[4]);
        for (int u = F.vcu; u < 1024; u += F.G) ret_r1_unit(F, u);
        PH_END(2);
        if (BOTH(2)) GRID_BAR();
    }
    if (IN(3)) { PH_TID(); PH_BEGIN(3);
        { PH_BEGIN(9); ret_r2_scan(F); PH_END(9); }
        PH_BEGIN(10);
        { const bool deal = (F.G == 256); const int bb = F.vcu >> 6, s = F.vcu & 63, nun = deal ? 4 : (1024 - F.vcu + F.G - 1) / F.G;
          _Pragma("unroll 1") for (int i = 0; i < nun; ++i) { int ub, ug; if (deal) { ub = bb; ug = (i == 0) ? 255 - s : (i == 1) ? 128 + s : (i == 2) ? 127 - s : s; } else { const int u = F.vcu + i * F.G; ub = u >> 8; ug = u & 255; }
              idx_unit(F, ub, ug); } }
        PH_END(10);
        PH_END(3);
        if (BOTH(3)) GRID_BAR();
    }
    if (IN(4)) { PH_TID(); PH_BEGIN(4);
        { PH_BEGIN(11); for (int u = F.vcu; u < 1024; u += F.G) ret_r3_unit(F, u, args.in[6]); PH_END(11); }
        PH_BEGIN(12);
        const attn_body::AttnTensors AT{(const attn_body::bf16*)(ws + WS_QA), (const attn_body::bf16*)(ws + WS_KA), (const attn_body::bf16*)(ws + WS_VA), F.mix, (const unsigned*)(ws + WS_BM), (const float*)(ws + WS_BIAS)};
        if (F.G == 256) { const attn_body::StaticOrder S((int)F.G, (int)blockIdx.x); attn_body::attn_phase<attn_body::StaticOrder>((char*)lds_raw + RING_OFF, AT, S); }
        else { const attn_body::StridedOrder S((int)F.G, (int)blockIdx.x); attn_body::attn_phase<attn_body::StridedOrder>((char*)lds_raw + RING_OFF, AT, S); }
        PH_END(12);
        PH_END(4);
        if (BOTH(4)) GRID_BAR();
    }
    if (IN(5)) { PH_TID(); PH_BEGIN(5);
        pg8::Gemm g{(const u16*)F.mix, (const u16*)(ws + WS_WOUT), MTOK, DM, DM}; pg8::StaticOrder S; S.init(MTOK, DM, F.G, (int)blockIdx.x);
        pg8::EpiX2 E{(const u16*)(ws + WS_XH), (u16*)(ws + WS_X2H), (float*)(ws + WS_PART2)};
        pg8::gemm_phase<pg8::EpiX2, pg8::StaticOrder, true, true>(ring, g, S, E);
        PH_END(5);
        if (BOTH(5)) GRID_BAR();
    }
    if (IN(6)) { PH_TID(); PH_BEGIN(6);
        pg8::Gemm g{(const u16*)(ws + WS_X2H), (const u16*)(ws + WS_WGU), MTOK, 2 * DFF, DM}; pg8::StaticOrder S; S.init(MTOK, 2 * DFF, F.G, (int)blockIdx.x);
        pg8::EpiGU E{(u16*)(ws + WS_U), (const float*)(ws + WS_PART2)};
        pg8::gemm_phase<pg8::EpiGU, pg8::StaticOrder, true, true>(ring, g, S, E);
        PH_END(6);
        if (BOTH(6)) GRID_BAR();
    }
    if (IN(7)) { PH_TID(); PH_BEGIN(7);
        pg8::Gemm g{(const u16*)(ws + WS_U), (const u16*)(ws + WS_WD), MTOK, DM, DFF}; pg8::StaticOrder S; S.init(MTOK, DM, F.G, (int)blockIdx.x);
#ifdef UNFUSED_FINAL_NORM
        pg8::EpiDown E{(const u16*)(ws + WS_X2H), args.out, (float*)(ws + WS_PART3)};
        pg8::gemm_phase<pg8::EpiDown, pg8::StaticOrder, true, true>(ring, g, S, E);
        PH_END(7);
        if (BOTH(7)) GRID_BAR();
#else
        pg8::EpiDownNorm E{(const u16*)(ws + WS_X2H), args.out, (float*)(ws + WS_PART3), (unsigned*)(ctl + 16384), args.in[12]};
        pg8::gemm_phase<pg8::EpiDownNorm, pg8::StaticOrder, true, true>(ring, g, S, E);
        PH_END(7);
#endif
    }
#ifdef UNFUSED_FINAL_NORM
    if (IN(8)) { PH_TID(); PH_BEGIN(8); final_norm(F, args.out, (const float*)(ws + WS_PART3), args.in[12]); PH_END(8); }
#endif
#undef IN
#undef BOTH
#undef GRID_BAR
}


#ifdef DIAG_DETERMINISM
__global__ void k_checksum(const unsigned* p, size_t nwords, unsigned long long* slot) {
    unsigned long long s = 0; for (size_t i = (size_t)blockIdx.x * blockDim.x + threadIdx.x; i < nwords; i += (size_t)gridDim.x * blockDim.x) s += (unsigned long long)p[i] * (unsigned long long)((i & 1023u) + 1u);
    for (int o = 32; o >= 1; o >>= 1) s += __shfl_xor(s, o);
    if ((threadIdx.x & 63) == 0) atomicAdd(slot, s);
}
#ifndef DIAG_PASSES
#define DIAG_PASSES 4
#endif
__global__ void k_checksum_cols(const unsigned* p, int rows, int pitchw, int c0, int c1, unsigned long long* slot) {
    unsigned long long s = 0; const int w = c1 - c0; for (size_t i = (size_t)blockIdx.x * blockDim.x + threadIdx.x; i < (size_t)rows * w; i += (size_t)gridDim.x * blockDim.x) { const size_t r = i / w, c = c0 + i % w; s += (unsigned long long)p[r * pitchw + c] * (unsigned long long)((i & 1023u) + 1u); }
    for (int o = 32; o >= 1; o >>= 1) s += __shfl_xor(s, o);
    if ((threadIdx.x & 63) == 0) atomicAdd(slot, s);
}
__global__ void k_report(float* out, const unsigned long long* cs, const int* phase_of, int nbuf, size_t n) {
    int ph = -1; for (int i = 0; i < nbuf && ph < 0; ++i) for (int p = 1; p < DIAG_PASSES; ++p) if (cs[i] != cs[64 * p + i]) { ph = phase_of[i]; break; }
    if (ph < 0) return; const float delta = 0.1f * (float)(ph + 1);
    for (size_t i = (size_t)blockIdx.x * blockDim.x + threadIdx.x; i < n; i += (size_t)gridDim.x * blockDim.x) out[i] += delta;
}
__global__ void k_setphase(int* phase_of, unsigned long long packed_lo, unsigned long long packed_hi) { const int i = threadIdx.x; if (i < 32) phase_of[i] = (int)(((i < 16 ? packed_lo : packed_hi) >> (4 * (i & 15))) & 15ull); }
extern "C" void kernel_launch(void* const* d_in, const int* in_sizes, int n_in, void* d_out, int out_size, void* d_ws, size_t ws_size, hipStream_t stream) {
    static int grid = 0;
    if (grid == 0) { int dev = 0, cus = 0; hipGetDevice(&dev); hipDeviceGetAttribute(&cus, hipDeviceAttributeMultiprocessorCount, dev);
        if (hipFuncSetAttribute((const void*)hymba_fwd, hipFuncAttributeMaxDynamicSharedMemorySize, LDS_BYTES) != hipSuccess) { grid = -1; return; } grid = cus; }
    if (grid < 0) return;
    hipMemsetAsync((char*)d_ws + WS_CTL, 0, CTL_ZERO_BYTES, stream);
    Args a{}; for (int i = 0; i < 13; ++i) a.in[i] = (const float*)d_in[i]; a.out = (float*)d_out; a.ws = (unsigned char*)d_ws;
    unsigned char* ws = (unsigned char*)d_ws; unsigned long long* cs = (unsigned long long*)(ws + 100 * 1024);
    struct B { int ph; const void* p; size_t bytes; };
    const B bufs[] = { {0, ws + WS_XH, (size_t)MTOK * DM * 2}, {0, ws + WS_RINV1, (size_t)MTOK * 4}, {0, ws + WS_WIN, (size_t)N_IN * 1024 * 2}, {1, ws + WS_WOUT, (size_t)1024 * 1024 * 2}, {1, ws + WS_WGU, (size_t)5632 * 1024 * 2}, {1, ws + WS_WD, (size_t)1024 * DFF * 2}, {1, ws + WS_CS, (size_t)SEQ * 64 * 8}, {0, ws + WS_BIAS, (size_t)8 * 128 * 4},
        {1, ws + WS_QA, 32 * MiB}, {1, ws + WS_KA, 32 * MiB}, {1, ws + WS_VA, 32 * MiB}, {1, ws + WS_QI, 32 * MiB}, {1, ws + WS_QB, 32 * MiB}, {1, ws + WS_KB, 32 * MiB}, {1, ws + WS_VB, 32 * MiB}, {1, ws + WS_GB, 32 * MiB}, {1, ws + WS_KIRAW, 8 * MiB}, {1, ws + WS_WI, 1 * MiB},
        {2, ws + WS_KIH, 4 * MiB}, {2, ws + WS_DS, 64 * MiB}, {3, ws + WS_ST, 32 * MiB}, {3, ws + WS_BM, 32 * MiB}, {4, d_out, 1}, {9, d_out, 2},
        {5, ws + WS_X2H, 64 * MiB}, {5, ws + WS_PART2, 2 * MiB}, {6, ws + WS_U, (size_t)MTOK * DFF * 2}, {7, d_out, 128 * MiB}, {7, ws + WS_PART3, 2 * MiB} };
    const int nbuf = (int)(sizeof(bufs) / sizeof(bufs[0]));
    for (int pass = 0; pass < DIAG_PASSES; ++pass)
        for (int li = 0; li < N_PHASES; ++li) {
            a.ph_lo = li; a.ph_hi = li + 1; a.li = 0; a.pad = 0;
            hipLaunchKernelGGL(hymba_fwd, dim3(grid), dim3(NWAVES * 64), LDS_BYTES, stream, a);
            for (int k = 0; k < nbuf; ++k) { if (bufs[k].bytes <= 2) { if (li == 4) hipLaunchKernelGGL(k_checksum_cols, dim3(1024), dim3(256), 0, stream, (const unsigned*)bufs[k].p, MTOK, 512, bufs[k].bytes == 1 ? 0 : 256, bufs[k].bytes == 1 ? 256 : 512, cs + pass * 64 + k); }
                else if (bufs[k].ph == li) hipLaunchKernelGGL(k_checksum, dim3(1024), dim3(256), 0, stream, (const unsigned*)bufs[k].p, bufs[k].bytes / 4, cs + pass * 64 + k); }
        }
    unsigned long long plo = 0, phi = 0; for (int k = 0; k < nbuf; ++k) { if (k < 16) plo |= (unsigned long long)bufs[k].ph << (4 * k); else phi |= (unsigned long long)bufs[k].ph << (4 * (k - 16)); }
    int* phase_of = (int*)(ws + 104 * 1024);
    hipLaunchKernelGGL(k_setphase, dim3(1), dim3(64), 0, stream, phase_of, plo, phi);
    hipLaunchKernelGGL(k_report, dim3(1024), dim3(256), 0, stream, (float*)d_out, (const unsigned long long*)cs, (const int*)phase_of, nbuf, (size_t)MTOK * DM);
}
#else
extern "C" void kernel_launch(void* const* d_in, const int* in_sizes, int n_in, void* d_out, int out_size, void* d_ws, size_t ws_size, hipStream_t stream) {
    static int grid = 0;
    if (grid == 0) {
        if (n_in != 13 || in_sizes[0] != MTOK * DM || out_size != MTOK * DM || ws_size < WS_END) { fprintf(stderr, "kernel_launch: unexpected shapes / workspace (%d inputs, ws %zu)\n", n_in, ws_size); grid = -1; return; }
        int dev = 0, cus = 0, per_cu = 0;
        if (hipGetDevice(&dev) != hipSuccess || hipDeviceGetAttribute(&cus, hipDeviceAttributeMultiprocessorCount, dev) != hipSuccess) { grid = -1; return; }
        if (hipFuncSetAttribute((const void*)hymba_fwd, hipFuncAttributeMaxDynamicSharedMemorySize, LDS_BYTES) != hipSuccess) { fprintf(stderr, "kernel_launch: hipFuncSetAttribute failed\n"); grid = -1; return; }
        if (hipOccupancyMaxActiveBlocksPerMultiprocessor(&per_cu, (const void*)hymba_fwd, NWAVES * 64, LDS_BYTES) != hipSuccess || per_cu < 1) { fprintf(stderr, "kernel_launch: occupancy query reports %d workgroups per CU\n", per_cu); }
        (void)hipGetLastError();
        grid = cus;
    }
    if (grid < 0) return;
    if (hipMemsetAsync((char*)d_ws + WS_CTL, 0, CTL_ZERO_BYTES, stream) != hipSuccess) return;
    Args a{};
    for (int i = 0; i < 13; ++i) a.in[i] = (const float*)d_in[i];
    a.out = (float*)d_out; a.ws = (unsigned char*)d_ws;
    for (int li = 0; li < N_LAUNCHES; ++li) {
        a.ph_lo = (N_LAUNCHES == N_PHASES) ? li : 0; a.ph_hi = (N_LAUNCHES == N_PHASES) ? li + 1 : N_PHASES; a.li = (N_LAUNCHES == N_PHASES) ? 0 : li; a.pad = 0;
        hipLaunchKernelGGL(hymba_fwd, dim3(grid), dim3(NWAVES * 64), LDS_BYTES, stream, a);
    }
}
#endif
```

```cpp
#include <hip/hip_runtime.h>
#include <hip/hip_bf16.h>
#include <cstdio>
#include <cstdint>
#include <cmath>

#define GAS __attribute__((address_space(1)))
#define LAS __attribute__((address_space(3)))
typedef unsigned short u16;
typedef _Float16 f16x8 __attribute__((ext_vector_type(8)));
typedef _Float16 f16x2 __attribute__((ext_vector_type(2)));
typedef float f32x2 __attribute__((ext_vector_type(2)));
typedef float f32x4 __attribute__((ext_vector_type(4)));
typedef float f32x16 __attribute__((ext_vector_type(16)));
typedef unsigned v4u __attribute__((ext_vector_type(4)));
typedef unsigned v2u __attribute__((ext_vector_type(2)));
typedef GAS unsigned gu32;
#define RLX_AGENT __ATOMIC_RELAXED, __HIP_MEMORY_SCOPE_AGENT
#define LDS_WAIT() asm volatile("s_waitcnt lgkmcnt(0)" ::: "memory")
#define VM_WAIT() asm volatile("s_waitcnt vmcnt(0)" ::: "memory")

__device__ __forceinline__ unsigned cvt_pk_f16(float lo, float hi) { f32x2 v = {lo, hi}; f16x2 h = __builtin_convertvector(v, f16x2); return __builtin_bit_cast(unsigned, h); }
__device__ __forceinline__ unsigned cvt_pk_bf16(float lo, float hi) { unsigned r; asm volatile("v_cvt_pk_bf16_f32 %0, %1, %2" : "=v"(r) : "v"(lo), "v"(hi)); return r; }
__device__ __forceinline__ float h2f(u16 h) { return (float)__builtin_bit_cast(_Float16, h); }
__device__ __forceinline__ float silu_f(float x) { return x * __builtin_amdgcn_rcpf(1.0f + __builtin_amdgcn_exp2f(-1.4426950408889634f * x)); }
__device__ __forceinline__ int crow(int r, int hi) { return (r & 3) + 8 * (r >> 2) + 4 * hi; }

constexpr int BATCH = 4, SEQ = 8192, DM = 1024, MTOK = BATCH * SEQ;
constexpr int NHA = 8, DHA = 64, NHB = 4, DHB = 128, DFF = 2816;
constexpr int N_IN = 4352;
constexpr float EPS = 1e-6f;
constexpr float C2 = 0.125f * 1.4426950408889634f;

namespace pg8 {
#define PG8_LAS __attribute__((address_space(3)))
constexpr int BM = 256, BK = 64, HALF = 128, HTB = HALF * BK * 2, STAGE_BYTES = 8 * HTB, NXCD = 8, WGM = 8;
__host__ __device__ __forceinline__ int lds_byte(int r, int c) { const int st = (r >> 4) * 2 + (c >> 5), rr = r & 15, cc = c & 31, ob = rr * 64 + cc * 2; return st * 1024 + (ob ^ (((ob >> 9) & 1) << 5)); }
__host__ __device__ __forceinline__ void stage_rc(int b, int& R, int& C) { const int st = b / 1024, sb = b % 1024, swz = sb ^ (((sb >> 9) & 1) << 5); R = (st >> 1) * 16 + swz / 64; C = (st & 1) * 32 + (swz % 64) / 2; }
__host__ __device__ __forceinline__ int perm32(int rho) { const int n = rho >> 4, i = rho & 15; return 8 * (i >> 2) + 4 * n + (i & 3); }
struct Unit { int pm, pn; };
struct Gemm { const u16* A; const u16* Bt; int M, N, K; };
struct StaticOrder {
    int nM, nN, nwg, G, c;
    __host__ __device__ void init(int M, int N, int G_, int c_) { nM = M / BM; nN = N / BM; nwg = nM * nN; G = G_; c = c_; }
    __host__ __device__ bool next(int i, Unit& u) const {
        const long L = (long)i * G + c; if (L >= nwg) return false;
        int wgid = (int)L; { const int q = nwg / NXCD, r = nwg % NXCD, xcd = wgid % NXCD, off = wgid / NXCD; wgid = (xcd < r ? xcd * (q + 1) : r * (q + 1) + (xcd - r) * q) + off; }
        const int nig = WGM * nN, gid = wgid / nig, fm = gid * WGM, gsz = (nM - fm) < WGM ? (nM - fm) : WGM;
        u.pm = fm + ((wgid % nig) % gsz); u.pn = (wgid % nig) / gsz; return true;
    }
    __device__ __forceinline__ void a_ready(const Unit&) const {}
    __device__ __forceinline__ void done(const Unit&) const {}
};

struct EpiProj {
    static constexpr int PROBE_ID = 40;
    static constexpr bool PERM = true, AFTER_DRAIN = false;
    unsigned char* tbase; float* kiraw; float* wi; const float* rinv;
    __device__ __forceinline__ void operator()(const f32x4 (&acc)[2][2][4][2], const Unit& u, int wr, int wc, int fr, int fq) const {
        const int row0 = u.pm * BM + wr * 64 + fr; const int pn = u.pn;
        float rr[2][4];
#pragma unroll
        for (int ai = 0; ai < 2; ++ai)
#pragma unroll
            for (int m = 0; m < 4; ++m) rr[ai][m] = rinv[row0 + ai * HALF + m * 16];
        if (pn < 16) {
            const int tsel = pn >> 1; u16* T = (u16*)(tbase + (size_t)tsel * (32u << 20));
            const int colt = (pn & 1) * 256 + wc * 32 + 8 * fq;
            const float sc = (tsel == 0) ? C2 : ((tsel == 5) ? 0.08838834764831845f : 1.0f);
#pragma unroll
            for (int ai = 0; ai < 2; ++ai)
#pragma unroll
                for (int m = 0; m < 4; ++m) { const int row = row0 + ai * HALF + m * 16; const float r = rr[ai][m] * sc; u16* rowp = T + (size_t)row * 512 + colt;
#pragma unroll
                    for (int bj = 0; bj < 2; ++bj) { f32x4 v0 = acc[ai][bj][m][0] * r, v1 = acc[ai][bj][m][1] * r;
                        if (tsel == 7) {
#pragma unroll
                            for (int j = 0; j < 4; ++j) { v0[j] = silu_f(v0[j]); v1[j] = silu_f(v1[j]); } }
                        v4u w;
                        if (tsel < 3) { w.x = cvt_pk_bf16(v0[0], v0[1]); w.y = cvt_pk_bf16(v0[2], v0[3]); w.z = cvt_pk_bf16(v1[0], v1[1]); w.w = cvt_pk_bf16(v1[2], v1[3]); }
                        else { w.x = cvt_pk_f16(v0[0], v0[1]); w.y = cvt_pk_f16(v0[2], v0[3]); w.z = cvt_pk_f16(v1[0], v1[1]); w.w = cvt_pk_f16(v1[2], v1[3]); }
                        *(v4u*)(rowp + bj * HALF) = w; } }
        } else {
            const int c0 = wc * 32 + 8 * fq;
#pragma unroll
            for (int ai = 0; ai < 2; ++ai)
#pragma unroll
                for (int m = 0; m < 4; ++m) { const int row = row0 + ai * HALF + m * 16; const float r = rr[ai][m];
                    if (c0 < 64) { *(f32x4*)(kiraw + (size_t)row * 64 + c0) = acc[ai][0][m][0] * r; *(f32x4*)(kiraw + (size_t)row * 64 + c0 + 4) = acc[ai][0][m][1] * r; }
                    else if (c0 == 64) { const float s = r * 0.35355339059327373f; *(f32x4*)(wi + (size_t)row * 8) = acc[ai][0][m][0] * s; *(f32x4*)(wi + (size_t)row * 8 + 4) = acc[ai][0][m][1] * s; } }
        }
    }
};
struct EpiX2 {
    static constexpr int PROBE_ID = 41;
    static constexpr bool PERM = true, AFTER_DRAIN = false;
    const u16* xh; u16* x2h; float* part;
    __device__ __forceinline__ void operator()(const f32x4 (&acc)[2][2][4][2], const Unit& u, int wr, int wc, int fr, int fq) const {
        const int row0 = u.pm * BM + wr * 64 + fr, col0 = u.pn * BM + wc * 32 + 8 * fq;
        v4u xx[2][4][2];
#pragma unroll
        for (int ai = 0; ai < 2; ++ai)
#pragma unroll
            for (int m = 0; m < 4; ++m)
#pragma unroll
                for (int bj = 0; bj < 2; ++bj) xx[ai][m][bj] = *(const v4u*)(xh + (size_t)(row0 + ai * HALF + m * 16) * DM + col0 + bj * HALF);
#pragma unroll
        for (int ai = 0; ai < 2; ++ai)
#pragma unroll
            for (int m = 0; m < 4; ++m) { const int row = row0 + ai * HALF + m * 16; const size_t off = (size_t)row * DM + col0; float ss = 0.f;
#pragma unroll
                for (int bj = 0; bj < 2; ++bj) { const v4u x = xx[ai][m][bj];
                    const f32x4 v0 = (f32x4){h2f((u16)(x.x & 0xffffu)), h2f((u16)(x.x >> 16)), h2f((u16)(x.y & 0xffffu)), h2f((u16)(x.y >> 16))} + acc[ai][bj][m][0];
                    const f32x4 v1 = (f32x4){h2f((u16)(x.z & 0xffffu)), h2f((u16)(x.z >> 16)), h2f((u16)(x.w & 0xffffu)), h2f((u16)(x.w >> 16))} + acc[ai][bj][m][1];
                    v4u h; h.x = cvt_pk_f16(v0[0], v0[1]); h.y = cvt_pk_f16(v0[2], v0[3]); h.z = cvt_pk_f16(v1[0], v1[1]); h.w = cvt_pk_f16(v1[2], v1[3]); *(v4u*)(x2h + off + bj * HALF) = h;
                    ss += ((v0[0] * v0[0] + v0[1] * v0[1]) + (v0[2] * v0[2] + v0[3] * v0[3])) + ((v1[0] * v1[0] + v1[1] * v1[1]) + (v1[2] * v1[2] + v1[3] * v1[3])); }
                ss += __shfl_xor(ss, 16); ss += __shfl_xor(ss, 32);
                if (fq == 0) part[(size_t)row * 16 + u.pn * 4 + wc] = ss; }
    }
};
struct EpiGU {
    static constexpr int PROBE_ID = 42;
    static constexpr bool PERM = true, AFTER_DRAIN = false;
    u16* U; const float* part;
    __device__ __forceinline__ void operator()(const f32x4 (&acc)[2][2][4][2], const Unit& u, int wr, int wc, int fr, int fq) const {
        const int row0 = u.pm * BM + wr * 64 + fr, colt = u.pn * HALF + wc * 32 + 8 * fq;
        f32x4 pq[2][4]; float rr[2][4];
#pragma unroll
        for (int ai = 0; ai < 2; ++ai)
#pragma unroll
            for (int m = 0; m < 4; ++m) pq[ai][m] = *(const f32x4*)(part + (size_t)(row0 + ai * HALF + m * 16) * 16 + 4 * fq);
#pragma unroll
        for (int ai = 0; ai < 2; ++ai)
#pragma unroll
            for (int m = 0; m < 4; ++m) { float sq = (pq[ai][m][0] + pq[ai][m][1]) + (pq[ai][m][2] + pq[ai][m][3]); sq += __shfl_xor(sq, 16); sq += __shfl_xor(sq, 32);
                rr[ai][m] = __builtin_amdgcn_rsqf(sq * (1.0f / DM) + EPS); }
#pragma unroll
        for (int ai = 0; ai < 2; ++ai)
#pragma unroll
            for (int m = 0; m < 4; ++m) { const int row = row0 + ai * HALF + m * 16;
                const float r = rr[ai][m];
                float o[8];
#pragma unroll
                for (int n = 0; n < 2; ++n)
#pragma unroll
                    for (int j = 0; j < 4; ++j) o[4 * n + j] = silu_f(acc[ai][0][m][n][j] * r) * (acc[ai][1][m][n][j] * r);
                v4u w; w.x = cvt_pk_f16(o[0], o[1]); w.y = cvt_pk_f16(o[2], o[3]); w.z = cvt_pk_f16(o[4], o[5]); w.w = cvt_pk_f16(o[6], o[7]);
                *(v4u*)(U + (size_t)row * DFF + colt) = w; }
    }
};
struct EpiDownNorm {
    static constexpr int PROBE_ID = 43;
    static constexpr bool PERM = true, AFTER_DRAIN = false;
    const u16* x2h; float* out; float* part; unsigned* cnt; const float* gfin;
    __device__ __forceinline__ void operator()(f32x4 (&acc)[2][2][4][2], const Unit& u, int wr, int wc, int fr, int fq) const {
        const int row0 = u.pm * BM + wr * 64 + fr, col0 = u.pn * BM + wc * 32 + 8 * fq;
        { v4u xx[2][4][2];
#pragma unroll
          for (int ai = 0; ai < 2; ++ai)
#pragma unroll
              for (int m = 0; m < 4; ++m)
#pragma unroll
                  for (int bj = 0; bj < 2; ++bj) xx[ai][m][bj] = *(const v4u*)(x2h + (size_t)(row0 + ai * HALF + m * 16) * DM + col0 + bj * HALF);
#pragma unroll
          for (int ai = 0; ai < 2; ++ai)
#pragma unroll
              for (int m = 0; m < 4; ++m) { const int row = row0 + ai * HALF + m * 16; float ss = 0.f;
#pragma unroll
                  for (int bj = 0; bj < 2; ++bj) { const v4u x = xx[ai][m][bj];
                      const f32x4 v0 = (f32x4){h2f((u16)(x.x & 0xffffu)), h2f((u16)(x.x >> 16)), h2f((u16)(x.y & 0xffffu)), h2f((u16)(x.y >> 16))} + acc[ai][bj][m][0];
                      const f32x4 v1 = (f32x4){h2f((u16)(x.z & 0xffffu)), h2f((u16)(x.z >> 16)), h2f((u16)(x.w & 0xffffu)), h2f((u16)(x.w >> 16))} + acc[ai][bj][m][1];
                      acc[ai][bj][m][0] = v0; acc[ai][bj][m][1] = v1;
                      ss += ((v0[0] * v0[0] + v0[1] * v0[1]) + (v0[2] * v0[2] + v0[3] * v0[3])) + ((v1[0] * v1[0] + v1[1] * v1[1]) + (v1[2] * v1[2] + v1[3] * v1[3])); }
                  ss += __shfl_xor(ss, 16); ss += __shfl_xor(ss, 32);
                  if (fq == 0) __hip_atomic_store((unsigned*)(part + (size_t)row * 16 + u.pn * 4 + wc), __builtin_bit_cast(unsigned, ss), __ATOMIC_RELAXED, __HIP_MEMORY_SCOPE_AGENT); } }
        asm volatile("s_waitcnt vmcnt(0)" ::: "memory");
        __builtin_amdgcn_s_barrier(); asm volatile("" ::: "memory");
        unsigned* cw = cnt + 64 * u.pm;
        if (threadIdx.x == 0) (void)__hip_atomic_fetch_add(cw, 1u, __ATOMIC_RELAXED, __HIP_MEMORY_SCOPE_AGENT);
        if (threadIdx.x < 64) { unsigned spins = 0u;
            while ((unsigned)__builtin_amdgcn_readfirstlane(__hip_atomic_load(cw, __ATOMIC_RELAXED, __HIP_MEMORY_SCOPE_AGENT)) < 4u) { __builtin_amdgcn_s_sleep(2); if (++spins > (1u << 22)) break; }
            __builtin_amdgcn_fence(__ATOMIC_ACQUIRE, "agent");
            asm volatile("s_waitcnt vmcnt(0)" ::: "memory"); }
        asm volatile("" ::: "memory"); __builtin_amdgcn_s_barrier(); asm volatile("" ::: "memory");
        f32x4 gv[2][2], pq[2][4]; float rr[2][4];
#pragma unroll
        for (int ai = 0; ai < 2; ++ai)
#pragma unroll
            for (int m = 0; m < 4; ++m) pq[ai][m] = *(const f32x4*)(part + (size_t)(row0 + ai * HALF + m * 16) * 16 + 4 * fq);
#pragma unroll
        for (int bj = 0; bj < 2; ++bj)
#pragma unroll
            for (int n = 0; n < 2; ++n) gv[bj][n] = *(const f32x4*)(gfin + col0 + bj * HALF + 4 * n);
#pragma unroll
        for (int ai = 0; ai < 2; ++ai)
#pragma unroll
            for (int m = 0; m < 4; ++m) { float sq = (pq[ai][m][0] + pq[ai][m][1]) + (pq[ai][m][2] + pq[ai][m][3]); sq += __shfl_xor(sq, 16); sq += __shfl_xor(sq, 32);
                rr[ai][m] = __builtin_amdgcn_rsqf(sq * (1.0f / DM) + EPS); }
#pragma unroll
        for (int ai = 0; ai < 2; ++ai)
#pragma unroll
            for (int m = 0; m < 4; ++m) { const size_t off = (size_t)(row0 + ai * HALF + m * 16) * DM + col0; const float r = rr[ai][m];
#pragma unroll
                for (int bj = 0; bj < 2; ++bj)
#pragma unroll
                    for (int n = 0; n < 2; ++n) *(f32x4*)(out + off + bj * HALF + 4 * n) = acc[ai][bj][m][n] * r * gv[bj][n]; }
    }
};
struct EpiDown {
    static constexpr int PROBE_ID = 44;
    static constexpr bool PERM = false, AFTER_DRAIN = false;
    const u16* x2h; float* x3; float* part;
    __device__ __forceinline__ void operator()(const f32x4 (&acc)[2][2][4][2], const Unit& u, int wr, int wc, int fr, int fq) const {
        const int row0 = u.pm * BM + wr * 64 + fr, col0 = u.pn * BM + wc * 32 + 4 * fq;
#pragma unroll
        for (int ai = 0; ai < 2; ++ai)
#pragma unroll
            for (int m = 0; m < 4; ++m) { const int row = row0 + ai * HALF + m * 16; const size_t off = (size_t)row * DM + col0; float ss = 0.f;
#pragma unroll
                for (int bj = 0; bj < 2; ++bj)
#pragma unroll
                    for (int n = 0; n < 2; ++n) { const size_t o = off + bj * HALF + n * 16; const v2u hh = *(const v2u*)(x2h + o);
                        const f32x4 r2 = {h2f((u16)(hh.x & 0xffffu)), h2f((u16)(hh.x >> 16)), h2f((u16)(hh.y & 0xffffu)), h2f((u16)(hh.y >> 16))}; const f32x4 v = r2 + acc[ai][bj][m][n];
                        *(f32x4*)(x3 + o) = v; ss += (v[0] * v[0] + v[1] * v[1]) + (v[2] * v[2] + v[3] * v[3]); }
                ss += __shfl_xor(ss, 16); ss += __shfl_xor(ss, 32);
                if (fq == 0) part[(size_t)row * 16 + u.pn * 4 + wc] = ss; }
    }
};

template <class Epi, class Sched, bool ALIGN_EPI = false, bool SP2 = false>
__device__ __forceinline__ void gemm_phase(PG8_LAS unsigned char* lds, const Gemm g, const Sched& S, const Epi& E) {
    const int tid = threadIdx.x, wid = __builtin_amdgcn_readfirstlane(tid >> 6), lane = tid & 63, wr = wid >> 2, wc = wid & 3, fr = lane & 15, fq = lane >> 4;
    const int K = g.K, nt = K / BK;
    unsigned voffA[2], voffB[2];
#pragma unroll
    for (int i = 0; i < 2; ++i) { int R, C; stage_rc(tid * 16 + i * 8192, R, C); const int Rb = Epi::PERM ? ((R & ~31) + perm32(R & 31)) : R;
        voffA[i] = (unsigned)(R * K + C) * 2u; voffB[i] = (unsigned)(Rb * K + C) * 2u; }
    const size_t kstep = (size_t)(BK * 2);
    const size_t hstep = (size_t)HALF * K * 2;
    const size_t tstep = 2 * hstep;
    const unsigned ldsw = (unsigned)wid * 1024u;
    const int aoff = lds_byte(wr * 64 + fr, fq * 8), boff = lds_byte(wc * 32 + fr, fq * 8);
#define PG8_SA(b, h) (((b) * 2 + (h)) * HTB)
#define PG8_SB(b, h) ((4 + (b) * 2 + (h)) * HTB)
#define PG8_STAGE(bufoff, gbase, voff) do { _Pragma("unroll") for (int _i = 0; _i < 2; ++_i) \
        __builtin_amdgcn_global_load_lds((const unsigned*)((const char*)(gbase) + (voff)[_i]), (PG8_LAS unsigned*)(lds + (bufoff) + ldsw + _i * 8192), 16, 0, 0); } while (0)
#define PG8_LDA(dst, b, h) do { _Pragma("unroll") for (int m = 0; m < 4; ++m) _Pragma("unroll") for (int k = 0; k < 2; ++k) dst[m][k] = *(const PG8_LAS f16x8*)(lds + PG8_SA(b, h) + aoff + m * 2048 + k * 1024); } while (0)
#define PG8_LDB(dst, b, h) do { _Pragma("unroll") for (int n = 0; n < 2; ++n) _Pragma("unroll") for (int k = 0; k < 2; ++k) dst[n][k] = *(const PG8_LAS f16x8*)(lds + PG8_SB(b, h) + boff + n * 2048 + k * 1024); } while (0)
#define PG8_MMA(ai, bj, At, Bt) do { __builtin_amdgcn_s_setprio(1); _Pragma("unroll") for (int m = 0; m < 4; ++m) _Pragma("unroll") for (int n = 0; n < 2; ++n) _Pragma("unroll") for (int k = 0; k < 2; ++k) \
        acc[ai][bj][m][n] = __builtin_amdgcn_mfma_f32_16x16x32_f16(Bt[n][k], At[m][k], acc[ai][bj][m][n], 0, 0, 0); __builtin_amdgcn_s_setprio(0); } while (0)
#define PG8_WAIT_V(n) asm volatile("s_waitcnt vmcnt(" #n ")" ::: "memory")
#define PG8_WAIT_L(n) asm volatile("s_waitcnt lgkmcnt(" #n ")" ::: "memory")
#define PG8_BAR __builtin_amdgcn_s_barrier()
#define PG8_SCHED __builtin_amdgcn_sched_barrier(0)
    Unit cur, nxt; int ui = 0;
    if (!S.next(0, cur)) return;
    f32x4 acc[2][2][4][2];
#pragma unroll
    for (int a = 0; a < 2; ++a)
#pragma unroll
        for (int b = 0; b < 2; ++b)
#pragma unroll
            for (int m = 0; m < 4; ++m)
#pragma unroll
                for (int n = 0; n < 2; ++n) acc[a][b][m][n] = (f32x4){0.f, 0.f, 0.f, 0.f};
    f16x8 At[4][2], B0[2][2], B1[2][2];
    const char* cA = (const char*)g.A + (size_t)cur.pm * tstep; const char* cB = (const char*)g.Bt + (size_t)cur.pn * tstep;
    S.a_ready(cur);
    if constexpr (SP2) {
        PG8_STAGE(PG8_SB(0, 0), cB, voffB); PG8_STAGE(PG8_SB(0, 1), cB + hstep, voffB); PG8_STAGE(PG8_SA(0, 0), cA, voffA); PG8_STAGE(PG8_SA(0, 1), cA + hstep, voffA);
        if (wr == 1) PG8_BAR;
        PG8_WAIT_V(2); PG8_BAR;
        PG8_STAGE(PG8_SB(1, 0), cB + kstep, voffB); PG8_STAGE(PG8_SA(1, 0), cA + kstep, voffA); PG8_STAGE(PG8_SB(1, 1), cB + hstep + kstep, voffB);
        PG8_WAIT_V(6); PG8_BAR;
    } else {
        PG8_STAGE(PG8_SB(0, 0), cB, voffB); PG8_STAGE(PG8_SA(0, 0), cA, voffA); PG8_STAGE(PG8_SB(0, 1), cB + hstep, voffB); PG8_STAGE(PG8_SA(0, 1), cA + hstep, voffA);
        if (wr == 1) PG8_BAR;
        PG8_WAIT_V(4); PG8_BAR;
        PG8_STAGE(PG8_SB(1, 0), cB + kstep, voffB); PG8_STAGE(PG8_SA(1, 0), cA + kstep, voffA); PG8_STAGE(PG8_SB(1, 1), cB + hstep + kstep, voffB);
        PG8_WAIT_V(6); PG8_BAR;
    }
    for (;;) {
        const bool has_next = S.next(ui + 1, nxt);
        const char* nA = has_next ? (const char*)g.A + (size_t)nxt.pm * tstep : cA; const char* nB = has_next ? (const char*)g.Bt + (size_t)nxt.pn * tstep : cB;
        for (int t = 0; t < nt; t += 2) {
            const bool last = (t == nt - 2);
            const char* a1 = cA + (size_t)(t + 1) * kstep;
            const char* a2 = last ? nA : cA + (size_t)(t + 2) * kstep; const char* b2 = last ? nB : cB + (size_t)(t + 2) * kstep;
            const char* a3 = a2 + kstep; const char* b3 = b2 + kstep;
            if (last && has_next) S.a_ready(nxt);
            if constexpr (SP2) {
            PG8_LDB(B0, 0, 0); PG8_LDB(B1, 0, 1); PG8_SCHED; PG8_LDA(At, 0, 0); PG8_STAGE(PG8_SA(1, 1), a1 + hstep, voffA);
            PG8_WAIT_V(8); PG8_WAIT_L(0); PG8_BAR; PG8_MMA(0, 0, At, B0); PG8_MMA(0, 1, At, B1); PG8_BAR; PG8_SCHED;
            PG8_LDA(At, 0, 1); PG8_STAGE(PG8_SB(0, 0), b2, voffB); PG8_STAGE(PG8_SB(0, 1), b2 + hstep, voffB); PG8_STAGE(PG8_SA(0, 0), a2, voffA);
            PG8_WAIT_V(8); PG8_WAIT_L(0); PG8_BAR; PG8_MMA(1, 0, At, B0); PG8_MMA(1, 1, At, B1); PG8_BAR; PG8_SCHED;
            PG8_LDB(B0, 1, 0); PG8_LDB(B1, 1, 1); PG8_SCHED; PG8_LDA(At, 1, 0); PG8_STAGE(PG8_SA(0, 1), a2 + hstep, voffA);
            PG8_WAIT_V(8); PG8_WAIT_L(0); PG8_BAR; PG8_MMA(0, 0, At, B0); PG8_MMA(0, 1, At, B1); PG8_BAR; PG8_SCHED;
            PG8_LDA(At, 1, 1); PG8_STAGE(PG8_SB(1, 0), b3, voffB); PG8_STAGE(PG8_SB(1, 1), b3 + hstep, voffB); PG8_STAGE(PG8_SA(1, 0), a3, voffA);
            PG8_WAIT_V(8); PG8_WAIT_L(0); PG8_BAR; PG8_MMA(1, 0, At, B0); PG8_MMA(1, 1, At, B1); PG8_BAR; PG8_SCHED;
            } else {
            PG8_LDB(B0, 0, 0); PG8_SCHED; PG8_LDA(At, 0, 0); PG8_STAGE(PG8_SA(1, 1), a1 + hstep, voffA);
            PG8_WAIT_L(8); PG8_BAR; PG8_WAIT_L(0); PG8_MMA(0, 0, At, B0); PG8_BAR; PG8_SCHED;
            PG8_LDB(B1, 0, 1); PG8_STAGE(PG8_SB(0, 0), b2, voffB);
            PG8_BAR; PG8_WAIT_L(0); PG8_MMA(0, 1, At, B1); PG8_BAR;
            PG8_LDA(At, 0, 1); PG8_STAGE(PG8_SA(0, 0), a2, voffA);
            PG8_BAR; PG8_WAIT_L(0); PG8_MMA(1, 0, At, B0); PG8_BAR; PG8_SCHED;
            PG8_STAGE(PG8_SB(0, 1), b2 + hstep, voffB);
            PG8_WAIT_V(6); PG8_BAR; PG8_MMA(1, 1, At, B1); PG8_BAR;
            PG8_LDB(B0, 1, 0); PG8_SCHED; PG8_LDA(At, 1, 0); PG8_STAGE(PG8_SA(0, 1), a2 + hstep, voffA);
            PG8_WAIT_L(8); PG8_BAR; PG8_WAIT_L(0); PG8_MMA(0, 0, At, B0); PG8_BAR; PG8_SCHED;
            PG8_LDB(B1, 1, 1); PG8_STAGE(PG8_SB(1, 0), b3, voffB);
            PG8_BAR; PG8_WAIT_L(0); PG8_MMA(0, 1, At, B1); PG8_BAR;
            PG8_LDA(At, 1, 1); PG8_STAGE(PG8_SA(1, 0), a3, voffA);
            PG8_BAR; PG8_WAIT_L(0); PG8_MMA(1, 0, At, B0); PG8_BAR; PG8_SCHED;
            PG8_STAGE(PG8_SB(1, 1), b3 + hstep, voffB);
            PG8_WAIT_V(6); PG8_BAR; PG8_MMA(1, 1, At, B1); PG8_BAR;
            }
        }
        if constexpr (ALIGN_EPI) { if (wr == 0) PG8_BAR; }
#ifdef PROBE_PHASE
        const unsigned long long pe0_ = (Epi::PROBE_ID == PROBE_PHASE) ? __builtin_amdgcn_s_memrealtime() : 0ull;
#endif
        if constexpr (!Epi::AFTER_DRAIN) { E(acc, cur, wr, wc, fr, fq); S.done(cur); }
#ifdef PROBE_PHASE
        if (Epi::PROBE_ID == PROBE_PHASE) { const unsigned long long t1_ = __builtin_amdgcn_s_memrealtime(), dt_ = t1_ - pe0_; while (__builtin_amdgcn_s_memrealtime() - t1_ < (unsigned long long)(PROBE_MULT) * dt_) __builtin_amdgcn_s_sleep(8); }
#endif
        if (!has_next) break;
#pragma unroll
        for (int a = 0; a < 2; ++a)
#pragma unroll
            for (int b = 0; b < 2; ++b)
#pragma unroll
                for (int m = 0; m < 4; ++m)
#pragma unroll
                    for (int n = 0; n < 2; ++n) acc[a][b][m][n] = (f32x4){0.f, 0.f, 0.f, 0.f};
        cur = nxt; cA = nA; cB = nB; ++ui;
        if constexpr (ALIGN_EPI) { if (wr == 1) PG8_BAR; }
    }
    PG8_WAIT_V(0);
    if constexpr (!ALIGN_EPI) { if (wr == 0) PG8_BAR; }
    PG8_BAR;
    if constexpr (Epi::AFTER_DRAIN) { E.fused(acc, cur, wr, wc, fr, fq, lds, wid, lane); S.done(cur); }
#undef PG8_SA
#undef PG8_SB
#undef PG8_STAGE
#undef PG8_LDA
#undef PG8_LDB
#undef PG8_MMA
#undef PG8_WAIT_V
#undef PG8_WAIT_L
#undef PG8_BAR
#undef PG8_SCHED
}

}

namespace attn_body {
using bf16=__hip_bfloat16;
using bf16x8=__attribute__((ext_vector_type(8)))short;
using s16x4=__attribute__((ext_vector_type(4)))short;
using f32x16=__attribute__((ext_vector_type(16)))float;
using u32x4=__attribute__((ext_vector_type(4)))unsigned;
constexpr int BATCH=4,NHEAD=8,SEQ=8192,D=64,DM=NHEAD*D,OPITCH=1024;
constexpr int NW=8,QBLK=32,QB=QBLK*NW,KVBLK=64,NQB=SEQ/QB;
constexpr int ATTN_PITCH=DM, ATTN_UNIT_ROWS=QB;
__device__ __forceinline__ int crow(int r,int hi){return (r&3)+8*(r>>2)+4*hi;}
#define SBAR() __builtin_amdgcn_sched_barrier(0)
__device__ __forceinline__ float bsel(float x,unsigned m){ return __builtin_bit_cast(float,__builtin_amdgcn_bitop3_b32(__builtin_bit_cast(unsigned,x),0xFF800000u,m,0xE4)); }
__device__ __forceinline__ void bmask(f32x16&p0,f32x16&p1,unsigned mw){
  #pragma unroll
  for(int r=0;r<16;++r){
    const unsigned m0=(unsigned)__builtin_amdgcn_sbfe((int)mw,r,1), m1=(unsigned)__builtin_amdgcn_sbfe((int)mw,16+r,1);
    const float x0=p0[r], x1=p1[r]; p0[r]=bsel(x0,m0); p1[r]=bsel(x1,m1); }
}
__device__ __forceinline__ void addbias(f32x16&p0,f32x16&p1,const float*btab,int dbase){
  #pragma unroll
  for(int r=0;r<16;++r){ int d0=dbase-((r&3)+8*(r>>2)); int d1=d0-32; d0=d0<0?0:(d0>127?127:d0); d1=d1<0?0:(d1>127?127:d1); p0[r]+=btab[d0]; p1[r]+=btab[d1]; }
}

constexpr int NSLOT=3, SLOTB=8192;
constexpr int LDS_K=0, LDS_V=NSLOT*SLOTB, LDS_WS=2*NSLOT*SLOTB, LDS_OST=LDS_WS+NW*64*4, LDS_BIAS=LDS_OST+NW*4096, LDS_MASK=LDS_BIAS+512, LDS_BYTES=LDS_MASK+NW*512;
constexpr float C2=0.125f*1.4426950408889634f;
__device__ __forceinline__ void glds16(const void*gsrc,unsigned lds_dst){unsigned keep;
  asm volatile("s_mov_b32 %0, m0\n\ts_mov_b32 m0, %2\n\ts_nop 0\n\tglobal_load_lds_dwordx4 %1, off\n\ts_mov_b32 m0, %0":"=&s"(keep):"v"(gsrc),"s"(lds_dst):"memory");}
__device__ __forceinline__ void glds4(const void*gsrc,unsigned lds_dst){unsigned keep;
  asm volatile("s_mov_b32 %0, m0\n\ts_mov_b32 m0, %2\n\ts_nop 0\n\tglobal_load_lds_dword %1, off\n\ts_mov_b32 m0, %0":"=&s"(keep):"v"(gsrc),"s"(lds_dst):"memory");}
__device__ __forceinline__ void glds4s(const void*sbase,unsigned voff,unsigned lds_dst){unsigned keep;
  asm volatile("s_mov_b32 %0, m0\n\ts_mov_b32 m0, %3\n\ts_nop 0\n\tglobal_load_lds_dword %1, %2\n\ts_mov_b32 m0, %0":"=&s"(keep):"v"(voff),"s"(sbase),"s"(lds_dst):"memory");}
__device__ __forceinline__ float max3f(float a,float b,float c){float r;asm("v_max3_f32 %0, %1, %2, %3":"=v"(r):"v"(a),"v"(b),"v"(c));return r;}
__device__ __forceinline__ float max2f(float a,float b){float r;asm("v_max_f32_e32 %0, %1, %2":"=v"(r):"v"(a),"v"(b));return r;}
__device__ __forceinline__ float fadd_s(float a,float b){float r;asm("v_add_f32_e32 %0, %1, %2":"=v"(r):"v"(a),"v"(b));return r;}
__device__ __forceinline__ float fsub_s(float a,float b){float r;asm("v_sub_f32_e32 %0, %1, %2":"=v"(r):"v"(a),"v"(b));return r;}
typedef float f32x2_t __attribute__((ext_vector_type(2))); typedef __bf16 bf16x2_t __attribute__((ext_vector_type(2)));
__device__ __forceinline__ unsigned cvtpk_s(float lo,float hi){f32x2_t v={lo,hi};bf16x2_t b=__builtin_convertvector(v,bf16x2_t);return __builtin_bit_cast(unsigned,b);}
#define WAIT_BAR(N) asm volatile("s_waitcnt vmcnt(" #N ") lgkmcnt(0)\n\ts_barrier":::"memory")

__device__ __forceinline__ void qkt(f32x16&p0,f32x16&p1,const char*Kslot,const bf16x8*qr,const f32x16&negm,int r32,int hi){
  const char*kb=Kslot+hi*1024+r32*16;
  #pragma unroll
  for(int d0=0;d0<4;++d0){
    const bf16x8 b0=*reinterpret_cast<const bf16x8*>(kb+d0*2048);
    const bf16x8 b1=*reinterpret_cast<const bf16x8*>(kb+d0*2048+512);
    if(d0==0){p0=__builtin_amdgcn_mfma_f32_32x32x16_bf16(b0,qr[0],negm,0,0,0);p1=__builtin_amdgcn_mfma_f32_32x32x16_bf16(b1,qr[0],negm,0,0,0);}
    else{p0=__builtin_amdgcn_mfma_f32_32x32x16_bf16(b0,qr[d0],p0,0,0,0);p1=__builtin_amdgcn_mfma_f32_32x32x16_bf16(b1,qr[d0],p1,0,0,0);}}
}
typedef __attribute__((address_space(3))) const char* lds_cptr;
typedef short v4i16_t __attribute__((ext_vector_type(4)));
__device__ __forceinline__ void kload8(bf16x8*kf,lds_cptr kp){
  kf[0]=*(const __attribute__((address_space(3))) bf16x8*)(kp);      kf[1]=*(const __attribute__((address_space(3))) bf16x8*)(kp+512);
  kf[2]=*(const __attribute__((address_space(3))) bf16x8*)(kp+2048); kf[3]=*(const __attribute__((address_space(3))) bf16x8*)(kp+2560);
  kf[4]=*(const __attribute__((address_space(3))) bf16x8*)(kp+4096); kf[5]=*(const __attribute__((address_space(3))) bf16x8*)(kp+4608);
  kf[6]=*(const __attribute__((address_space(3))) bf16x8*)(kp+6144); kf[7]=*(const __attribute__((address_space(3))) bf16x8*)(kp+6656);
}
__device__ __forceinline__ void kload2(bf16x8*kf,lds_cptr kp,int j){ kf[2*j]=*(const __attribute__((address_space(3))) bf16x8*)(kp+j*2048); kf[2*j+1]=*(const __attribute__((address_space(3))) bf16x8*)(kp+j*2048+512); }
__device__ __forceinline__ s16x4 vtr(lds_cptr p){ return __builtin_bit_cast(s16x4,__builtin_amdgcn_ds_read_tr16_b64_v4i16((__attribute__((address_space(3))) v4i16_t*)p)); }
__device__ __forceinline__ float rowmax(const f32x16&p0,const f32x16&p1){
  float a=max3f(p0[0],p0[1],p1[0]),b=max3f(p0[2],p0[3],p1[1]);a=max3f(a,p1[2],p1[3]);
  #pragma unroll
  for(int r=4;r<16;r+=4){a=max3f(a,p0[r],p0[r+1]);b=max3f(b,p0[r+2],p0[r+3]);a=max3f(a,p1[r],p1[r+1]);b=max3f(b,p1[r+2],p1[r+3]);}
  const float m=max2f(a,b);
  auto rr=__builtin_amdgcn_permlane32_swap(__float_as_uint(m),__float_as_uint(m),false,false);
  return max2f(__uint_as_float(rr[0]),__uint_as_float(rr[1]));
}
__device__ __forceinline__ void pv(f32x16*o,int vb,bf16x8 pa0,bf16x8 pa1,bf16x8 pa2,bf16x8 pa3){
  #pragma unroll
  for(int d0=0;d0<2;++d0){s16x4 lo[4],hi[4];
    #pragma unroll
    for(int ks=0;ks<4;++ks){
      asm volatile("ds_read_b64_tr_b16 %0,%1 offset:%c2":"=&v"(lo[ks]):"v"(vb),"i"(d0*4096+ks*1024):"memory");
      asm volatile("ds_read_b64_tr_b16 %0,%1 offset:%c2":"=&v"(hi[ks]):"v"(vb),"i"(d0*4096+ks*1024+512):"memory");}
    asm volatile("s_waitcnt lgkmcnt(0)":::"memory");SBAR();
    #define PK(k) (bf16x8){lo[k][0],lo[k][1],lo[k][2],lo[k][3],hi[k][0],hi[k][1],hi[k][2],hi[k][3]}
    o[d0]=__builtin_amdgcn_mfma_f32_32x32x16_bf16(pa0,PK(0),o[d0],0,0,0);
    o[d0]=__builtin_amdgcn_mfma_f32_32x32x16_bf16(pa1,PK(1),o[d0],0,0,0);
    o[d0]=__builtin_amdgcn_mfma_f32_32x32x16_bf16(pa2,PK(2),o[d0],0,0,0);
    o[d0]=__builtin_amdgcn_mfma_f32_32x32x16_bf16(pa3,PK(3),o[d0],0,0,0);
    #undef PK
  }
}

#ifndef ATTN_STORE16
#define ATTN_STORE16(p,v) (*(u32x4*)(p)=(v))
#endif
template<int THRL> __device__ __forceinline__ void attn_unit(int b,int h,int qb,const bf16*Q,const bf16*__restrict__ K,const bf16*__restrict__ V,unsigned short*O,const unsigned*__restrict__ BMK,const float*__restrict__ BIASG,char*shm){
  const int tid=threadIdx.x,lane=tid&63,r32=lane&31,hi=lane>>5; const int wid=__builtin_amdgcn_readfirstlane(tid>>6);
  const long rowbase=(long)b*SEQ; const int q0=qb*QB;
  const bf16*Qw=Q+(rowbase+q0+wid*QBLK)*DM+h*D;
  const bf16*Kh=K+rowbase*DM+h*D,*Vh=V+rowbase*DM+h*D;
  const unsigned lds0=(unsigned)(uintptr_t)shm;
  float*wsf=(float*)(shm+LDS_WS)+wid*64;
  float*btab=(float*)(shm+LDS_BIAS);
  if(tid<128)btab[tid]=BIASG[h*128+tid];
  const unsigned*bmw=BMK+((size_t)(b*256+qb*8+wid)*128)*64;
  unsigned mwc;
  const unsigned mdst=lds0+LDS_MASK+wid*512;
  #define MDMA(tt) glds4s(bmw+(size_t)(tt)*64,(unsigned)lane*4u,(unsigned)__builtin_amdgcn_readfirstlane(mdst+(((tt)&1)<<8)))
  #define MREAD(tt) (*(const __attribute__((address_space(3))) unsigned*)((lds_cptr)shm+LDS_MASK+wid*512+(((tt)&1)<<8)+lane*4))
  MDMA(0); MDMA(1);
  const bf16*ksrc=Kh+(long)lane*DM+wid*8;
  const bf16*vsrc=Vh+(long)(16*(wid&3)+(lane>>2))*DM+(wid>>2)*32+(lane&3)*8;
  const unsigned kdst=lds0+LDS_K+wid*1024, vdst=lds0+LDS_V+wid*1024;
  #define DMA_K(t,slot) glds16(ksrc+(long)(t)*KVBLK*DM,(unsigned)__builtin_amdgcn_readfirstlane(kdst+(slot)))
  #define DMA_V(t,slot) glds16(vsrc+(long)(t)*KVBLK*DM,(unsigned)__builtin_amdgcn_readfirstlane(vdst+(slot)))
  const int vb0=(int)(lds0+LDS_V)+((lane>>4)&1)*32+(lane&3)*8+(4*hi+((lane&15)>>2))*64;
  const char*Kbase=shm+LDS_K; bf16x8 kf[8];
  const lds_cptr shm3=(lds_cptr)shm; const lds_cptr kp0=shm3+LDS_K+hi*1024+r32*16; const lds_cptr vp0=shm3+LDS_V+((lane>>4)&1)*32+(lane&3)*8+(4*hi+((lane&15)>>2))*64;
  const int NT=(q0+QB)/KVBLK;
  DMA_K(0,0);DMA_V(0,0);DMA_K(1,SLOTB);
  bf16x8 qr[4];
  #pragma unroll
  for(int d0=0;d0<4;++d0)qr[d0]=*reinterpret_cast<const bf16x8*>(&Qw[(long)r32*DM+d0*16+hi*8]);
  float mhat=0.f,l_reg=0.f;f32x16 o[2];o[0]=f32x16{};o[1]=f32x16{};f32x16 negm=f32x16{};asm volatile("":"+v"(negm));
  const int qrel=wid*QBLK+r32;
  #define CMASK(P0,P1,t) do{ bmask(P0,P1,mwc); if((t)>=NT-7)addbias(P0,P1,btab,q0+qrel-64*(t)-4*hi); }while(0)
  bool resc=false;
  #define START(P0,P1) do{ const float rm=rowmax(P0,P1); resc=false; \
    { const float dl=(rm==-INFINITY)?0.f:rm; mhat=fadd_s(mhat,dl); \
      _Pragma("unroll") for(int r=0;r<16;++r){P0[r]=fsub_s(P0[r],dl);P1[r]=fsub_s(P1[r],dl);} \
      _Pragma("unroll") for(int r=0;r<16;++r)negm[r]=-mhat; asm volatile("":"+v"(negm)); } \
    _Pragma("unroll") for(int r=0;r<16;++r)P0[r]=__builtin_amdgcn_exp2f(P0[r]); }while(0)
  #define RESC() do{ if(resc){ asm volatile("s_waitcnt lgkmcnt(0)":::"memory"); \
      _Pragma("unroll") for(int d_=0;d_<2;++d_) _Pragma("unroll") for(int r=0;r<16;++r)o[d_][r]*=wsf[crow(r,hi)]; } }while(0)
  f32x16 pA0,pA1,pB0,pB1;
  int sl_prev=0,sl_cur=0,sl_next=SLOTB;
  #define ROT() do{sl_prev=sl_cur;sl_cur=sl_next;sl_next=(sl_next==(NSLOT-1)*SLOTB)?0:sl_next+SLOTB;}while(0)
  DMA_K(2,2*SLOTB);
  WAIT_BAR(3);
  mwc=MREAD(0);
  qkt(pA0,pA1,Kbase,qr,negm,r32,hi);asm volatile("s_nop 15\n\ts_nop 7":"+v"(pA0),"+v"(pA1));CMASK(pA0,pA1,0);
  START(pA0,pA1);
  _Pragma("unroll") for(int r=0;r<16;++r)pA1[r]=__builtin_amdgcn_exp2f(pA1[r]);
  WAIT_BAR(0);
  DMA_K(3,0);DMA_V(1,SLOTB);
  ROT();
  kload8(kf,kp0+sl_cur);
  WAIT_BAR(2);
  s16x4 vlo[8],vhi[8]; u32x4 pw0,pw1,pw2,pw3;
  #define PKW(P,B) cvtpk_s(P[B],P[B+1])
  #define PAF(k) __builtin_bit_cast(bf16x8,pw##k)
  #define VFR(i) (bf16x8){vlo[i][0],vlo[i][1],vlo[i][2],vlo[i][3],vhi[i][0],vhi[i][1],vhi[i][2],vhi[i][3]}
  #define PIN(x) asm volatile("":"+v"(x))
  #define MX3(a,b,c) __builtin_fmaxf(__builtin_fmaxf((a),(b)),(c))
  #define GAPA(MF,A0,A1,A2,A3,W0,W1,PW) do{ MF; sacc+=A0; sacc+=A1; sacc+=A2; sacc+=A3; PIN(sacc); W0; W1; PIN(PW); SBAR(); }while(0)
  #define EX(v) __builtin_amdgcn_exp2f(v)
  #define GAPB(MF,X,B) do{ MF; X[B]=EX(X[B]); X[B+1]=EX(X[B+1]); X[B+2]=EX(X[B+2]); X[B+3]=EX(X[B+3]); PIN(X); SBAR(); }while(0)
  #define VRD(i) do{ vlo[i]=vtr(vp_+(((i)>>2)*4096+((i)&3)*1024)); vhi[i]=vtr(vp_+(((i)>>2)*4096+((i)&3)*1024+512)); }while(0)
  #define KRD(G,j) do{ if(G){ kload2(kf,kp0+sl_next,j); SBAR(); } }while(0)
  #define STEP(C0,C1,P0,P1,t,GK,GV,GL) do{ SBAR(); mwc=MREAD(t); \
    const lds_cptr vp_=vp0+sl_prev; \
    VRD(0); SBAR(); float sacc=(P0[0]+P0[1]); \
    GAPA(C0=__builtin_amdgcn_mfma_f32_32x32x16_bf16(kf[0],qr[0],negm,0,0,0), P0[2],P0[3],P0[4],P0[5],     pw0[0]=PKW(P0,0), pw0[1]=PKW(P0,2), pw0); \
    VRD(4); SBAR(); GAPA(C1=__builtin_amdgcn_mfma_f32_32x32x16_bf16(kf[1],qr[0],negm,0,0,0), P0[6],P0[7],P0[8],P0[9],     pw0[2]=PKW(P0,4), pw0[3]=PKW(P0,6), pw0); \
    VRD(1); SBAR(); GAPA(C0=__builtin_amdgcn_mfma_f32_32x32x16_bf16(kf[2],qr[1],C0,0,0,0),   P0[10],P0[11],P0[12],P0[13], pw1[0]=PKW(P0,8), pw1[1]=PKW(P0,10), pw1); \
    VRD(5); SBAR(); GAPA(C1=__builtin_amdgcn_mfma_f32_32x32x16_bf16(kf[3],qr[1],C1,0,0,0),   P0[14],P0[15],P1[0],P1[1],   pw1[2]=PKW(P0,12),pw1[3]=PKW(P0,14), pw1); \
    VRD(2); SBAR(); GAPA(C0=__builtin_amdgcn_mfma_f32_32x32x16_bf16(kf[4],qr[2],C0,0,0,0),   P1[2],P1[3],P1[4],P1[5],     pw2[0]=PKW(P1,0), pw2[1]=PKW(P1,2), pw2); \
    VRD(6); SBAR(); GAPA(C1=__builtin_amdgcn_mfma_f32_32x32x16_bf16(kf[5],qr[2],C1,0,0,0),   P1[6],P1[7],P1[8],P1[9],     pw2[2]=PKW(P1,4), pw2[3]=PKW(P1,6), pw2); \
    VRD(3); SBAR(); GAPA(C0=__builtin_amdgcn_mfma_f32_32x32x16_bf16(kf[6],qr[3],C0,0,0,0),   P1[10],P1[11],P1[12],P1[13], pw3[0]=PKW(P1,8), pw3[1]=PKW(P1,10), pw3); \
    VRD(7); SBAR(); GAPA(C1=__builtin_amdgcn_mfma_f32_32x32x16_bf16(kf[7],qr[3],C1,0,0,0),   P1[14],P1[15],0.f,0.f,       pw3[2]=PKW(P1,12),pw3[3]=PKW(P1,14), pw3); \
    l_reg+=sacc; \
    if((t)+1<NT){MDMA((t)+1);} if(GK){DMA_K((t)+3,sl_cur);} if(GV){DMA_V((t)+1,sl_next);} \
    CMASK(C0,C1,t); \
    { float a=MX3(C0[0],C0[1],C1[0]),b=MX3(C0[2],C0[3],C1[1]); a=MX3(a,C1[2],C1[3]); \
      _Pragma("unroll") for(int r=4;r<16;r+=4){a=MX3(a,C0[r],C0[r+1]);b=MX3(b,C0[r+2],C0[r+3]);a=MX3(a,C1[r],C1[r+1]);b=MX3(b,C1[r+2],C1[r+3]);} \
      float rm=__builtin_fmaxf(a,b); { auto rr=__builtin_amdgcn_permlane32_swap(__float_as_uint(rm),__float_as_uint(rm),false,false); rm=__builtin_fmaxf(__uint_as_float(rr[0]),__uint_as_float(rr[1])); } \
      resc=false; \
      if(__builtin_expect(__any(rm>(float)THRL),0)){ const float dl=__builtin_fmaxf(rm,0.f); mhat+=dl; \
        _Pragma("unroll") for(int r=0;r<16;++r){C0[r]-=dl;C1[r]-=dl;} \
        _Pragma("unroll") for(int r=0;r<16;++r)negm[r]=-mhat; asm volatile("":"+v"(negm)); \
        const float f=__builtin_amdgcn_exp2f(-dl); l_reg*=f; if(hi==0)wsf[r32]=f; resc=true; } } \
    SBAR(); \
    GAPB(o[0]=__builtin_amdgcn_mfma_f32_32x32x16_bf16(PAF(0),VFR(0),o[0],0,0,0), C0,0); \
    GAPB(o[1]=__builtin_amdgcn_mfma_f32_32x32x16_bf16(PAF(0),VFR(4),o[1],0,0,0), C0,4); \
    KRD(GL,0); GAPB(o[0]=__builtin_amdgcn_mfma_f32_32x32x16_bf16(PAF(1),VFR(1),o[0],0,0,0), C0,8); \
    KRD(GL,1); GAPB(o[1]=__builtin_amdgcn_mfma_f32_32x32x16_bf16(PAF(1),VFR(5),o[1],0,0,0), C0,12); \
    KRD(GL,2); GAPB(o[0]=__builtin_amdgcn_mfma_f32_32x32x16_bf16(PAF(2),VFR(2),o[0],0,0,0), C1,0); \
    KRD(GL,3); GAPB(o[1]=__builtin_amdgcn_mfma_f32_32x32x16_bf16(PAF(2),VFR(6),o[1],0,0,0), C1,4); \
    GAPB(o[0]=__builtin_amdgcn_mfma_f32_32x32x16_bf16(PAF(3),VFR(3),o[0],0,0,0), C1,8); \
    GAPB(o[1]=__builtin_amdgcn_mfma_f32_32x32x16_bf16(PAF(3),VFR(7),o[1],0,0,0), C1,12); \
    }while(0)
  int t=1;
  #undef CMASK
  #define CMASK(P0,P1,t) do{ bmask(P0,P1,mwc); }while(0)
  for(;t+7<NT;t+=2){
    STEP(pB0,pB1,pA0,pA1,t,true,true,true);     WAIT_BAR(2); RESC(); ROT();
    STEP(pA0,pA1,pB0,pB1,t+1,true,true,true);   WAIT_BAR(2); RESC(); ROT();
  }
  #undef CMASK
  #define CMASK(P0,P1,t) do{ bmask(P0,P1,mwc); addbias(P0,P1,btab,q0+qrel-64*(t)-4*hi); }while(0)
  #define ENDW(tt) do{ if((tt)+3<NT){WAIT_BAR(2);} else if((tt)+2<NT){WAIT_BAR(1);} else {WAIT_BAR(0);} }while(0)
  for(;t+1<NT;t+=2){
    STEP(pB0,pB1,pA0,pA1,t,(t+3<NT),(t+1<NT),(t+1<NT));       ENDW(t);   RESC(); ROT();
    STEP(pA0,pA1,pB0,pB1,t+1,(t+4<NT),(t+2<NT),(t+2<NT));     ENDW(t+1); RESC(); ROT();
  }
  STEP(pB0,pB1,pA0,pA1,NT-1,false,false,false); RESC();
  { float sacc=pB0[0]+pB0[1]; _Pragma("unroll") for(int r=2;r<16;++r)sacc+=pB0[r]; _Pragma("unroll") for(int r=0;r<16;++r)sacc+=pB1[r]; l_reg+=sacc;
    pw0=(u32x4){PKW(pB0,0),PKW(pB0,2),PKW(pB0,4),PKW(pB0,6)};pw1=(u32x4){PKW(pB0,8),PKW(pB0,10),PKW(pB0,12),PKW(pB0,14)};pw2=(u32x4){PKW(pB1,0),PKW(pB1,2),PKW(pB1,4),PKW(pB1,6)};pw3=(u32x4){PKW(pB1,8),PKW(pB1,10),PKW(pB1,12),PKW(pB1,14)};
    SBAR(); pv(o,vb0+sl_cur,PAF(0),PAF(1),PAF(2),PAF(3)); }
  #undef PKW
  #undef PAF
  #undef VFR
  #undef PIN
  #undef MX3
  #undef GAPA
  #undef GAPB
  #undef EX
  #undef VRD
  #undef KRD
  #undef STEP
  #undef ENDW
  {auto rr=__builtin_amdgcn_permlane32_swap(__float_as_uint(l_reg),__float_as_uint(l_reg),false,false);l_reg=__uint_as_float(rr[0])+__uint_as_float(rr[1]);}
  if(hi==0)wsf[32+r32]=l_reg;asm volatile("s_waitcnt lgkmcnt(0)":::"memory");
  float rli[16];
  #pragma unroll
  for(int r=0;r<16;++r)rli[r]=__builtin_amdgcn_rcpf(wsf[32+crow(r,hi)]);
  unsigned short*Ow=O+(rowbase+q0+wid*QBLK)*OPITCH+h*D;
  { _Float16*stg=(_Float16*)(shm+LDS_OST)+wid*2048;
    #pragma unroll
    for(int r=0;r<16;++r){const int orow=crow(r,hi);
      #pragma unroll
      for(int d0=0;d0<2;++d0)stg[orow*64+d0*32+r32]=(_Float16)(o[d0][r]*rli[r]);}
    asm volatile("s_waitcnt lgkmcnt(0)":::"memory");
    #pragma unroll
    for(int i=0;i<4;++i){const int row=i*8+(lane>>3),ch=lane&7; const u32x4 v=*(const u32x4*)(stg+row*64+ch*8); ATTN_STORE16(Ow+(long)row*OPITCH+ch*8,v);} }
  asm volatile("s_waitcnt lgkmcnt(0)\n\ts_barrier":::"memory");
  #undef DMA_K
  #undef MDMA
  #undef MREAD
  #undef DMA_V
  #undef CMASK
  #undef START
  #undef RESC
  #undef ROT
}
constexpr int ATTN_LDS_BYTES=LDS_BYTES;
struct AttnTensors { const bf16* Q; const bf16* K; const bf16* V; unsigned short* O; const unsigned* BMK; const float* BIASG; };
struct AttnUnit { int bh; int qb; };
struct StaticOrder {
  int vcu;
  __device__ __forceinline__ explicit StaticOrder(int grid,int block):vcu((block%8)*(grid/8)+block/8){}
  __device__ __forceinline__ bool next(int i,AttnUnit&u)const{ if(i>=4)return false; const int s=vcu&7; u.bh=vcu>>3; u.qb=(i==0)?s:(i==1)?15-s:(i==2)?16+s:31-s; return true; }
  __device__ __forceinline__ void a_ready(const AttnUnit&)const{}
  __device__ __forceinline__ void done(const AttnUnit&)const{}
};
struct StridedOrder {
  int G,c;
  __device__ __forceinline__ explicit StridedOrder(int grid,int block):G(grid),c(block){}
  __device__ __forceinline__ bool next(int i,AttnUnit&u)const{ const int L=i*G+c; if(L>=BATCH*NHEAD*NQB)return false; u.bh=L/NQB; u.qb=L%NQB; return true; }
  __device__ __forceinline__ void a_ready(const AttnUnit&)const{}
  __device__ __forceinline__ void done(const AttnUnit&)const{}
};
template<class Sched,int THRL=8> __device__ __forceinline__ void attn_phase(char*lds,const AttnTensors&T,const Sched&S){
  AttnUnit u;
  for(int i=0;S.next(i,u);++i){ S.a_ready(u); attn_unit<THRL>(u.bh/NHEAD,u.bh%NHEAD,u.qb,T.Q,T.K,T.V,T.O,T.BMK,T.BIASG,lds); S.done(u); }
}
#undef SBAR
#undef WAIT_BAR
}

constexpr int NWAVES = 8;
#ifndef MK_N_LAUNCHES
#define MK_N_LAUNCHES 1
#endif
constexpr int N_PHASES = 9;
constexpr int N_LAUNCHES = MK_N_LAUNCHES;

constexpr size_t MiB = 1u << 20;
constexpr size_t WS_CTL = 0, CTL_ZERO_BYTES = 128 * 1024;
constexpr size_t WS_WIN = 2 * MiB, WS_WOUT = 11 * MiB, WS_WGU = 13 * MiB, WS_WD = 24 * MiB;
constexpr size_t WS_CS = 30 * MiB;
constexpr size_t WS_RINV1 = 34 * MiB, WS_PART2 = 35 * MiB, WS_PART3 = 37 * MiB, WS_WI = 39 * MiB;
constexpr size_t WS_BIAS = 34 * MiB + 512 * 1024;
constexpr size_t WS_KIRAW = 40 * MiB, WS_KIH = 48 * MiB;
constexpr size_t WS_XH = 52 * MiB, WS_MIX = 52 * MiB;
constexpr size_t WS_QA = 116 * MiB;
constexpr size_t WS_KA = WS_QA + 32 * MiB, WS_VA = WS_QA + 64 * MiB, WS_QI = WS_QA + 96 * MiB, WS_QB = WS_QA + 128 * MiB, WS_KB = WS_QA + 160 * MiB, WS_VB = WS_QA + 192 * MiB, WS_GB = WS_QA + 224 * MiB;
constexpr size_t WS_DS = 372 * MiB;
constexpr size_t WS_ST = 436 * MiB;
constexpr size_t WS_BM = 468 * MiB;
constexpr size_t WS_X2H = 372 * MiB;
constexpr size_t WS_U = 180 * MiB;
constexpr size_t WS_END = 512 * MiB;
static_assert(WS_BM + 32 * MiB <= WS_END && WS_U + (size_t)MTOK * DFF * 2 <= WS_DS + 64 * MiB, "d_ws map");
constexpr int CW_BAR = 4096;

constexpr int LCTL_BYTES = 4096;
constexpr int RING_OFF = LCTL_BYTES, RING_BYTES = 139264;
constexpr int LDS_BYTES = RING_OFF + RING_BYTES;
static_assert(LDS_BYTES <= 160 * 1024 - 1024, "LDS");

#define XB_TMO      128
#define XB_XCNT(j)  (256  + 64 * (j))
#define XB_XSUB(j)  (1280 + 64 * (j))
#define XB_XGEN(j)  (2304 + 64 * (j))
#define XB_TOP      3328
#define XB_TOPGEN   3392
#define XCD_BAR_WORDS 3456
#define XB_SPIN_CAP (1u << 18)

__device__ __forceinline__ unsigned xb_ld(unsigned* p)              { return __hip_atomic_load(p, __ATOMIC_RELAXED, __HIP_MEMORY_SCOPE_AGENT); }
__device__ __forceinline__ unsigned xb_add(unsigned* p, unsigned v) { return __hip_atomic_fetch_add(p, v, __ATOMIC_RELAXED, __HIP_MEMORY_SCOPE_AGENT); }
__device__ __forceinline__ unsigned xb_xcc_id() { return (unsigned)__builtin_amdgcn_s_getreg((3 << 11) | 20) & 0xFu; }
#define XB_SPIN(cond, bar) do { unsigned _sp = 0; while (cond) { __builtin_amdgcn_s_sleep(1); \
    if ((++_sp & 255u) == 0u) { if (xb_ld(&(bar)[XB_TMO])) break; if (_sp > XB_SPIN_CAP) { atomicAdd(&(bar)[XB_TMO], 1u); break; } } } } while (0)

struct XcdBarrier {
    unsigned* bar; unsigned x;
    volatile LAS unsigned* st;
};

__device__ __forceinline__ XcdBarrier xcd_barrier_post(unsigned* bar, volatile LAS unsigned* st) {
    XcdBarrier b; b.bar = bar; b.x = xb_xcc_id(); b.st = st;
    if (threadIdx.x == 0) (void)xb_add(&bar[XB_XCNT(b.x)], 1u);
    return b;
}
__device__ __forceinline__ void xcd_barrier_complete(unsigned* bar, unsigned x, unsigned& nloc, unsigned& nx) {
    const unsigned G = gridDim.x * gridDim.y * gridDim.z;
    unsigned sum, cnt, mine, sp = 0u;
    for (;;) {
        sum = 0u; cnt = 0u; mine = 0u;
#pragma unroll
        for (unsigned j = 0; j < 16; ++j) { const unsigned c = xb_ld(&bar[XB_XCNT(j)]); sum += c; cnt += (c > 0u) ? 1u : 0u; mine = (j == x) ? c : mine; }
        if (sum == G) break;
        __builtin_amdgcn_s_sleep(1);
        if ((++sp & 255u) == 0u) { if (xb_ld(&bar[XB_TMO])) break; if (sp > XB_SPIN_CAP) { atomicAdd(&bar[XB_TMO], 1u); break; } }
    }
    nloc = mine > 0u ? mine : 1u; nx = cnt > 0u ? cnt : 1u;
}

__device__ __forceinline__ void xcd_barrier(const XcdBarrier& b) {
    asm volatile("s_waitcnt vmcnt(0)" ::: "memory");
    __syncthreads();
    if (threadIdx.x == 0) {
        unsigned* bar = b.bar;
        __builtin_amdgcn_s_waitcnt(0);
        unsigned nloc = b.st[0], nx = b.st[1];
        if (nloc == 0u) { xcd_barrier_complete(bar, b.x, nloc, nx); b.st[0] = nloc; b.st[1] = nx; }
        const unsigned old = xb_add(&bar[XB_XSUB(b.x)], 1u);
        const unsigned gen = old / nloc;
        if (old + 1u == (gen + 1u) * nloc) {
            __builtin_amdgcn_fence(__ATOMIC_RELEASE, "agent");
            asm volatile("s_waitcnt vmcnt(0)" ::: "memory");
            const unsigned og = xb_add(&bar[XB_TOP], 1u);
            const unsigned tg = og / nx;
            if (og + 1u == (tg + 1u) * nx) xb_add(&bar[XB_TOPGEN], 1u);
            else XB_SPIN(xb_ld(&bar[XB_TOPGEN]) == tg, bar);
            __builtin_amdgcn_fence(__ATOMIC_ACQUIRE, "agent");
            xb_add(&bar[XB_XGEN(b.x)], 1u);
            asm volatile("s_waitcnt vmcnt(0)" ::: "memory");
        } else {
            XB_SPIN(xb_ld(&bar[XB_XGEN(b.x)]) == gen, bar);
            __builtin_amdgcn_fence(__ATOMIC_ACQUIRE, "agent");
            asm volatile("s_waitcnt vmcnt(0)" ::: "memory");
        }
    }
    __syncthreads();
}

struct Frame {
    LAS unsigned char* lds;
    unsigned char* ws;
    u16* mix;
    int tid, lane, wave;
    int vcu, G;
};
__device__ __forceinline__ float wave_sum(float v) {
#pragma unroll
    for (int o = 1; o < 64; o <<= 1) v += __shfl_xor(v, o);
    return v;
}

#ifdef PROBE_PHASE
#define SUB_BEGIN(k) const unsigned long long sb0_##k = ((k) == PROBE_PHASE) ? __builtin_amdgcn_s_memrealtime() : 0ull
#define SUB_END(k) do { if ((k) == PROBE_PHASE) { const unsigned long long t1_ = __builtin_amdgcn_s_memrealtime(), dt_ = t1_ - sb0_##k; while (__builtin_amdgcn_s_memrealtime() - t1_ < (unsigned long long)(PROBE_MULT) * dt_) __builtin_amdgcn_s_sleep(8); } } while (0)
#else
#define SUB_BEGIN(k) do {} while (0)
#define SUB_END(k) do {} while (0)
#endif
__device__ __forceinline__ void p0_tr_item(const float* W, int ldw, int scol0, int nvalid, const float* gain, u16* WT, int K, int drow0, int k0, LAS float* scr, int lane) {
    f32x4 v[8];
#pragma unroll
    for (int i = 0; i < 8; ++i) { const int kk = 8 * i + (lane >> 3), n4 = 4 * (lane & 7);
        v[i] = (n4 + 3 < nvalid) ? *(const f32x4*)(W + (size_t)(k0 + kk) * ldw + scol0 + n4) : (f32x4){0.f, 0.f, 0.f, 0.f}; }
#pragma unroll
    for (int i = 0; i < 8; ++i) { const int kk = 8 * i + (lane >> 3), n4 = 4 * (lane & 7); const float gk = gain ? gain[k0 + kk] : 1.0f;
        scr[kk * 33 + n4 + 0] = v[i][0] * gk; scr[kk * 33 + n4 + 1] = v[i][1] * gk; scr[kk * 33 + n4 + 2] = v[i][2] * gk; scr[kk * 33 + n4 + 3] = v[i][3] * gk; }
    LDS_WAIT(); asm volatile("" ::: "memory");
    const int c = lane & 7;
#pragma unroll
    for (int j = 0; j < 4; ++j) { const int n = (lane >> 3) + 8 * j; const LAS float* s = scr + (8 * c) * 33 + n;
        v4u o; o.x = cvt_pk_f16(s[0 * 33], s[1 * 33]); o.y = cvt_pk_f16(s[2 * 33], s[3 * 33]); o.z = cvt_pk_f16(s[4 * 33], s[5 * 33]); o.w = cvt_pk_f16(s[6 * 33], s[7 * 33]);
        *(v4u*)(WT + (size_t)(drow0 + n) * K + k0 + 8 * c) = o; }
    LDS_WAIT(); asm volatile("" ::: "memory");
}
__constant__ unsigned char T5_BUCKET[128] = {0, 1, 2, 3, 4, 5, 6, 7, 8, 9, 10, 11, 12, 13, 14, 15, 16, 16, 16, 17, 17, 18, 18, 18, 19, 19, 19, 20, 20, 20, 20, 21, 21, 21, 21, 22, 22, 22, 22, 22, 23, 23, 23, 23, 23, 23, 24, 24, 24, 24, 24, 24, 25, 25, 25, 25, 25, 25, 25, 26, 26, 26, 26, 26, 26, 26, 26, 27, 27, 27, 27, 27, 27, 27, 27, 27, 27, 28, 28, 28, 28, 28, 28, 28, 28, 28, 28, 29, 29, 29, 29, 29, 29, 29, 29, 29, 29, 29, 29, 30, 30, 30, 30, 30, 30, 30, 30, 30, 30, 30, 30, 30, 30, 31, 31, 31, 31, 31, 31, 31, 31, 31, 31, 31, 31, 31, 31, 31};
struct P0Args { const float *x, *g_mix, *w_in, *rel_bias, *w_out, *g_ffn, *w_gate, *w_up, *w_down; };
template <int PART> __device__ __forceinline__ void p0_prologue(Frame& F, const P0Args& A, int widx, int wg0, int nwg) {
    LAS float* scr = (LAS float*)(F.lds + RING_OFF + F.wave * 16384);
    const int gw = (widx - wg0) * NWAVES + F.wave, NGW = nwg * NWAVES;
    if (widx < wg0 || widx >= wg0 + nwg) return;
    u16* WinT = (u16*)(F.ws + WS_WIN); u16* WoutT = (u16*)(F.ws + WS_WOUT); u16* WguT = (u16*)(F.ws + WS_WGU); u16* WdT = (u16*)(F.ws + WS_WD);
    constexpr int I_IN = 16 * (N_IN / 32), I_OUT = 16 * 32, I_GU = 16 * 176, I_D = 44 * 32, NITEMS = I_IN + I_OUT + I_GU + I_D;
    SUB_BEGIN(20);
    for (int it = (PART == 0 ? gw : I_IN + gw); it < (PART == 0 ? I_IN : NITEMS); it += NGW) {
        int r = it;
        if (r < I_IN) { const int kb = r / (N_IN / 32), nb = r % (N_IN / 32), drow0 = 32 * nb; int scol0, nvalid = 32;
            if (drow0 < 2048) scol0 = drow0; else if (drow0 < 4096) scol0 = 2120 + (drow0 - 2048); else { const int off = drow0 - 4096; scol0 = 2048 + off; nvalid = 72 - off; nvalid = nvalid < 0 ? 0 : (nvalid > 32 ? 32 : nvalid); }
            p0_tr_item(A.w_in, 4168, scol0, nvalid, A.g_mix, WinT, 1024, drow0, 64 * kb, scr, F.lane); continue; }
        r -= I_IN;
        if (r < I_OUT) { const int kb = r / 32, nb = r % 32; p0_tr_item(A.w_out, 1024, 32 * nb, 32, nullptr, WoutT, 1024, 32 * nb, 64 * kb, scr, F.lane); continue; }
        r -= I_OUT;
        if (r < I_GU) { const int kb = r / 176, nb = r % 176, t = nb >> 3, w = nb & 7;
            p0_tr_item(w < 4 ? A.w_gate : A.w_up, DFF, 128 * t + 32 * (w & 3), 32, A.g_ffn, WguT, 1024, 256 * t + 32 * w, 64 * kb, scr, F.lane); continue; }
        r -= I_GU;
        { const int kb = r / 32, nb = r % 32; p0_tr_item(A.w_down, 1024, 32 * nb, 32, nullptr, WdT, DFF, 32 * nb, 64 * kb, scr, F.lane); }
    }
    SUB_END(20);
    SUB_BEGIN(21);
    if (PART == 0) {
    u16* XH = (u16*)(F.ws + WS_XH); float* rinv1 = (float*)(F.ws + WS_RINV1);
    for (int m0 = gw; m0 < MTOK; m0 += 4 * NGW) {
        f32x4 v[4][4]; float ss[4];
#pragma unroll
        for (int r = 0; r < 4; ++r) { const int m = m0 + r * NGW < MTOK ? m0 + r * NGW : m0; const f32x4* xr = (const f32x4*)(A.x + (size_t)m * DM) + F.lane;
#pragma unroll
            for (int j = 0; j < 4; ++j) v[r][j] = xr[64 * j]; }
#pragma unroll
        for (int r = 0; r < 4; ++r) { float s = 0.f;
#pragma unroll
            for (int j = 0; j < 4; ++j) s += (v[r][j][0] * v[r][j][0] + v[r][j][1] * v[r][j][1]) + (v[r][j][2] * v[r][j][2] + v[r][j][3] * v[r][j][3]);
            ss[r] = wave_sum(s); }
#pragma unroll
        for (int r = 0; r < 4; ++r) { const int m = m0 + r * NGW; if (m < MTOK) {
            if (F.lane == 0) rinv1[m] = 1.0f / sqrtf(ss[r] * (1.0f / DM) + EPS);
            v2u* o = (v2u*)(XH + (size_t)m * DM) + F.lane;
#pragma unroll
            for (int j = 0; j < 4; ++j) { v2u h; h.x = cvt_pk_f16(v[r][j][0], v[r][j][1]); h.y = cvt_pk_f16(v[r][j][2], v[r][j][3]); o[64 * j] = h; } } }
    }
    }
    SUB_END(21);
    SUB_BEGIN(22);
    if (PART == 1) {
    f32x2* CS = (f32x2*)(F.ws + WS_CS);
    for (int e = (widx - wg0) * (NWAVES * 64) + F.tid; e < SEQ * 64; e += nwg * NWAVES * 64) {
        const int pos = e >> 6, i = e & 63;
        const float theta = (float)(1.0 / exp2((double)i * (13.287712379549449 / 63.0)));
        const float ang = (float)pos * theta;
        const double rev = (double)ang * 0.15915494309189535; const double fr = rev - rint(rev);
        const double a = fr * 6.283185307179586;
        CS[e] = (f32x2){(float)cos(a), (float)sin(a)};
    }
    }
    SUB_END(22);
    if (PART == 0 && blockIdx.x == 0) { float* BT = (float*)(F.ws + WS_BIAS);
        for (int e = F.tid; e < 8 * 128; e += NWAVES * 64) { const int h = e >> 7, d = e & 127; BT[e] = (A.rel_bias[(int)T5_BUCKET[d] * 8 + h] - A.rel_bias[31 * 8 + h]) * 1.4426950408889634f; } }
}

__device__ __forceinline__ void ki_layernorm(Frame& F, const float* ln_g, const float* ln_b) {
    const float* KIR = (const float*)(F.ws + WS_KIRAW); u16* KIH = (u16*)(F.ws + WS_KIH);
    for (int e = F.vcu * (NWAVES * 64) + F.tid; e < MTOK * 4; e += F.G * NWAVES * 64) {
        const int tok = e >> 2, part = e & 3; const f32x4* src = (const f32x4*)(KIR + (size_t)tok * 64 + part * 16);
        f32x4 v[4]; float s = 0.f;
#pragma unroll
        for (int j = 0; j < 4; ++j) { v[j] = src[j]; s += (v[j][0] + v[j][1]) + (v[j][2] + v[j][3]); }
        s += __shfl_xor(s, 1); s += __shfl_xor(s, 2);
        const float mu = s * (1.0f / 64.0f); float q = 0.f;
#pragma unroll
        for (int j = 0; j < 4; ++j) { v[j] = v[j] - mu; q += (v[j][0] * v[j][0] + v[j][1] * v[j][1]) + (v[j][2] * v[j][2] + v[j][3] * v[j][3]); }
        q += __shfl_xor(q, 1); q += __shfl_xor(q, 2);
        const float rs = 1.0f / sqrtf(q * (1.0f / 64.0f) + EPS);
        v2u* dst = (v2u*)(KIH + (size_t)tok * 64 + part * 16);
#pragma unroll
        for (int j = 0; j < 4; ++j) { const f32x4 g = *(const f32x4*)(ln_g + part * 16 + 4 * j), bb = *(const f32x4*)(ln_b + part * 16 + 4 * j); const f32x4 y = v[j] * rs * g + bb;
            v2u h; h.x = cvt_pk_f16(y[0], y[1]); h.y = cvt_pk_f16(y[2], y[3]); dst[j] = h; }
    }
}

constexpr int RP = 136;
constexpr int RT_BYTES = 128 * RP * 2;
__device__ __forceinline__ float ret_log2g(int h) { return log2f(1.0f - exp2f(-5.0f - (float)h)); }
template <bool TR, bool DECAY> __device__ __forceinline__ void ret_stage_rot(Frame& F, const u16* src  , int row0, int pos0, int h, LAS _Float16* dst, float lg) {
    const f32x2* CS = (const f32x2*)(F.ws + WS_CS);
#pragma unroll
    for (int it = 0; it < 2; ++it) { const int ch = F.tid + 512 * it;
        const int j = TR ? (ch & 127) : (ch >> 3), fc = TR ? (ch >> 7) : (ch & 7);
        const u16* p = src + (size_t)(row0 + j) * 512 + h * 128 + 8 * fc;
        const v4u a = *(const v4u*)p, b = *(const v4u*)(p + 64);
        const f32x4* cs = (const f32x4*)(CS + (size_t)(pos0 + j) * 64 + 8 * fc);
        const f32x4 c0 = cs[0], c1 = cs[1], c2 = cs[2], c3 = cs[3];
        const float co[8] = {c0[0], c0[2], c1[0], c1[2], c2[0], c2[2], c3[0], c3[2]}, si[8] = {c0[1], c0[3], c1[1], c1[3], c2[1], c2[3], c3[1], c3[3]};
        const unsigned aw[4] = {a.x, a.y, a.z, a.w}, bw[4] = {b.x, b.y, b.z, b.w};
        const float sc = DECAY ? exp2f(lg * (float)(127 - j)) : 1.0f;
        float o1[8], o2[8];
#pragma unroll
        for (int i = 0; i < 8; ++i) { const float x1 = h2f((u16)(aw[i >> 1] >> (16 * (i & 1)))), x2 = h2f((u16)(bw[i >> 1] >> (16 * (i & 1))));
            o1[i] = (x1 * co[i] - x2 * si[i]) * sc; o2[i] = (x2 * co[i] + x1 * si[i]) * sc; }
        if (TR) {
#pragma unroll
            for (int i = 0; i < 8; ++i) { dst[(8 * fc + i) * RP + j] = (_Float16)o1[i]; dst[(64 + 8 * fc + i) * RP + j] = (_Float16)o2[i]; }
        } else {
            v4u w1, w2; w1.x = cvt_pk_f16(o1[0], o1[1]); w1.y = cvt_pk_f16(o1[2], o1[3]); w1.z = cvt_pk_f16(o1[4], o1[5]); w1.w = cvt_pk_f16(o1[6], o1[7]);
            w2.x = cvt_pk_f16(o2[0], o2[1]); w2.y = cvt_pk_f16(o2[2], o2[3]); w2.z = cvt_pk_f16(o2[4], o2[5]); w2.w = cvt_pk_f16(o2[6], o2[7]);
            *(LAS v4u*)(dst + j * RP + 8 * fc) = w1; *(LAS v4u*)(dst + j * RP + 64 + 8 * fc) = w2; }
    }
}
__device__ __forceinline__ void ret_stage_vt(Frame& F, const u16* src, int row0, int h, LAS _Float16* dst) {
#pragma unroll
    for (int it = 0; it < 4; ++it) { const int ch = F.tid + 512 * it, j = ch & 127, fc = ch >> 7;
        const v4u a = *(const v4u*)(src + (size_t)(row0 + j) * 512 + h * 128 + 8 * fc); const unsigned aw[4] = {a.x, a.y, a.z, a.w};
#pragma unroll
        for (int i = 0; i < 8; ++i) dst[(8 * fc + i) * RP + j] = __builtin_bit_cast(_Float16, (u16)(aw[i >> 1] >> (16 * (i & 1)))); }
}
__device__ __forceinline__ void ret_r1_unit(Frame& F, int u) {
    const int bh = u >> 6, c = u & 63, b = bh >> 2, h = bh & 3, row0 = b * SEQ + c * 128, r32 = F.lane & 31, hi = F.lane >> 5;
    LAS _Float16* KT = (LAS _Float16*)(F.lds + RING_OFF); LAS _Float16* VT = (LAS _Float16*)(F.lds + RING_OFF + RT_BYTES);
    ret_stage_rot<true, true>(F, (const u16*)(F.ws + WS_KB), row0, c * 128, h, KT, ret_log2g(h));
    ret_stage_vt(F, (const u16*)(F.ws + WS_VB), row0, h, VT);
    __syncthreads();
    const int eb = F.wave >> 1, db0 = 2 * (F.wave & 1);
    f32x16 acc0 = {}, acc1 = {};
#pragma unroll
    for (int s = 0; s < 8; ++s) {
        const f16x8 a = *(const LAS f16x8*)(VT + (32 * eb + r32) * RP + 16 * s + 8 * hi);
        const f16x8 b0 = *(const LAS f16x8*)(KT + (32 * db0 + r32) * RP + 16 * s + 8 * hi);
        const f16x8 b1 = *(const LAS f16x8*)(KT + (32 * (db0 + 1) + r32) * RP + 16 * s + 8 * hi);
        acc0 = __builtin_amdgcn_mfma_f32_32x32x16_f16(a, b0, acc0, 0, 0, 0);
        acc1 = __builtin_amdgcn_mfma_f32_32x32x16_f16(a, b1, acc1, 0, 0, 0);
    }
    float* DS = (float*)(F.ws + WS_DS) + (size_t)u * 16384;
#pragma unroll
    for (int r = 0; r < 16; ++r) { const int e = 32 * eb + crow(r, hi); DS[e * 128 + 32 * db0 + r32] = acc0[r]; DS[e * 128 + 32 * (db0 + 1) + r32] = acc1[r]; }
    __syncthreads();
}
__device__ __forceinline__ void ret_r2_scan(Frame& F) {
    const float* DS = (const float*)(F.ws + WS_DS); u16* ST = (u16*)(F.ws + WS_ST);
    for (int e = F.vcu * (NWAVES * 64) + F.tid; e < 16 * 8192; e += F.G * NWAVES * 64) {
        const int bh = e >> 13, off = (e & 8191) * 2; const float dec = exp2f(128.0f * ret_log2g(bh & 3));
        float s0 = 0.f, s1 = 0.f;
#pragma unroll 8
        for (int c = 0; c < 64; ++c) { const size_t o = ((size_t)(bh * 64 + c)) * 16384 + off;
            *(unsigned*)(ST + o) = cvt_pk_f16(s0, s1);
            const f32x2 d = *(const f32x2*)(DS + o); s0 = dec * s0 + d[0]; s1 = dec * s1 + d[1]; }
    }
}
__device__ __forceinline__ void ret_r3_unit(Frame& F, int u, const float* gn_g) {
    const int bh = u >> 6, c = u & 63, b = bh >> 2, h = bh & 3, row0 = b * SEQ + c * 128, r32 = F.lane & 31, hi = F.lane >> 5;
    LAS _Float16* Qs = (LAS _Float16*)(F.lds + RING_OFF); LAS _Float16* Ks = (LAS _Float16*)(F.lds + RING_OFF + RT_BYTES);
    LAS _Float16* VT = (LAS _Float16*)(F.lds + RING_OFF + 2 * RT_BYTES); LAS _Float16* Ps = (LAS _Float16*)(F.lds + RING_OFF + 3 * RT_BYTES);
    LAS float* rowpart = (LAS float*)(F.lds + 2048);
    const float lg = ret_log2g(h);
    const int ib = F.wave >> 1, xb0 = 2 * (F.wave & 1);
    SUB_BEGIN(30);
    ret_stage_rot<false, false>(F, (const u16*)(F.ws + WS_QB), row0, c * 128, h, Qs, lg);
    ret_stage_rot<false, false>(F, (const u16*)(F.ws + WS_KB), row0, c * 128, h, Ks, lg);
    ret_stage_vt(F, (const u16*)(F.ws + WS_VB), row0, h, VT);
    __syncthreads();
    SUB_END(30);
    SUB_BEGIN(31);
#pragma unroll
    for (int t = 0; t < 2; ++t) { const int jb = xb0 + t; f32x16 acc = {};
        if (jb <= ib) {
#pragma unroll
            for (int s = 0; s < 8; ++s) { const f16x8 a = *(const LAS f16x8*)(Qs + (32 * ib + r32) * RP + 16 * s + 8 * hi); const f16x8 bb = *(const LAS f16x8*)(Ks + (32 * jb + r32) * RP + 16 * s + 8 * hi);
                acc = __builtin_amdgcn_mfma_f32_32x32x16_f16(a, bb, acc, 0, 0, 0); } }
        const int j = 32 * jb + r32;
#pragma unroll
        for (int r = 0; r < 16; ++r) { const int i = 32 * ib + crow(r, hi); const float v = (i >= j) ? acc[r] * exp2f(lg * (float)(i - j)) : 0.f; Ps[i * RP + j] = (_Float16)v; } }
    __syncthreads();
    SUB_END(31);
    SUB_BEGIN(32);
    const u16* ST = (const u16*)(F.ws + WS_ST) + (size_t)u * 16384;
    f32x16 y[2];
#pragma unroll
    for (int t = 0; t < 2; ++t) { const int eb = xb0 + t; f32x16 intra = {}, cross = {};
#pragma unroll
        for (int s = 0; s < 8; ++s) { if (s < 2 * (ib + 1)) { const f16x8 a = *(const LAS f16x8*)(Ps + (32 * ib + r32) * RP + 16 * s + 8 * hi); const f16x8 bb = *(const LAS f16x8*)(VT + (32 * eb + r32) * RP + 16 * s + 8 * hi);
                intra = __builtin_amdgcn_mfma_f32_32x32x16_f16(a, bb, intra, 0, 0, 0); } }
#pragma unroll
        for (int s = 0; s < 8; ++s) { const f16x8 a = *(const LAS f16x8*)(Qs + (32 * ib + r32) * RP + 16 * s + 8 * hi); const f16x8 bb = *(const f16x8*)(ST + (32 * eb + r32) * 128 + 16 * s + 8 * hi);
            cross = __builtin_amdgcn_mfma_f32_32x32x16_f16(a, bb, cross, 0, 0, 0); }
#pragma unroll
        for (int r = 0; r < 16; ++r) { const int i = 32 * ib + crow(r, hi); y[t][r] = intra[r] + exp2f(lg * (float)(i + 1)) * cross[r]; } }
    SUB_END(32);
    SUB_BEGIN(33);
    float ss[16];
#pragma unroll
    for (int r = 0; r < 16; ++r) { float v = y[0][r] * y[0][r] + y[1][r] * y[1][r];
#pragma unroll
        for (int o = 1; o < 32; o <<= 1) v += __shfl_xor(v, o);
        ss[r] = v; }
    __syncthreads();
#pragma unroll
    for (int r = 0; r < 16; ++r) { const int i = 32 * ib + crow(r, hi);
#pragma unroll
        for (int t = 0; t < 2; ++t) Ps[i * RP + 32 * (xb0 + t) + r32] = (_Float16)y[t][r]; }
    if (r32 == 0) {
#pragma unroll
        for (int r = 0; r < 16; ++r) rowpart[(F.wave & 1) * 128 + 32 * ib + crow(r, hi)] = ss[r]; }
    __syncthreads();
    { const u16* GBp = (const u16*)(F.ws + WS_GB); u16* MIX = F.mix;
#pragma unroll
      for (int it = 0; it < 4; ++it) { const int ch = F.tid + 512 * it, i = ch >> 4, ec = ch & 15;
          const float rinv = 1.0f / sqrtf((rowpart[i] + rowpart[128 + i]) * (1.0f / 128.0f) + EPS);
          const v4u yv = *(const LAS v4u*)(Ps + i * RP + 8 * ec), gv = *(const v4u*)(GBp + (size_t)(row0 + i) * 512 + h * 128 + 8 * ec);
          const f32x4 g0 = *(const f32x4*)(gn_g + h * 128 + 8 * ec), g1 = *(const f32x4*)(gn_g + h * 128 + 8 * ec + 4);
          const unsigned yw[4] = {yv.x, yv.y, yv.z, yv.w}, gw[4] = {gv.x, gv.y, gv.z, gv.w}; float o[8];
#pragma unroll
          for (int k = 0; k < 8; ++k) o[k] = h2f((u16)(yw[k >> 1] >> (16 * (k & 1)))) * rinv * (k < 4 ? g0[k & 3] : g1[k & 3]) * h2f((u16)(gw[k >> 1] >> (16 * (k & 1))));
          v4u w; w.x = cvt_pk_f16(o[0], o[1]); w.y = cvt_pk_f16(o[2], o[3]); w.z = cvt_pk_f16(o[4], o[5]); w.w = cvt_pk_f16(o[6], o[7]);
          *(v4u*)(MIX + (size_t)(row0 + i) * 1024 + 512 + h * 128 + 8 * ec) = w; } }
    SUB_END(33);
    __syncthreads();
}

constexpr int IDX_CAP = 64, IDX_SEG = 28, IDX_LCAP = 16 * IDX_SEG, IDX_OVF = 64;
struct IdxSt { unsigned lo, hi, need, shift, cnt, above, ready, pad; };
__device__ __forceinline__ unsigned ok_key(float s) { const unsigned u = __builtin_bit_cast(unsigned, s); return u ^ ((unsigned)((int)u >> 31) | 0x80000000u); }

__device__ __forceinline__ void lds_add(LAS unsigned* p, unsigned v) { (void)__hip_atomic_fetch_add(p, v, __ATOMIC_RELAXED, __HIP_MEMORY_SCOPE_WORKGROUP); }
__device__ __forceinline__ unsigned lds_add_rtn(LAS unsigned* p, unsigned v) { return __hip_atomic_fetch_add(p, v, __ATOMIC_RELAXED, __HIP_MEMORY_SCOPE_WORKGROUP); }
__device__ __forceinline__ void idx_unit(Frame& F, int b, int g) {
    int lane_u = F.lane; asm volatile("" : "+v"(lane_u));
    const int lane = lane_u, wid = F.wave, l15 = lane & 15, fq = lane >> 4, set = wid >> 2, wsub = wid & 3;
    const int q0 = 32 * g, NT64 = 4 * (g >> 3) + 4, qloc = 16 * set + l15, qpos = q0 + qloc;
    unsigned* BMu = (unsigned*)(F.ws + WS_BM) + ((size_t)(b * 256 + g) * 128) * 64;
    if (g < 8) {
        const int r32 = lane & 31, hi = lane >> 5;
        for (int T = wid; T < NT64; T += 8) { unsigned w = 0u; const int lim = q0 + r32 - 64 * T - 4 * hi;
#pragma unroll 1
            for (int gi = 0; gi < 8; ++gi) { int c = lim - 8 * (gi & 3) - 32 * (gi >> 2) + 1; c = c < 0 ? 0 : (c > 4 ? 4 : c); w |= ((1u << c) - 1u) << (4 * gi); }
            BMu[T * 64 + lane] = w; }
        return;
    }
    LAS unsigned* hist = (LAS unsigned*)(F.lds + RING_OFF);
    LAS unsigned* okarr = hist;
    LAS u16* keyarr = (LAS u16*)(hist + 32 * IDX_LCAP);
    LAS unsigned* ovf = hist + 32 * IDX_LCAP + 16 * IDX_LCAP;
    LAS unsigned* img = ovf + 32 * IDX_OVF * 2;
    volatile LAS unsigned* segcnt = (volatile LAS unsigned*)(F.lds + 2048);
    volatile LAS IdxSt* st = (volatile LAS IdxSt*)(F.lds + 1024);
    volatile LAS unsigned* flag = (volatile LAS unsigned*)(F.lds + 512);
    const size_t row = (size_t)b * SEQ + qpos;
    const u16* QI = (const u16*)(F.ws + WS_QI) + row * 512; const float* WI = (const float*)(F.ws + WS_WI) + row * 8;
    const u16* KIb = (const u16*)(F.ws + WS_KIH) + (size_t)b * SEQ * 64;
    float ch[8];
    { const f32x4 w0 = *(const f32x4*)WI, w1 = *(const f32x4*)(WI + 4);
      const float ssq_ = ((w0[0] * w0[0] + w0[1] * w0[1]) + (w0[2] * w0[2] + w0[3] * w0[3])) + ((w1[0] * w1[0] + w1[1] * w1[1]) + (w1[2] * w1[2] + w1[3] * w1[3]));
      const float fac_ = 0.0625f * 90.5f / sqrtf(ssq_ > 1e-30f ? ssq_ : 1e-30f);
      for (int j = 0; j < 4; ++j) { ch[j] = w0[j] * fac_; ch[4 + j] = w1[j] * fac_; } }
    f16x8 qf[8][2], qt[2];
#pragma unroll
    for (int h = 0; h < 8; ++h)
#pragma unroll
        for (int s = 0; s < 2; ++s) qf[h][s] = *(const f16x8*)(QI + h * 64 + 32 * s + 8 * fq);
#pragma unroll
    for (int s = 0; s < 2; ++s) {
#pragma unroll
        for (int i = 0; i < 8; ++i) { float a = 0.f;
#pragma unroll
            for (int h = 0; h < 8; ++h) a += ch[h] * (float)qf[h][s][i];
            qt[s][i] = (_Float16)a; } }
    const int nT = (g >> 1) + 1;
#define IDX_TILE(k0_, k1_, sc) do { \
        sc = __builtin_amdgcn_mfma_f32_16x16x32_f16(k0_, qt[0], (f32x4){0.f, 0.f, 0.f, 0.f}, 0, 0, 0); sc = __builtin_amdgcn_mfma_f32_16x16x32_f16(k1_, qt[1], sc, 0, 0, 0); \
        _Pragma("unroll") for (int h = 0; h < 8; ++h) { f32x4 dh_ = __builtin_amdgcn_mfma_f32_16x16x32_f16(k0_, qf[h][0], (f32x4){0.f, 0.f, 0.f, 0.f}, 0, 0, 0); dh_ = __builtin_amdgcn_mfma_f32_16x16x32_f16(k1_, qf[h][1], dh_, 0, 0, 0); \
            _Pragma("unroll") for (int i = 0; i < 4; ++i) sc[i] = __builtin_fmaf(__builtin_fabsf(dh_[i]), ch[h], sc[i]); } } while (0)
#define IDX_TILE_NS(k0_, k1_, sc) do {   \
        sc = __builtin_amdgcn_mfma_f32_16x16x32_f16(k0_, qt[0], (f32x4){0.f, 0.f, 0.f, 0.f}, 0, 0, 0); sc = __builtin_amdgcn_mfma_f32_16x16x32_f16(k1_, qt[1], sc, 0, 0, 0); \
        _Pragma("unroll") for (int h = 0; h < 8; ++h) { f32x4 dh_ = __builtin_amdgcn_mfma_f32_16x16x32_f16(k0_, qf[h][0], (f32x4){0.f, 0.f, 0.f, 0.f}, 0, 0, 0); dh_ = __builtin_amdgcn_mfma_f32_16x16x32_f16(k1_, qf[h][1], dh_, 0, 0, 0); \
            _Pragma("unroll") for (int i = 0; i < 4; ++i) { float a_ = __builtin_fmaf(__builtin_fabsf(dh_[i]), ch[h], sc[i]); if (i) asm("" : "+v"(a_)); sc[i] = a_; } } } while (0)
#define IDX_KTILE(dst, T, m) do { const u16* kp_ = KIb + (size_t)(64 * (T) + 16 * (m) + l15_) * 64 + 8 * fq_; dst[0] = *(const f16x8*)kp_; dst[1] = *(const f16x8*)(kp_ + 32); } while (0)

    const int floorb = 0;
#pragma unroll 1
    for (int attempt = (g >= 16) ? 0 : 1; attempt < 2; ++attempt) {
        const bool sampled = (attempt == 0);
        for (int i = F.tid; i < 8192; i += NWAVES * 64) ((LAS v4u*)hist)[i] = (v4u){0u, 0u, 0u, 0u};
        if (F.tid < 32) { st[F.tid].lo = 0u; st[F.tid].hi = 0xFFFFFFFFu; st[F.tid].need = 256u; st[F.tid].shift = 0u; st[F.tid].cnt = 0u; st[F.tid].above = 0u; st[F.tid].ready = 0u; st[F.tid].pad = 0u; }
        if (F.tid < 2) flag[F.tid] = 0u;
        __syncthreads();
        for (int level = 0; level < 8; ++level) {
            int l15_ = l15, fq_ = fq; asm volatile("" : "+v"(l15_), "+v"(fq_)); const int qloc_ = 16 * set + l15_; LAS unsigned* hq = hist + qloc_ * 1024;
            const unsigned rdy = st[qloc_].ready, lo = rdy ? 1u : st[qloc_].lo, width = rdy ? 0u : st[qloc_].hi - lo, sh = st[qloc_].shift;
            LDS_WAIT();
            const int Tstep = sampled ? 16 : 4, fl_ = sampled ? 0 : floorb;
            f16x8 kc[4][2];
#pragma unroll
            for (int m = 0; m < 4; ++m) IDX_KTILE(kc[m], wsub < nT ? wsub : 0, m);
            if (level == 0) {
                for (int T = wsub; T < nT; T += Tstep) { const int Tn = T + Tstep < nT ? T + Tstep : T;
#pragma unroll
                    for (int m = 0; m < 4; ++m) { const int kt = 64 * T + 16 * m;
                        f32x4 sc; IDX_TILE(kc[m][0], kc[m][1], sc);
                        IDX_KTILE(kc[m], Tn, m);
                        const int lim = qpos - kt - 4 * fq_;
#pragma unroll
                        for (int i = 0; i < 4; ++i) { int bin = (int)__builtin_floorf(sc[i]) + 512; bin = bin < 0 ? 0 : (bin > 1023 ? 1023 : bin);
                            if ((bin >= fl_) & (i <= lim)) lds_add(hq + bin, 1u); } } }
            } else {
                for (int T = wsub; T < nT; T += 4) { const int Tn = T + 4 < nT ? T + 4 : T;
#pragma unroll
                    for (int m = 0; m < 4; ++m) { const int kt = 64 * T + 16 * m;
                        f32x4 sc; IDX_TILE(kc[m][0], kc[m][1], sc);
                        IDX_KTILE(kc[m], Tn, m);
                        const int lim = qpos - kt - 4 * fq_;
#pragma unroll
                        for (int i = 0; i < 4; ++i) { const unsigned d = ok_key(sc[i]) - lo; unsigned bin = d >> sh; bin = bin > 1023u ? 1023u : bin;
                            if ((d <= width) & (i <= lim)) lds_add(hq + bin, 1u); } } }
            }
            __syncthreads();
#pragma unroll 1
            for (int qq = 0; qq < 4; ++qq) { const int q = 4 * wid + qq; if (st[q].ready) continue;
                int ln = lane; asm volatile("" : "+v"(ln));
                LAS unsigned* hw = hist + q * 1024 + 16 * ln; unsigned wv[16]; unsigned s_ = 0u;
#pragma unroll
                for (int i = 0; i < 16; ++i) { wv[i] = hw[i]; s_ += wv[i]; }
                unsigned suf = s_;
#pragma unroll
                for (int o = 1; o < 64; o <<= 1) { const unsigned t = __shfl_down(suf, o); if (ln + o < 64) suf += t; }
                const unsigned total = __shfl(suf, 0), aboveL = suf - s_;
                const unsigned qlo = st[q].lo, qhi = st[q].hi, qsh = st[q].shift, qneed = st[q].need;
                if (sampled) {
                    const int p_ = q0 + q, tm_ = p_ >> 6; const int ns_ = 64 * (4 * (tm_ >> 4) + ((tm_ & 15) < 4 ? (tm_ & 15) : 4)) + (((tm_ & 15) < 4) ? (p_ & 63) + 1 : 0);
                    const float f_ = (float)ns_ / (float)(p_ + 1), mean_ = 256.0f * f_, sd_ = sqrtf(256.0f * f_ * (1.0f - f_));
                    const int rhi_ = (int)(mean_ - 4.0f * sd_), rlo_ = (int)(mean_ + 4.0f * sd_) + 1; const unsigned thi_ = rhi_ < 1 ? 1u : (unsigned)rhi_, tlo_ = (unsigned)rlo_;
                    if (total < tlo_) { if (ln == 0) flag[1] = 1u; }
                    else {
#pragma unroll 1
                        for (int which = 0; which < 2; ++which) { const unsigned tgt = which ? tlo_ : thi_;
                            if (aboveL < tgt && tgt <= aboveL + s_) { unsigned accu = aboveL, bin = 0u; bool found = false;
#pragma unroll
                                for (int i = 15; i >= 0; --i) { if (!found && accu + wv[i] >= tgt) { found = true; bin = 16u * (unsigned)ln + i; } if (!found) accu += wv[i]; }
                                if (which) st[q].lo = ok_key((float)((int)bin - 512)); else st[q].hi = (bin == 1023u) ? 0xFFFFFFFFu : ok_key((float)((int)bin - 511)) - 1u; } }
                    }
                    if (ln == 0) st[q].ready = 1u;
                } else if (qneed > total) {
                    if (ln == 0) { if (level == 0) { st[q].hi = ok_key((float)(floorb - 512)) - 1u; st[q].lo = 0u; } else { st[q].hi = qlo - 1u; st[q].lo = 0u; } st[q].need = qneed - total; } }
                else if (aboveL < qneed && qneed <= aboveL + s_) {
                    unsigned accu = aboveL, bin = 0u, cbin = 0u; bool found = false;
#pragma unroll
                    for (int i = 15; i >= 0; --i) { if (!found && accu + wv[i] >= qneed) { found = true; bin = 16u * (unsigned)ln + i; cbin = wv[i]; } if (!found) accu += wv[i]; }
                    unsigned nlo, nhi;
                    if (level == 0) { nlo = (bin == 0u) ? 0u : ok_key((float)((int)bin - 512)); nhi = (bin == 1023u) ? 0xFFFFFFFFu : ok_key((float)((int)bin - 511)) - 1u; }
                    else { nlo = qlo + (bin << qsh); nhi = nlo + ((1u << qsh) - 1u); if (nhi < nlo || nhi > qhi || bin == 1023u) nhi = qhi; }
                    st[q].lo = nlo; st[q].hi = nhi; st[q].need = qneed - accu;
                    if (cbin <= (unsigned)IDX_CAP || (level > 0 && qsh == 0u)) st[q].ready = 1u; }
                LDS_WAIT();
                if (!st[q].ready) { const unsigned w_ = st[q].hi - st[q].lo; const unsigned nb = 32u - (unsigned)__builtin_clz(w_ | 1u); if (ln == 0) { st[q].shift = nb > 10u ? nb - 10u : 0u; flag[0] = 1u; } }
#pragma unroll
                for (int i = 0; i < 16; ++i) hw[i] = 0u;
            }
            __syncthreads();
            const unsigned again = flag[0];
            __syncthreads();
            if (F.tid == 0) flag[0] = 0u;
            if (!again) break;
        }
        { const unsigned fail_ = flag[1]; __syncthreads(); if (sampled && fail_) continue; }
        {
            int l15_ = l15, fq_ = fq; asm volatile("" : "+v"(l15_), "+v"(fq_)); const int qloc_ = 16 * set + l15_;
            const unsigned lo = st[qloc_].lo, hiK = st[qloc_].hi, width = hiK - lo;
            LDS_WAIT();
            float flo = __builtin_bit_cast(float, (lo & 0x80000000u) ? (lo ^ 0x80000000u) : ~lo), fhi = __builtin_bit_cast(float, (hiK & 0x80000000u) ? (hiK ^ 0x80000000u) : ~hiK);
            if (!(flo == flo)) flo = -INFINITY; if (!(fhi == fhi)) fhi = INFINITY;
            const int seg_ = wsub * 4 + fq_; LAS unsigned* okl = okarr + qloc_ * IDX_LCAP + seg_ * IDX_SEG; LAS u16* keyl = keyarr + qloc_ * IDX_LCAP + seg_ * IDX_SEG;
            unsigned nabove = 0u, mycnt = 0u;
            f16x8 kc[4][2];
#pragma unroll
            for (int m = 0; m < 4; ++m) IDX_KTILE(kc[m], wsub < nT ? wsub : 0, m);
            for (int T = wsub; T < NT64; T += 4) { unsigned part = 0u;
                if (T < nT) { const int Tn = T + 4 < nT ? T + 4 : T; const bool diag = (64 * T + 63 > q0);
#pragma unroll
                    for (int m = 0; m < 4; ++m) { const int kt = 64 * T + 16 * m;
                        f32x4 sc; IDX_TILE_NS(kc[m][0], kc[m][1], sc);
                        IDX_KTILE(kc[m], Tn, m);
                        if (diag) { const int lim = qpos - kt - 4 * fq_;
#pragma unroll
                            for (int i = 0; i < 4; ++i) sc[i] = (i <= lim) ? sc[i] : __builtin_nanf(""); }
                        const unsigned kb = (unsigned)(kt + 4 * fq_);
                        if (__builtin_amdgcn_ballot_w64(mycnt > (unsigned)(IDX_SEG - 4)) != 0ull) {
#pragma unroll
                            for (int i = 0; i < 4; ++i) { const bool sure = sc[i] > fhi;
                                part |= sure ? (1u << (16 * (m >> 1) + 8 * (m & 1) + i)) : 0u;
                                if ((sc[i] >= flo) & !sure) { if (mycnt < (unsigned)IDX_SEG) { okl[mycnt] = ok_key(sc[i]); keyl[mycnt] = (u16)(kb + i); }
                                    else { const unsigned pos = lds_add_rtn((LAS unsigned*)&st[qloc_].pad, 1u); if (pos < (unsigned)IDX_OVF) { ovf[(qloc_ * IDX_OVF + pos) * 2] = ok_key(sc[i]); ovf[(qloc_ * IDX_OVF + pos) * 2 + 1] = kb + i; } }
                                    mycnt += 1u; } }
                        } else {
#pragma unroll
                            for (int i = 0; i < 4; ++i) { const bool sure = sc[i] > fhi;
                                part |= sure ? (1u << (16 * (m >> 1) + 8 * (m & 1) + i)) : 0u;
                                okl[mycnt] = ok_key(sc[i]); keyl[mycnt] = (u16)(kb + i);
                                mycnt += ((sc[i] >= flo) & !sure) ? 1u : 0u; } }
                    }
                    nabove += (unsigned)__builtin_popcount(part);
                }
                part <<= 4 * (fq_ >> 1);
                const unsigned word = part | (unsigned)__shfl_xor((int)part, 32);
                if (fq_ < 2) img[T * 64 + qloc_ + 32 * (fq_ & 1)] = word; }
            lds_add((LAS unsigned*)&st[qloc_].above, nabove); lds_add((LAS unsigned*)&st[qloc_].cnt, mycnt);
            segcnt[qloc_ * 16 + seg_] = mycnt < (unsigned)IDX_SEG ? mycnt : (unsigned)IDX_SEG;
        }
        __syncthreads();
        if (sampled) {
            if (F.tid < 32) { const unsigned a = st[F.tid].above, c = st[F.tid].cnt; if (!(a < 256u && a + c >= 256u && st[F.tid].pad <= (unsigned)IDX_OVF)) flag[1] = 1u; else st[F.tid].need = 256u - a; }
            __syncthreads();
            const unsigned fail_ = flag[1]; __syncthreads();
            if (fail_) continue;
        }
#pragma unroll 1
        for (int qq = 0; qq < 4; ++qq) { int ln = lane; asm volatile("" : "+v"(ln)); const int q = 4 * wid + qq;
            const unsigned need = st[q].need;
            const LAS unsigned* lw = okarr + q * IDX_LCAP; const LAS u16* lk = keyarr + q * IDX_LCAP;
            const LAS unsigned* lo_ = ovf + q * IDX_OVF * 2; const unsigned novf = st[q].pad < (unsigned)IDX_OVF ? st[q].pad : (unsigned)IDX_OVF;
            unsigned ek[8];
#pragma unroll
            for (int k = 0; k < 7; ++k) { const unsigned j = (unsigned)ln + 64u * k; ek[k] = ((j % IDX_SEG) < segcnt[q * 16 + (j / IDX_SEG)]) ? lw[j] : 0u; }
            ek[7] = ((unsigned)ln < novf) ? lo_[2 * ln] : 0u;
            const unsigned rlo_ = st[q].lo, rhi_ = st[q].hi; const int topbit = 31 - (int)__builtin_clz((rlo_ ^ rhi_) | 1u);
            unsigned Tv = (topbit >= 31) ? 0u : (rlo_ & ~((2u << topbit) - 1u));
#pragma unroll 1
            for (int bit = topbit; bit >= 0; --bit) { const unsigned cand = Tv | (1u << bit); unsigned c = 0u;
#pragma unroll
                for (int k = 0; k < 8; ++k) c += (unsigned)__popcll(__ballot(ek[k] >= cand));
                if (c >= need) Tv = cand; }
            unsigned cgt = 0u, ceq = 0u;
#pragma unroll
            for (int k = 0; k < 8; ++k) { cgt += (unsigned)__popcll(__ballot(ek[k] > Tv)); ceq += (unsigned)__popcll(__ballot(ek[k] == Tv && ek[k] != 0u)); }
            const unsigned need_eq = need > cgt ? need - cgt : 0u;
#pragma unroll
            for (int k = 0; k < 8; ++k) { bool sel = ek[k] > Tv; const unsigned myj = (unsigned)ln + 64u * k;
                const unsigned mykey = (k < 7) ? (unsigned)lk[myj < (unsigned)IDX_LCAP ? myj : 0u] : lo_[2 * ln + 1];
                if (ek[k] == Tv && ek[k] != 0u) { if (need_eq >= ceq) sel = true; else { unsigned rk = 0u;
                        for (unsigned j = 0; j < (unsigned)IDX_LCAP; ++j) rk += ((j % IDX_SEG) < segcnt[q * 16 + (j / IDX_SEG)] && lw[j] == Tv && lk[j] < mykey) ? 1u : 0u;
                        for (unsigned j = 0; j < novf; ++j) rk += (lo_[2 * j] == Tv && lo_[2 * j + 1] < mykey) ? 1u : 0u; sel = rk < need_eq; } }
                if (sel) { const unsigned ki = mykey, T = ki >> 6, k64 = ki & 63u, half = k64 >> 5, k32 = k64 & 31u, khi = (k32 >> 2) & 1u, r = (k32 & 3u) + 4u * (k32 >> 3);
                    (void)__hip_atomic_fetch_or(img + T * 64 + (unsigned)q + 32u * khi, 1u << (16u * half + r), __ATOMIC_RELAXED, __HIP_MEMORY_SCOPE_WORKGROUP); } }
        }
        __syncthreads();
        { int t_ = F.tid; asm volatile("" : "+v"(t_)); for (int i = t_; i < NT64 * 16; i += NWAVES * 64) ((v4u*)BMu)[i] = ((const LAS v4u*)img)[i]; }
        break;
    }
    __syncthreads();
#undef IDX_TILE
#undef IDX_TILE_NS
#undef IDX_KTILE
}

__device__ __forceinline__ void final_norm(Frame& F, float* out, const float* part, const float* gfin) {
    const int gw = F.vcu * NWAVES + F.wave, NGW = F.G * NWAVES;
    for (int m = gw; m < MTOK; m += NGW) {
        float p = (F.lane < 16) ? part[(size_t)m * 16 + F.lane] : 0.f; p = wave_sum(p);
        const float r = 1.0f / sqrtf(p * (1.0f / DM) + EPS);
        f32x4* xr = (f32x4*)(out + (size_t)m * DM) + F.lane; const f32x4* gr = (const f32x4*)gfin + F.lane;
#pragma unroll
        for (int j = 0; j < 4; ++j) { const f32x4 v = xr[64 * j] * r * gr[64 * j]; xr[64 * j] = v; }
    }
}

struct Args { const float* in[13]; float* out; unsigned char* ws; int ph_lo, ph_hi, li, pad; };
__global__ void __launch_bounds__(NWAVES * 64, 2) hymba_fwd(Args args) {
    extern __shared__ __attribute__((aligned(16))) unsigned char lds_raw[];
    Frame F;
    F.lds = (LAS unsigned char*)lds_raw; F.ws = args.ws; F.mix = (u16*)args.out;
    F.tid = threadIdx.x; F.lane = F.tid & 63; F.wave = __builtin_amdgcn_readfirstlane(F.tid >> 6);
    F.G = gridDim.x; { const int bx = blockIdx.x; F.vcu = (F.G % 8 == 0) ? (bx % 8) * (F.G / 8) + bx / 8 : bx; }
    for (int u = F.tid; u < LCTL_BYTES / 4; u += NWAVES * 64) ((LAS unsigned*)F.lds)[u] = 0u;
    __syncthreads();
    gu32* ctl = (gu32*)(args.ws + WS_CTL);
    XcdBarrier bar; bar.bar = (unsigned*)(ctl + CW_BAR) + args.li * XCD_BAR_WORDS; bar.x = 0; bar.st = nullptr;
    if (N_LAUNCHES != N_PHASES) bar = xcd_barrier_post((unsigned*)(ctl + CW_BAR) + args.li * XCD_BAR_WORDS, (volatile LAS unsigned*)(F.lds + 64));
#define GRID_BAR() do { if (N_LAUNCHES != N_PHASES) xcd_barrier(bar); } while (0)
    const int lo = args.ph_lo, hi = args.ph_hi;
#ifndef PHASE_MASK
#define PHASE_MASK 0x1ff
#endif
#define IN(k) (((PHASE_MASK >> (k)) & 1) && lo <= (k) && (k) < hi)
#define BOTH(k) (IN(k) && IN((k) + 1))
#define PH_TID() do { int t_ = threadIdx.x; asm volatile("" : "+v"(t_)); F.tid = t_; F.lane = t_ & 63; F.wave = __builtin_amdgcn_readfirstlane(t_ >> 6); } while (0)
#ifdef PROBE_PHASE
#define PH_BEGIN(k) const unsigned long long t0_##k = ((k) == PROBE_PHASE) ? __builtin_amdgcn_s_memrealtime() : 0ull
#define PH_END(k) do { if ((k) == PROBE_PHASE) { const unsigned long long t1_ = __builtin_amdgcn_s_memrealtime(), dt_ = t1_ - t0_##k; while (__builtin_amdgcn_s_memrealtime() - t1_ < (unsigned long long)(PROBE_MULT) * dt_) __builtin_amdgcn_s_sleep(8); } } while (0)
#else
#define PH_BEGIN(k) do {} while (0)
#define PH_END(k) do {} while (0)
#endif
    const float* x = args.in[0];
    unsigned char* ws = args.ws;
    LAS unsigned char* ring = F.lds + RING_OFF;

    if (IN(0)) { PH_TID(); PH_BEGIN(0);
        P0Args A{x, args.in[1], args.in[2], args.in[5], args.in[7], args.in[8], args.in[9], args.in[10], args.in[11]};
        p0_prologue<0>(F, A, F.vcu, 0, F.G);
        if (F.G != 256) p0_prologue<1>(F, A, F.vcu, 0, F.G);
        PH_END(0);
        if (BOTH(0)) GRID_BAR();
    }
    if (IN(1)) { PH_TID(); PH_BEGIN(1);
        pg8::Gemm g{(const u16*)(ws + WS_XH), (const u16*)(ws + WS_WIN), MTOK, N_IN, DM}; pg8::StaticOrder S; S.init(MTOK, N_IN, F.G, (int)blockIdx.x);
        pg8::EpiProj E{ws + WS_QA, (float*)(ws + WS_KIRAW), (float*)(ws + WS_WI), (const float*)(ws + WS_RINV1)};
        pg8::gemm_phase<pg8::EpiProj, pg8::StaticOrder, true, true>(ring, g, S, E);
        if (F.G == 256) { P0Args A{x, args.in[1], args.in[2], args.in[5], args.in[7], args.in[8], args.in[9], args.in[10], args.in[11]}; __syncthreads(); p0_prologue<1>(F, A, (int)blockIdx.x, 128, 128); }
        PH_END(1);
        if (BOTH(1)) GRID_BAR();
    }
    if (IN(2)) { PH_TID(); PH_BEGIN(2);
        ki_layernorm(F, args.in[3], args.in[4]);
        for (int u = F.vcu; u < 1024; u += F.G) ret_r1_unit(F, u);
        PH_END(2);
        if (BOTH(2)) GRID_BAR();
    }
    if (IN(3)) { PH_TID(); PH_BEGIN(3);
        { PH_BEGIN(9); ret_r2_scan(F); PH_END(9); }
        PH_BEGIN(10);
        { const bool deal = (F.G == 256); const int bb = F.vcu >> 6, s = F.vcu & 63, nun = deal ? 4 : (1024 - F.vcu + F.G - 1) / F.G;
          _Pragma("unroll 1") for (int i = 0; i < nun; ++i) { int ub, ug; if (deal) { ub = bb; ug = (i == 0) ? 255 - s : (i == 1) ? 128 + s : (i == 2) ? 127 - s : s; } else { const int u = F.vcu + i * F.G; ub = u >> 8; ug = u & 255; }
              idx_unit(F, ub, ug); } }
        PH_END(10);
        PH_END(3);
        if (BOTH(3)) GRID_BAR();
    }
    if (IN(4)) { PH_TID(); PH_BEGIN(4);
        { PH_BEGIN(11); for (int u = F.vcu; u < 1024; u += F.G) ret_r3_unit(F, u, args.in[6]); PH_END(11); }
        PH_BEGIN(12);
        const attn_body::AttnTensors AT{(const attn_body::bf16*)(ws + WS_QA), (const attn_body::bf16*)(ws + WS_KA), (const attn_body::bf16*)(ws + WS_VA), F.mix, (const unsigned*)(ws + WS_BM), (const float*)(ws + WS_BIAS)};
        if (F.G == 256) { const attn_body::StaticOrder S((int)F.G, (int)blockIdx.x); attn_body::attn_phase<attn_body::StaticOrder>((char*)lds_raw + RING_OFF, AT, S); }
        else { const attn_body::StridedOrder S((int)F.G, (int)blockIdx.x); attn_body::attn_phase<attn_body::StridedOrder>((char*)lds_raw + RING_OFF, AT, S); }
        PH_END(12);
        PH_END(4);
        if (BOTH(4)) GRID_BAR();
    }
    if (IN(5)) { PH_TID(); PH_BEGIN(5);
        pg8::Gemm g{(const u16*)F.mix, (const u16*)(ws + WS_WOUT), MTOK, DM, DM}; pg8::StaticOrder S; S.init(MTOK, DM, F.G, (int)blockIdx.x);
        pg8::EpiX2 E{(const u16*)(ws + WS_XH), (u16*)(ws + WS_X2H), (float*)(ws + WS_PART2)};
        pg8::gemm_phase<pg8::EpiX2, pg8::StaticOrder, true, true>(ring, g, S, E);
        PH_END(5);
        if (BOTH(5)) GRID_BAR();
    }
    if (IN(6)) { PH_TID(); PH_BEGIN(6);
        pg8::Gemm g{(const u16*)(ws + WS_X2H), (const u16*)(ws + WS_WGU), MTOK, 2 * DFF, DM}; pg8::StaticOrder S; S.init(MTOK, 2 * DFF, F.G, (int)blockIdx.x);
        pg8::EpiGU E{(u16*)(ws + WS_U), (const float*)(ws + WS_PART2)};
        pg8::gemm_phase<pg8::EpiGU, pg8::StaticOrder, true, true>(ring, g, S, E);
        PH_END(6);
        if (BOTH(6)) GRID_BAR();
    }
    if (IN(7)) { PH_TID(); PH_BEGIN(7);
        pg8::Gemm g{(const u16*)(ws + WS_U), (const u16*)(ws + WS_WD), MTOK, DM, DFF}; pg8::StaticOrder S; S.init(MTOK, DM, F.G, (int)blockIdx.x);
#ifdef UNFUSED_FINAL_NORM
        pg8::EpiDown E{(const u16*)(ws + WS_X2H), args.out, (float*)(ws + WS_PART3)};
        pg8::gemm_phase<pg8::EpiDown, pg8::StaticOrder, true, true>(ring, g, S, E);
        PH_END(7);
        if (BOTH(7)) GRID_BAR();
#else
        pg8::EpiDownNorm E{(const u16*)(ws + WS_X2H), args.out, (float*)(ws + WS_PART3), (unsigned*)(ctl + 16384), args.in[12]};
        pg8::gemm_phase<pg8::EpiDownNorm, pg8::StaticOrder, true, true>(ring, g, S, E);
        PH_END(7);
#endif
    }
#ifdef UNFUSED_FINAL_NORM
    if (IN(8)) { PH_TID(); PH_BEGIN(8); final_norm(F, args.out, (const float*)(ws + WS_PART3), args.in[12]); PH_END(8); }
#endif
#undef IN
#undef BOTH
#undef GRID_BAR
}


#ifdef DIAG_DETERMINISM
__global__ void k_checksum(const unsigned* p, size_t nwords, unsigned long long* slot) {
    unsigned long long s = 0; for (size_t i = (size_t)blockIdx.x * blockDim.x + threadIdx.x; i < nwords; i += (size_t)gridDim.x * blockDim.x) s += (unsigned long long)p[i] * (unsigned long long)((i & 1023u) + 1u);
    for (int o = 32; o >= 1; o >>= 1) s += __shfl_xor(s, o);
    if ((threadIdx.x & 63) == 0) atomicAdd(slot, s);
}
#ifndef DIAG_PASSES
#define DIAG_PASSES 4
#endif
__global__ void k_checksum_cols(const unsigned* p, int rows, int pitchw, int c0, int c1, unsigned long long* slot) {
    unsigned long long s = 0; const int w = c1 - c0; for (size_t i = (size_t)blockIdx.x * blockDim.x + threadIdx.x; i < (size_t)rows * w; i += (size_t)gridDim.x * blockDim.x) { const size_t r = i / w, c = c0 + i % w; s += (unsigned long long)p[r * pitchw + c] * (unsigned long long)((i & 1023u) + 1u); }
    for (int o = 32; o >= 1; o >>= 1) s += __shfl_xor(s, o);
    if ((threadIdx.x & 63) == 0) atomicAdd(slot, s);
}
__global__ void k_report(float* out, const unsigned long long* cs, const int* phase_of, int nbuf, size_t n) {
    int ph = -1; for (int i = 0; i < nbuf && ph < 0; ++i) for (int p = 1; p < DIAG_PASSES; ++p) if (cs[i] != cs[64 * p + i]) { ph = phase_of[i]; break; }
    if (ph < 0) return; const float delta = 0.1f * (float)(ph + 1);
    for (size_t i = (size_t)blockIdx.x * blockDim.x + threadIdx.x; i < n; i += (size_t)gridDim.x * blockDim.x) out[i] += delta;
}
__global__ void k_setphase(int* phase_of, unsigned long long packed_lo, unsigned long long packed_hi) { const int i = threadIdx.x; if (i < 32) phase_of[i] = (int)(((i < 16 ? packed_lo : packed_hi) >> (4 * (i & 15))) & 15ull); }
extern "C" void kernel_launch(void* const* d_in, const int* in_sizes, int n_in, void* d_out, int out_size, void* d_ws, size_t ws_size, hipStream_t stream) {
    static int grid = 0;
    if (grid == 0) { int dev = 0, cus = 0; hipGetDevice(&dev); hipDeviceGetAttribute(&cus, hipDeviceAttributeMultiprocessorCount, dev);
        if (hipFuncSetAttribute((const void*)hymba_fwd, hipFuncAttributeMaxDynamicSharedMemorySize, LDS_BYTES) != hipSuccess) { grid = -1; return; } grid = cus; }
    if (grid < 0) return;
    hipMemsetAsync((char*)d_ws + WS_CTL, 0, CTL_ZERO_BYTES, stream);
    Args a{}; for (int i = 0; i < 13; ++i) a.in[i] = (const float*)d_in[i]; a.out = (float*)d_out; a.ws = (unsigned char*)d_ws;
    unsigned char* ws = (unsigned char*)d_ws; unsigned long long* cs = (unsigned long long*)(ws + 100 * 1024);
    struct B { int ph; const void* p; size_t bytes; };
    const B bufs[] = { {0, ws + WS_XH, (size_t)MTOK * DM * 2}, {0, ws + WS_RINV1, (size_t)MTOK * 4}, {0, ws + WS_WIN, (size_t)N_IN * 1024 * 2}, {1, ws + WS_WOUT, (size_t)1024 * 1024 * 2}, {1, ws + WS_WGU, (size_t)5632 * 1024 * 2}, {1, ws + WS_WD, (size_t)1024 * DFF * 2}, {1, ws + WS_CS, (size_t)SEQ * 64 * 8}, {0, ws + WS_BIAS, (size_t)8 * 128 * 4},
        {1, ws + WS_QA, 32 * MiB}, {1, ws + WS_KA, 32 * MiB}, {1, ws + WS_VA, 32 * MiB}, {1, ws + WS_QI, 32 * MiB}, {1, ws + WS_QB, 32 * MiB}, {1, ws + WS_KB, 32 * MiB}, {1, ws + WS_VB, 32 * MiB}, {1, ws + WS_GB, 32 * MiB}, {1, ws + WS_KIRAW, 8 * MiB}, {1, ws + WS_WI, 1 * MiB},
        {2, ws + WS_KIH, 4 * MiB}, {2, ws + WS_DS, 64 * MiB}, {3, ws + WS_ST, 32 * MiB}, {3, ws + WS_BM, 32 * MiB}, {4, d_out, 1}, {9, d_out, 2},
        {5, ws + WS_X2H, 64 * MiB}, {5, ws + WS_PART2, 2 * MiB}, {6, ws + WS_U, (size_t)MTOK * DFF * 2}, {7, d_out, 128 * MiB}, {7, ws + WS_PART3, 2 * MiB} };
    const int nbuf = (int)(sizeof(bufs) / sizeof(bufs[0]));
    for (int pass = 0; pass < DIAG_PASSES; ++pass)
        for (int li = 0; li < N_PHASES; ++li) {
            a.ph_lo = li; a.ph_hi = li + 1; a.li = 0; a.pad = 0;
            hipLaunchKernelGGL(hymba_fwd, dim3(grid), dim3(NWAVES * 64), LDS_BYTES, stream, a);
            for (int k = 0; k < nbuf; ++k) { if (bufs[k].bytes <= 2) { if (li == 4) hipLaunchKernelGGL(k_checksum_cols, dim3(1024), dim3(256), 0, stream, (const unsigned*)bufs[k].p, MTOK, 512, bufs[k].bytes == 1 ? 0 : 256, bufs[k].bytes == 1 ? 256 : 512, cs + pass * 64 + k); }
                else if (bufs[k].ph == li) hipLaunchKernelGGL(k_checksum, dim3(1024), dim3(256), 0, stream, (const unsigned*)bufs[k].p, bufs[k].bytes / 4, cs + pass * 64 + k); }
        }
    unsigned long long plo = 0, phi = 0; for (int k = 0; k < nbuf; ++k) { if (k < 16) plo |= (unsigned long long)bufs[k].ph << (4 * k); else phi |= (unsigned long long)bufs[k].ph << (4 * (k - 16)); }
    int* phase_of = (int*)(ws + 104 * 1024);
    hipLaunchKernelGGL(k_setphase, dim3(1), dim3(64), 0, stream, phase_of, plo, phi);
    hipLaunchKernelGGL(k_report, dim3(1024), dim3(256), 0, stream, (float*)d_out, (const unsigned long long*)cs, (const int*)phase_of, nbuf, (size_t)MTOK * DM);
}
#else
extern "C" void kernel_launch(void* const* d_in, const int* in_sizes, int n_in, void* d_out, int out_size, void* d_ws, size_t ws_size, hipStream_t stream) {
    static int grid = 0;
    if (grid == 0) {
        if (n_in != 13 || in_sizes[0] != MTOK * DM || out_size != MTOK * DM || ws_size < WS_END) { fprintf(stderr, "kernel_launch: unexpected shapes / workspace (%d inputs, ws %zu)\n", n_in, ws_size); grid = -1; return; }
        int dev = 0, cus = 0, per_cu = 0;
        if (hipGetDevice(&dev) != hipSuccess || hipDeviceGetAttribute(&cus, hipDeviceAttributeMultiprocessorCount, dev) != hipSuccess) { grid = -1; return; }
        if (hipFuncSetAttribute((const void*)hymba_fwd, hipFuncAttributeMaxDynamicSharedMemorySize, LDS_BYTES) != hipSuccess) { fprintf(stderr, "kernel_launch: hipFuncSetAttribute failed\n"); grid = -1; return; }
        if (hipOccupancyMaxActiveBlocksPerMultiprocessor(&per_cu, (const void*)hymba_fwd, NWAVES * 64, LDS_BYTES) != hipSuccess || per_cu < 1) { fprintf(stderr, "kernel_launch: occupancy query reports %d workgroups per CU\n", per_cu); }
        (void)hipGetLastError();
        grid = cus;
    }
    if (grid < 0) return;
    if (hipMemsetAsync((char*)d_ws + WS_CTL, 0, CTL_ZERO_BYTES, stream) != hipSuccess) return;
    Args a{};
    for (int i = 0; i < 13; ++i) a.in[i] = (const float*)d_in[i];
    a.out = (float*)d_out; a.ws = (unsigned char*)d_ws;
    for (int li = 0; li < N_LAUNCHES; ++li) {
        a.ph_lo = (N_LAUNCHES == N_PHASES) ? li : 0; a.ph_hi = (N_LAUNCHES == N_PHASES) ? li + 1 : N_PHASES; a.li = (N_LAUNCHES == N_PHASES) ? 0 : li; a.pad = 0;
        hipLaunchKernelGGL(hymba_fwd, dim3(grid), dim3(NWAVES * 64), LDS_BYTES, stream, a);
    }
}
#endif
```

```cpp
#include <hip/hip_runtime.h>
#include <hip/hip_bf16.h>
#include <cstdio>
#include <cstdint>
#include <cmath>

#define GAS __attribute__((address_space(1)))
#define LAS __attribute__((address_space(3)))
typedef unsigned short u16;
typedef _Float16 f16x8 __attribute__((ext_vector_type(8)));
typedef _Float16 f16x2 __attribute__((ext_vector_type(2)));
typedef float f32x2 __attribute__((ext_vector_type(2)));
typedef float f32x4 __attribute__((ext_vector_type(4)));
typedef float f32x16 __attribute__((ext_vector_type(16)));
typedef unsigned v4u __attribute__((ext_vector_type(4)));
typedef unsigned v2u __attribute__((ext_vector_type(2)));
typedef GAS unsigned gu32;
#define RLX_AGENT __ATOMIC_RELAXED, __HIP_MEMORY_SCOPE_AGENT
#define LDS_WAIT() asm volatile("s_waitcnt lgkmcnt(0)" ::: "memory")
#define VM_WAIT() asm volatile("s_waitcnt vmcnt(0)" ::: "memory")

__device__ __forceinline__ unsigned cvt_pk_f16(float lo, float hi) { f32x2 v = {lo, hi}; f16x2 h = __builtin_convertvector(v, f16x2); return __builtin_bit_cast(unsigned, h); }
__device__ __forceinline__ unsigned cvt_pk_bf16(float lo, float hi) { unsigned r; asm volatile("v_cvt_pk_bf16_f32 %0, %1, %2" : "=v"(r) : "v"(lo), "v"(hi)); return r; }
__device__ __forceinline__ float h2f(u16 h) { return (float)__builtin_bit_cast(_Float16, h); }
__device__ __forceinline__ float silu_f(float x) { return x * __builtin_amdgcn_rcpf(1.0f + __builtin_amdgcn_exp2f(-1.4426950408889634f * x)); }
__device__ __forceinline__ int crow(int r, int hi) { return (r & 3) + 8 * (r >> 2) + 4 * hi; }

constexpr int BATCH = 4, SEQ = 8192, DM = 1024, MTOK = BATCH * SEQ;
constexpr int NHA = 8, DHA = 64, NHB = 4, DHB = 128, DFF = 2816;
constexpr int N_IN = 4352;
constexpr float EPS = 1e-6f;
constexpr float C2 = 0.125f * 1.4426950408889634f;

namespace pg8 {
#define PG8_LAS __attribute__((address_space(3)))
constexpr int BM = 256, BK = 64, HALF = 128, HTB = HALF * BK * 2, STAGE_BYTES = 8 * HTB, NXCD = 8, WGM = 8;
__host__ __device__ __forceinline__ int lds_byte(int r, int c) { const int st = (r >> 4) * 2 + (c >> 5), rr = r & 15, cc = c & 31, ob = rr * 64 + cc * 2; return st * 1024 + (ob ^ (((ob >> 9) & 1) << 5)); }
__host__ __device__ __forceinline__ void stage_rc(int b, int& R, int& C) { const int st = b / 1024, sb = b % 1024, swz = sb ^ (((sb >> 9) & 1) << 5); R = (st >> 1) * 16 + swz / 64; C = (st & 1) * 32 + (swz % 64) / 2; }
__host__ __device__ __forceinline__ int perm32(int rho) { const int n = rho >> 4, i = rho & 15; return 8 * (i >> 2) + 4 * n + (i & 3); }
struct Unit { int pm, pn; };
struct Gemm { const u16* A; const u16* Bt; int M, N, K; };
struct StaticOrder {
    int nM, nN, nwg, G, c;
    __host__ __device__ void init(int M, int N, int G_, int c_) { nM = M / BM; nN = N / BM; nwg = nM * nN; G = G_; c = c_; }
    __host__ __device__ bool next(int i, Unit& u) const {
        const long L = (long)i * G + c; if (L >= nwg) return false;
        int wgid = (int)L; { const int q = nwg / NXCD, r = nwg % NXCD, xcd = wgid % NXCD, off = wgid / NXCD; wgid = (xcd < r ? xcd * (q + 1) : r * (q + 1) + (xcd - r) * q) + off; }
        const int nig = WGM * nN, gid = wgid / nig, fm = gid * WGM, gsz = (nM - fm) < WGM ? (nM - fm) : WGM;
        u.pm = fm + ((wgid % nig) % gsz); u.pn = (wgid % nig) / gsz; return true;
    }
    __device__ __forceinline__ void a_ready(const Unit&) const {}
    __device__ __forceinline__ void done(const Unit&) const {}
};

struct EpiProj {
    static constexpr int PROBE_ID = 40;
    static constexpr bool PERM = true, AFTER_DRAIN = false;
    unsigned char* tbase; float* kiraw; float* wi; const float* rinv;
    __device__ __forceinline__ void operator()(const f32x4 (&acc)[2][2][4][2], const Unit& u, int wr, int wc, int fr, int fq) const {
        const int row0 = u.pm * BM + wr * 64 + fr; const int pn = u.pn;
        float rr[2][4];
#pragma unroll
        for (int ai = 0; ai < 2; ++ai)
#pragma unroll
            for (int m = 0; m < 4; ++m) rr[ai][m] = rinv[row0 + ai * HALF + m * 16];
        if (pn < 16) {
            const int tsel = pn >> 1; u16* T = (u16*)(tbase + (size_t)tsel * (32u << 20));
            const int colt = (pn & 1) * 256 + wc * 32 + 8 * fq;
            const float sc = (tsel == 0) ? C2 : ((tsel == 5) ? 0.08838834764831845f : 1.0f);
#pragma unroll
            for (int ai = 0; ai < 2; ++ai)
#pragma unroll
                for (int m = 0; m < 4; ++m) { const int row = row0 + ai * HALF + m * 16; const float r = rr[ai][m] * sc; u16* rowp = T + (size_t)row * 512 + colt;
#pragma unroll
                    for (int bj = 0; bj < 2; ++bj) { f32x4 v0 = acc[ai][bj][m][0] * r, v1 = acc[ai][bj][m][1] * r;
                        if (tsel == 7) {
#pragma unroll
                            for (int j = 0; j < 4; ++j) { v0[j] = silu_f(v0[j]); v1[j] = silu_f(v1[j]); } }
                        v4u w;
                        if (tsel < 3) { w.x = cvt_pk_bf16(v0[0], v0[1]); w.y = cvt_pk_bf16(v0[2], v0[3]); w.z = cvt_pk_bf16(v1[0], v1[1]); w.w = cvt_pk_bf16(v1[2], v1[3]); }
                        else { w.x = cvt_pk_f16(v0[0], v0[1]); w.y = cvt_pk_f16(v0[2], v0[3]); w.z = cvt_pk_f16(v1[0], v1[1]); w.w = cvt_pk_f16(v1[2], v1[3]); }
                        *(v4u*)(rowp + bj * HALF) = w; } }
        } else {
            const int c0 = wc * 32 + 8 * fq;
            if (c0 <= 64) {
                float* dst = (c0 < 64) ? kiraw + c0 : wi; const int stride = (c0 < 64) ? 64 : 8; const float s2 = (c0 < 64) ? 1.0f : 0.35355339059327373f;
#pragma unroll
                for (int ai = 0; ai < 2; ++ai)
#pragma unroll
                    for (int m = 0; m < 4; ++m) { const int row = row0 + ai * HALF + m * 16; const float r = rr[ai][m] * s2;
                        *(f32x4*)(dst + (size_t)row * stride) = acc[ai][0][m][0] * r; *(f32x4*)(dst + (size_t)row * stride + 4) = acc[ai][0][m][1] * r; } }
        }
    }
};
struct EpiX2 {
    static constexpr int PROBE_ID = 41;
    static constexpr bool PERM = true, AFTER_DRAIN = false;
    const u16* xh; u16* x2h; float* part;
    __device__ __forceinline__ void operator()(const f32x4 (&acc)[2][2][4][2], const Unit& u, int wr, int wc, int fr, int fq) const {
        const int row0 = u.pm * BM + wr * 64 + fr, col0 = u.pn * BM + wc * 32 + 8 * fq;
        v4u xx[2][4][2];
#pragma unroll
        for (int ai = 0; ai < 2; ++ai)
#pragma unroll
            for (int m = 0; m < 4; ++m)
#pragma unroll
                for (int bj = 0; bj < 2; ++bj) xx[ai][m][bj] = *(const v4u*)(xh + (size_t)(row0 + ai * HALF + m * 16) * DM + col0 + bj * HALF);
#pragma unroll
        for (int ai = 0; ai < 2; ++ai)
#pragma unroll
            for (int m = 0; m < 4; ++m) { const int row = row0 + ai * HALF + m * 16; const size_t off = (size_t)row * DM + col0; float ss = 0.f;
#pragma unroll
                for (int bj = 0; bj < 2; ++bj) { const v4u x = xx[ai][m][bj];
                    const f32x4 v0 = (f32x4){h2f((u16)(x.x & 0xffffu)), h2f((u16)(x.x >> 16)), h2f((u16)(x.y & 0xffffu)), h2f((u16)(x.y >> 16))} + acc[ai][bj][m][0];
                    const f32x4 v1 = (f32x4){h2f((u16)(x.z & 0xffffu)), h2f((u16)(x.z >> 16)), h2f((u16)(x.w & 0xffffu)), h2f((u16)(x.w >> 16))} + acc[ai][bj][m][1];
                    v4u h; h.x = cvt_pk_f16(v0[0], v0[1]); h.y = cvt_pk_f16(v0[2], v0[3]); h.z = cvt_pk_f16(v1[0], v1[1]); h.w = cvt_pk_f16(v1[2], v1[3]); *(v4u*)(x2h + off + bj * HALF) = h;
                    ss += ((v0[0] * v0[0] + v0[1] * v0[1]) + (v0[2] * v0[2] + v0[3] * v0[3])) + ((v1[0] * v1[0] + v1[1] * v1[1]) + (v1[2] * v1[2] + v1[3] * v1[3])); }
                ss += __shfl_xor(ss, 16); ss += __shfl_xor(ss, 32);
                if (fq == 0) part[(size_t)row * 16 + u.pn * 4 + wc] = ss; }
    }
};
struct EpiGU {
    static constexpr int PROBE_ID = 42;
    static constexpr bool PERM = true, AFTER_DRAIN = false;
    u16* U; const float* part;
    __device__ __forceinline__ void operator()(const f32x4 (&acc)[2][2][4][2], const Unit& u, int wr, int wc, int fr, int fq) const {
        const int row0 = u.pm * BM + wr * 64 + fr, colt = u.pn * HALF + wc * 32 + 8 * fq;
        f32x4 pq[2][4]; float rr[2][4];
#pragma unroll
        for (int ai = 0; ai < 2; ++ai)
#pragma unroll
            for (int m = 0; m < 4; ++m) pq[ai][m] = *(const f32x4*)(part + (size_t)(row0 + ai * HALF + m * 16) * 16 + 4 * fq);
#pragma unroll
        for (int ai = 0; ai < 2; ++ai)
#pragma unroll
            for (int m = 0; m < 4; ++m) { float sq = (pq[ai][m][0] + pq[ai][m][1]) + (pq[ai][m][2] + pq[ai][m][3]); sq += __shfl_xor(sq, 16); sq += __shfl_xor(sq, 32);
                rr[ai][m] = __builtin_amdgcn_rsqf(sq * (1.0f / DM) + EPS); }
#pragma unroll
        for (int ai = 0; ai < 2; ++ai)
#pragma unroll
            for (int m = 0; m < 4; ++m) { const int row = row0 + ai * HALF + m * 16;
                const float r = rr[ai][m];
                float o[8];
#pragma unroll
                for (int n = 0; n < 2; ++n)
#pragma unroll
                    for (int j = 0; j < 4; ++j) o[4 * n + j] = silu_f(acc[ai][0][m][n][j] * r) * (acc[ai][1][m][n][j] * r);
                v4u w; w.x = cvt_pk_f16(o[0], o[1]); w.y = cvt_pk_f16(o[2], o[3]); w.z = cvt_pk_f16(o[4], o[5]); w.w = cvt_pk_f16(o[6], o[7]);
                *(v4u*)(U + (size_t)row * DFF + colt) = w; }
    }
};
struct EpiDownNorm {
    static constexpr int PROBE_ID = 43;
    static constexpr bool PERM = true, AFTER_DRAIN = false;
    const u16* x2h; float* out; float* part; unsigned* cnt; const float* gfin;
    __device__ __forceinline__ void operator()(f32x4 (&acc)[2][2][4][2], const Unit& u, int wr, int wc, int fr, int fq) const {
        const int row0 = u.pm * BM + wr * 64 + fr, col0 = u.pn * BM + wc * 32 + 8 * fq;
        { v4u xx[2][4][2];
#pragma unroll
          for (int ai = 0; ai < 2; ++ai)
#pragma unroll
              for (int m = 0; m < 4; ++m)
#pragma unroll
                  for (int bj = 0; bj < 2; ++bj) xx[ai][m][bj] = *(const v4u*)(x2h + (size_t)(row0 + ai * HALF + m * 16) * DM + col0 + bj * HALF);
#pragma unroll
          for (int ai = 0; ai < 2; ++ai)
#pragma unroll
              for (int m = 0; m < 4; ++m) { const int row = row0 + ai * HALF + m * 16; float ss = 0.f;
#pragma unroll
                  for (int bj = 0; bj < 2; ++bj) { const v4u x = xx[ai][m][bj];
                      const f32x4 v0 = (f32x4){h2f((u16)(x.x & 0xffffu)), h2f((u16)(x.x >> 16)), h2f((u16)(x.y & 0xffffu)), h2f((u16)(x.y >> 16))} + acc[ai][bj][m][0];
                      const f32x4 v1 = (f32x4){h2f((u16)(x.z & 0xffffu)), h2f((u16)(x.z >> 16)), h2f((u16)(x.w & 0xffffu)), h2f((u16)(x.w >> 16))} + acc[ai][bj][m][1];
                      acc[ai][bj][m][0] = v0; acc[ai][bj][m][1] = v1;
                      ss += ((v0[0] * v0[0] + v0[1] * v0[1]) + (v0[2] * v0[2] + v0[3] * v0[3])) + ((v1[0] * v1[0] + v1[1] * v1[1]) + (v1[2] * v1[2] + v1[3] * v1[3])); }
                  ss += __shfl_xor(ss, 16); ss += __shfl_xor(ss, 32);
                  if (fq == 0) __hip_atomic_store((unsigned*)(part + (size_t)row * 16 + u.pn * 4 + wc), __builtin_bit_cast(unsigned, ss), __ATOMIC_RELAXED, __HIP_MEMORY_SCOPE_AGENT); } }
        asm volatile("s_waitcnt vmcnt(0)" ::: "memory");
        __builtin_amdgcn_s_barrier(); asm volatile("" ::: "memory");
        unsigned* cw = cnt + 64 * u.pm;
        if (threadIdx.x == 0) (void)__hip_atomic_fetch_add(cw, 1u, __ATOMIC_RELAXED, __HIP_MEMORY_SCOPE_AGENT);
        if (threadIdx.x < 64) { unsigned spins = 0u;
            while ((unsigned)__builtin_amdgcn_readfirstlane(__hip_atomic_load(cw, __ATOMIC_RELAXED, __HIP_MEMORY_SCOPE_AGENT)) < 4u) { __builtin_amdgcn_s_sleep(2); if (++spins > (1u << 22)) break; }
            __builtin_amdgcn_fence(__ATOMIC_ACQUIRE, "agent");
            asm volatile("s_waitcnt vmcnt(0)" ::: "memory"); }
        asm volatile("" ::: "memory"); __builtin_amdgcn_s_barrier(); asm volatile("" ::: "memory");
        f32x4 gv[2][2], pq[2][4]; float rr[2][4];
#pragma unroll
        for (int ai = 0; ai < 2; ++ai)
#pragma unroll
            for (int m = 0; m < 4; ++m) pq[ai][m] = *(const f32x4*)(part + (size_t)(row0 + ai * HALF + m * 16) * 16 + 4 * fq);
#pragma unroll
        for (int bj = 0; bj < 2; ++bj)
#pragma unroll
            for (int n = 0; n < 2; ++n) gv[bj][n] = *(const f32x4*)(gfin + col0 + bj * HALF + 4 * n);
#pragma unroll
        for (int ai = 0; ai < 2; ++ai)
#pragma unroll
            for (int m = 0; m < 4; ++m) { float sq = (pq[ai][m][0] + pq[ai][m][1]) + (pq[ai][m][2] + pq[ai][m][3]); sq += __shfl_xor(sq, 16); sq += __shfl_xor(sq, 32);
                rr[ai][m] = __builtin_amdgcn_rsqf(sq * (1.0f / DM) + EPS); }
#pragma unroll
        for (int ai = 0; ai < 2; ++ai)
#pragma unroll
            for (int m = 0; m < 4; ++m) { const size_t off = (size_t)(row0 + ai * HALF + m * 16) * DM + col0; const float r = rr[ai][m];
#pragma unroll
                for (int bj = 0; bj < 2; ++bj)
#pragma unroll
                    for (int n = 0; n < 2; ++n) *(f32x4*)(out + off + bj * HALF + 4 * n) = acc[ai][bj][m][n] * r * gv[bj][n]; }
    }
};
struct EpiDown {
    static constexpr int PROBE_ID = 44;
    static constexpr bool PERM = false, AFTER_DRAIN = false;
    const u16* x2h; float* x3; float* part;
    __device__ __forceinline__ void operator()(const f32x4 (&acc)[2][2][4][2], const Unit& u, int wr, int wc, int fr, int fq) const {
        const int row0 = u.pm * BM + wr * 64 + fr, col0 = u.pn * BM + wc * 32 + 4 * fq;
#pragma unroll
        for (int ai = 0; ai < 2; ++ai)
#pragma unroll
            for (int m = 0; m < 4; ++m) { const int row = row0 + ai * HALF + m * 16; const size_t off = (size_t)row * DM + col0; float ss = 0.f;
#pragma unroll
                for (int bj = 0; bj < 2; ++bj)
#pragma unroll
                    for (int n = 0; n < 2; ++n) { const size_t o = off + bj * HALF + n * 16; const v2u hh = *(const v2u*)(x2h + o);
                        const f32x4 r2 = {h2f((u16)(hh.x & 0xffffu)), h2f((u16)(hh.x >> 16)), h2f((u16)(hh.y & 0xffffu)), h2f((u16)(hh.y >> 16))}; const f32x4 v = r2 + acc[ai][bj][m][n];
                        *(f32x4*)(x3 + o) = v; ss += (v[0] * v[0] + v[1] * v[1]) + (v[2] * v[2] + v[3] * v[3]); }
                ss += __shfl_xor(ss, 16); ss += __shfl_xor(ss, 32);
                if (fq == 0) part[(size_t)row * 16 + u.pn * 4 + wc] = ss; }
    }
};

template <class Epi, class Sched, bool ALIGN_EPI = false, bool SP2 = false>
__device__ __forceinline__ void gemm_phase(PG8_LAS unsigned char* lds, const Gemm g, const Sched& S, const Epi& E) {
    const int tid = threadIdx.x, wid = __builtin_amdgcn_readfirstlane(tid >> 6), lane = tid & 63, wr = wid >> 2, wc = wid & 3, fr = lane & 15, fq = lane >> 4;
    const int K = g.K, nt = K / BK;
    unsigned voffA[2], voffB[2];
#pragma unroll
    for (int i = 0; i < 2; ++i) { int R, C; stage_rc(tid * 16 + i * 8192, R, C); const int Rb = Epi::PERM ? ((R & ~31) + perm32(R & 31)) : R;
        voffA[i] = (unsigned)(R * K + C) * 2u; voffB[i] = (unsigned)(Rb * K + C) * 2u; }
    const size_t kstep = (size_t)(BK * 2);
    const size_t hstep = (size_t)HALF * K * 2;
    const size_t tstep = 2 * hstep;
    const unsigned ldsw = (unsigned)wid * 1024u;
    const int aoff = lds_byte(wr * 64 + fr, fq * 8), boff = lds_byte(wc * 32 + fr, fq * 8);
#define PG8_SA(b, h) (((b) * 2 + (h)) * HTB)
#define PG8_SB(b, h) ((4 + (b) * 2 + (h)) * HTB)
#define PG8_STAGE(bufoff, gbase, voff) do { _Pragma("unroll") for (int _i = 0; _i < 2; ++_i) \
        __builtin_amdgcn_global_load_lds((const unsigned*)((const char*)(gbase) + (voff)[_i]), (PG8_LAS unsigned*)(lds + (bufoff) + ldsw + _i * 8192), 16, 0, 0); } while (0)
#define PG8_LDA(dst, b, h) do { _Pragma("unroll") for (int m = 0; m < 4; ++m) _Pragma("unroll") for (int k = 0; k < 2; ++k) dst[m][k] = *(const PG8_LAS f16x8*)(lds + PG8_SA(b, h) + aoff + m * 2048 + k * 1024); } while (0)
#define PG8_LDB(dst, b, h) do { _Pragma("unroll") for (int n = 0; n < 2; ++n) _Pragma("unroll") for (int k = 0; k < 2; ++k) dst[n][k] = *(const PG8_LAS f16x8*)(lds + PG8_SB(b, h) + boff + n * 2048 + k * 1024); } while (0)
#define PG8_MMA(ai, bj, At, Bt) do { __builtin_amdgcn_s_setprio(1); _Pragma("unroll") for (int m = 0; m < 4; ++m) _Pragma("unroll") for (int n = 0; n < 2; ++n) _Pragma("unroll") for (int k = 0; k < 2; ++k) \
        acc[ai][bj][m][n] = __builtin_amdgcn_mfma_f32_16x16x32_f16(Bt[n][k], At[m][k], acc[ai][bj][m][n], 0, 0, 0); __builtin_amdgcn_s_setprio(0); } while (0)
#define PG8_WAIT_V(n) asm volatile("s_waitcnt vmcnt(" #n ")" ::: "memory")
#define PG8_WAIT_L(n) asm volatile("s_waitcnt lgkmcnt(" #n ")" ::: "memory")
#define PG8_BAR __builtin_amdgcn_s_barrier()
#define PG8_SCHED __builtin_amdgcn_sched_barrier(0)
    Unit cur, nxt; int ui = 0;
    if (!S.next(0, cur)) return;
    f32x4 acc[2][2][4][2];
#pragma unroll
    for (int a = 0; a < 2; ++a)
#pragma unroll
        for (int b = 0; b < 2; ++b)
#pragma unroll
            for (int m = 0; m < 4; ++m)
#pragma unroll
                for (int n = 0; n < 2; ++n) acc[a][b][m][n] = (f32x4){0.f, 0.f, 0.f, 0.f};
    f16x8 At[4][2], B0[2][2], B1[2][2];
    const char* cA = (const char*)g.A + (size_t)cur.pm * tstep; const char* cB = (const char*)g.Bt + (size_t)cur.pn * tstep;
    S.a_ready(cur);
    if constexpr (SP2) {
        PG8_STAGE(PG8_SB(0, 0), cB, voffB); PG8_STAGE(PG8_SB(0, 1), cB + hstep, voffB); PG8_STAGE(PG8_SA(0, 0), cA, voffA); PG8_STAGE(PG8_SA(0, 1), cA + hstep, voffA);
        if (wr == 1) PG8_BAR;
        PG8_WAIT_V(2); PG8_BAR;
        PG8_STAGE(PG8_SB(1, 0), cB + kstep, voffB); PG8_STAGE(PG8_SA(1, 0), cA + kstep, voffA); PG8_STAGE(PG8_SB(1, 1), cB + hstep + kstep, voffB);
        PG8_WAIT_V(6); PG8_BAR;
    } else {
        PG8_STAGE(PG8_SB(0, 0), cB, voffB); PG8_STAGE(PG8_SA(0, 0), cA, voffA); PG8_STAGE(PG8_SB(0, 1), cB + hstep, voffB); PG8_STAGE(PG8_SA(0, 1), cA + hstep, voffA);
        if (wr == 1) PG8_BAR;
        PG8_WAIT_V(4); PG8_BAR;
        PG8_STAGE(PG8_SB(1, 0), cB + kstep, voffB); PG8_STAGE(PG8_SA(1, 0), cA + kstep, voffA); PG8_STAGE(PG8_SB(1, 1), cB + hstep + kstep, voffB);
        PG8_WAIT_V(6); PG8_BAR;
    }
    for (;;) {
        const bool has_next = S.next(ui + 1, nxt);
        const char* nA = has_next ? (const char*)g.A + (size_t)nxt.pm * tstep : cA; const char* nB = has_next ? (const char*)g.Bt + (size_t)nxt.pn * tstep : cB;
        for (int t = 0; t < nt; t += 2) {
            const bool last = (t == nt - 2);
            const char* a1 = cA + (size_t)(t + 1) * kstep;
            const char* a2 = last ? nA : cA + (size_t)(t + 2) * kstep; const char* b2 = last ? nB : cB + (size_t)(t + 2) * kstep;
            const char* a3 = a2 + kstep; const char* b3 = b2 + kstep;
            if (last && has_next) S.a_ready(nxt);
            if constexpr (SP2) {
            PG8_LDB(B0, 0, 0); PG8_LDB(B1, 0, 1); PG8_SCHED; PG8_LDA(At, 0, 0); PG8_STAGE(PG8_SA(1, 1), a1 + hstep, voffA);
            PG8_WAIT_V(8); PG8_WAIT_L(0); PG8_BAR; PG8_MMA(0, 0, At, B0); PG8_MMA(0, 1, At, B1); PG8_BAR; PG8_SCHED;
            PG8_LDA(At, 0, 1); PG8_STAGE(PG8_SB(0, 0), b2, voffB); PG8_STAGE(PG8_SB(0, 1), b2 + hstep, voffB); PG8_STAGE(PG8_SA(0, 0), a2, voffA);
            PG8_WAIT_V(8); PG8_WAIT_L(0); PG8_BAR; PG8_MMA(1, 0, At, B0); PG8_MMA(1, 1, At, B1); PG8_BAR; PG8_SCHED;
            PG8_LDB(B0, 1, 0); PG8_LDB(B1, 1, 1); PG8_SCHED; PG8_LDA(At, 1, 0); PG8_STAGE(PG8_SA(0, 1), a2 + hstep, voffA);
            PG8_WAIT_V(8); PG8_WAIT_L(0); PG8_BAR; PG8_MMA(0, 0, At, B0); PG8_MMA(0, 1, At, B1); PG8_BAR; PG8_SCHED;
            PG8_LDA(At, 1, 1); PG8_STAGE(PG8_SB(1, 0), b3, voffB); PG8_STAGE(PG8_SB(1, 1), b3 + hstep, voffB); PG8_STAGE(PG8_SA(1, 0), a3, voffA);
            PG8_WAIT_V(8); PG8_WAIT_L(0); PG8_BAR; PG8_MMA(1, 0, At, B0); PG8_MMA(1, 1, At, B1); PG8_BAR; PG8_SCHED;
            } else {
            PG8_LDB(B0, 0, 0); PG8_SCHED; PG8_LDA(At, 0, 0); PG8_STAGE(PG8_SA(1, 1), a1 + hstep, voffA);
            PG8_WAIT_L(8); PG8_BAR; PG8_WAIT_L(0); PG8_MMA(0, 0, At, B0); PG8_BAR; PG8_SCHED;
            PG8_LDB(B1, 0, 1); PG8_STAGE(PG8_SB(0, 0), b2, voffB);
            PG8_BAR; PG8_WAIT_L(0); PG8_MMA(0, 1, At, B1); PG8_BAR;
            PG8_LDA(At, 0, 1); PG8_STAGE(PG8_SA(0, 0), a2, voffA);
            PG8_BAR; PG8_WAIT_L(0); PG8_MMA(1, 0, At, B0); PG8_BAR; PG8_SCHED;
            PG8_STAGE(PG8_SB(0, 1), b2 + hstep, voffB);
            PG8_WAIT_V(6); PG8_BAR; PG8_MMA(1, 1, At, B1); PG8_BAR;
            PG8_LDB(B0, 1, 0); PG8_SCHED; PG8_LDA(At, 1, 0); PG8_STAGE(PG8_SA(0, 1), a2 + hstep, voffA);
            PG8_WAIT_L(8); PG8_BAR; PG8_WAIT_L(0); PG8_MMA(0, 0, At, B0); PG8_BAR; PG8_SCHED;
            PG8_LDB(B1, 1, 1); PG8_STAGE(PG8_SB(1, 0), b3, voffB);
            PG8_BAR; PG8_WAIT_L(0); PG8_MMA(0, 1, At, B1); PG8_BAR;
            PG8_LDA(At, 1, 1); PG8_STAGE(PG8_SA(1, 0), a3, voffA);
            PG8_BAR; PG8_WAIT_L(0); PG8_MMA(1, 0, At, B0); PG8_BAR; PG8_SCHED;
            PG8_STAGE(PG8_SB(1, 1), b3 + hstep, voffB);
            PG8_WAIT_V(6); PG8_BAR; PG8_MMA(1, 1, At, B1); PG8_BAR;
            }
        }
        if constexpr (ALIGN_EPI) { if (wr == 0) PG8_BAR; }
#ifdef PROBE_PHASE
        const unsigned long long pe0_ = (Epi::PROBE_ID == PROBE_PHASE) ? __builtin_amdgcn_s_memrealtime() : 0ull;
#endif
        if constexpr (!Epi::AFTER_DRAIN) { E(acc, cur, wr, wc, fr, fq); S.done(cur); }
#ifdef PROBE_PHASE
        if (Epi::PROBE_ID == PROBE_PHASE) { const unsigned long long t1_ = __builtin_amdgcn_s_memrealtime(), dt_ = t1_ - pe0_; while (__builtin_amdgcn_s_memrealtime() - t1_ < (unsigned long long)(PROBE_MULT) * dt_) __builtin_amdgcn_s_sleep(8); }
#endif
        if (!has_next) break;
#pragma unroll
        for (int a = 0; a < 2; ++a)
#pragma unroll
            for (int b = 0; b < 2; ++b)
#pragma unroll
                for (int m = 0; m < 4; ++m)
#pragma unroll
                    for (int n = 0; n < 2; ++n) acc[a][b][m][n] = (f32x4){0.f, 0.f, 0.f, 0.f};
        cur = nxt; cA = nA; cB = nB; ++ui;
        if constexpr (ALIGN_EPI) { if (wr == 1) PG8_BAR; }
    }
    PG8_WAIT_V(0);
    if constexpr (!ALIGN_EPI) { if (wr == 0) PG8_BAR; }
    PG8_BAR;
    if constexpr (Epi::AFTER_DRAIN) { E.fused(acc, cur, wr, wc, fr, fq, lds, wid, lane); S.done(cur); }
#undef PG8_SA
#undef PG8_SB
#undef PG8_STAGE
#undef PG8_LDA
#undef PG8_LDB
#undef PG8_MMA
#undef PG8_WAIT_V
#undef PG8_WAIT_L
#undef PG8_BAR
#undef PG8_SCHED
}

}

namespace attn_body {
using bf16=__hip_bfloat16;
using bf16x8=__attribute__((ext_vector_type(8)))short;
using s16x4=__attribute__((ext_vector_type(4)))short;
using f32x16=__attribute__((ext_vector_type(16)))float;
using u32x4=__attribute__((ext_vector_type(4)))unsigned;
constexpr int BATCH=4,NHEAD=8,SEQ=8192,D=64,DM=NHEAD*D,OPITCH=1024;
constexpr int NW=8,QBLK=32,QB=QBLK*NW,KVBLK=64,NQB=SEQ/QB;
constexpr int ATTN_PITCH=DM, ATTN_UNIT_ROWS=QB;
__device__ __forceinline__ int crow(int r,int hi){return (r&3)+8*(r>>2)+4*hi;}
#define SBAR() __builtin_amdgcn_sched_barrier(0)
__device__ __forceinline__ float bsel(float x,unsigned m){ return __builtin_bit_cast(float,__builtin_amdgcn_bitop3_b32(__builtin_bit_cast(unsigned,x),0xFF800000u,m,0xE4)); }
__device__ __forceinline__ void bmask(f32x16&p0,f32x16&p1,unsigned mw){
  #pragma unroll
  for(int r=0;r<16;++r){
    const unsigned m0=(unsigned)__builtin_amdgcn_sbfe((int)mw,r,1), m1=(unsigned)__builtin_amdgcn_sbfe((int)mw,16+r,1);
    const float x0=p0[r], x1=p1[r]; p0[r]=bsel(x0,m0); p1[r]=bsel(x1,m1); }
}
__device__ __forceinline__ void addbias(f32x16&p0,f32x16&p1,const float*btab,int dbase){
  #pragma unroll
  for(int r=0;r<16;++r){ int d0=dbase-((r&3)+8*(r>>2)); int d1=d0-32; d0=d0<0?0:(d0>127?127:d0); d1=d1<0?0:(d1>127?127:d1); p0[r]+=btab[d0]; p1[r]+=btab[d1]; }
}

constexpr int NSLOT=3, SLOTB=8192;
constexpr int LDS_K=0, LDS_V=NSLOT*SLOTB, LDS_WS=2*NSLOT*SLOTB, LDS_OST=LDS_WS+NW*64*4, LDS_BIAS=LDS_OST+NW*4096, LDS_MASK=LDS_BIAS+512, LDS_BYTES=LDS_MASK+NW*512;
constexpr float C2=0.125f*1.4426950408889634f;
__device__ __forceinline__ void glds16(const void*gsrc,unsigned lds_dst){unsigned keep;
  asm volatile("s_mov_b32 %0, m0\n\ts_mov_b32 m0, %2\n\ts_nop 0\n\tglobal_load_lds_dwordx4 %1, off\n\ts_mov_b32 m0, %0":"=&s"(keep):"v"(gsrc),"s"(lds_dst):"memory");}
__device__ __forceinline__ void glds4(const void*gsrc,unsigned lds_dst){unsigned keep;
  asm volatile("s_mov_b32 %0, m0\n\ts_mov_b32 m0, %2\n\ts_nop 0\n\tglobal_load_lds_dword %1, off\n\ts_mov_b32 m0, %0":"=&s"(keep):"v"(gsrc),"s"(lds_dst):"memory");}
__device__ __forceinline__ void glds4s(const void*sbase,unsigned voff,unsigned lds_dst){unsigned keep;
  asm volatile("s_mov_b32 %0, m0\n\ts_mov_b32 m0, %3\n\ts_nop 0\n\tglobal_load_lds_dword %1, %2\n\ts_mov_b32 m0, %0":"=&s"(keep):"v"(voff),"s"(sbase),"s"(lds_dst):"memory");}
__device__ __forceinline__ float max3f(float a,float b,float c){float r;asm("v_max3_f32 %0, %1, %2, %3":"=v"(r):"v"(a),"v"(b),"v"(c));return r;}
__device__ __forceinline__ float max2f(float a,float b){float r;asm("v_max_f32_e32 %0, %1, %2":"=v"(r):"v"(a),"v"(b));return r;}
__device__ __forceinline__ float fadd_s(float a,float b){float r;asm("v_add_f32_e32 %0, %1, %2":"=v"(r):"v"(a),"v"(b));return r;}
__device__ __forceinline__ float fsub_s(float a,float b){float r;asm("v_sub_f32_e32 %0, %1, %2":"=v"(r):"v"(a),"v"(b));return r;}
typedef float f32x2_t __attribute__((ext_vector_type(2))); typedef __bf16 bf16x2_t __attribute__((ext_vector_type(2)));
__device__ __forceinline__ unsigned cvtpk_s(float lo,float hi){f32x2_t v={lo,hi};bf16x2_t b=__builtin_convertvector(v,bf16x2_t);return __builtin_bit_cast(unsigned,b);}
#define WAIT_BAR(N) asm volatile("s_waitcnt vmcnt(" #N ") lgkmcnt(0)\n\ts_barrier":::"memory")

__device__ __forceinline__ void qkt(f32x16&p0,f32x16&p1,const char*Kslot,const bf16x8*qr,const f32x16&negm,int r32,int hi){
  const char*kb=Kslot+hi*1024+r32*16;
  #pragma unroll
  for(int d0=0;d0<4;++d0){
    const bf16x8 b0=*reinterpret_cast<const bf16x8*>(kb+d0*2048);
    const bf16x8 b1=*reinterpret_cast<const bf16x8*>(kb+d0*2048+512);
    if(d0==0){p0=__builtin_amdgcn_mfma_f32_32x32x16_bf16(b0,qr[0],negm,0,0,0);p1=__builtin_amdgcn_mfma_f32_32x32x16_bf16(b1,qr[0],negm,0,0,0);}
    else{p0=__builtin_amdgcn_mfma_f32_32x32x16_bf16(b0,qr[d0],p0,0,0,0);p1=__builtin_amdgcn_mfma_f32_32x32x16_bf16(b1,qr[d0],p1,0,0,0);}}
}
typedef __attribute__((address_space(3))) const char* lds_cptr;
typedef short v4i16_t __attribute__((ext_vector_type(4)));
__device__ __forceinline__ void kload8(bf16x8*kf,lds_cptr kp){
  kf[0]=*(const __attribute__((address_space(3))) bf16x8*)(kp);      kf[1]=*(const __attribute__((address_space(3))) bf16x8*)(kp+512);
  kf[2]=*(const __attribute__((address_space(3))) bf16x8*)(kp+2048); kf[3]=*(const __attribute__((address_space(3))) bf16x8*)(kp+2560);
  kf[4]=*(const __attribute__((address_space(3))) bf16x8*)(kp+4096); kf[5]=*(const __attribute__((address_space(3))) bf16x8*)(kp+4608);
  kf[6]=*(const __attribute__((address_space(3))) bf16x8*)(kp+6144); kf[7]=*(const __attribute__((address_space(3))) bf16x8*)(kp+6656);
}
__device__ __forceinline__ void kload2(bf16x8*kf,lds_cptr kp,int j){ kf[2*j]=*(const __attribute__((address_space(3))) bf16x8*)(kp+j*2048); kf[2*j+1]=*(const __attribute__((address_space(3))) bf16x8*)(kp+j*2048+512); }
__device__ __forceinline__ s16x4 vtr(lds_cptr p){ return __builtin_bit_cast(s16x4,__builtin_amdgcn_ds_read_tr16_b64_v4i16((__attribute__((address_space(3))) v4i16_t*)p)); }
__device__ __forceinline__ float rowmax(const f32x16&p0,const f32x16&p1){
  float a=max3f(p0[0],p0[1],p1[0]),b=max3f(p0[2],p0[3],p1[1]);a=max3f(a,p1[2],p1[3]);
  #pragma unroll
  for(int r=4;r<16;r+=4){a=max3f(a,p0[r],p0[r+1]);b=max3f(b,p0[r+2],p0[r+3]);a=max3f(a,p1[r],p1[r+1]);b=max3f(b,p1[r+2],p1[r+3]);}
  const float m=max2f(a,b);
  auto rr=__builtin_amdgcn_permlane32_swap(__float_as_uint(m),__float_as_uint(m),false,false);
  return max2f(__uint_as_float(rr[0]),__uint_as_float(rr[1]));
}
__device__ __forceinline__ void pv(f32x16*o,int vb,bf16x8 pa0,bf16x8 pa1,bf16x8 pa2,bf16x8 pa3){
  #pragma unroll
  for(int d0=0;d0<2;++d0){s16x4 lo[4],hi[4];
    #pragma unroll
    for(int ks=0;ks<4;++ks){
      asm volatile("ds_read_b64_tr_b16 %0,%1 offset:%c2":"=&v"(lo[ks]):"v"(vb),"i"(d0*4096+ks*1024):"memory");
      asm volatile("ds_read_b64_tr_b16 %0,%1 offset:%c2":"=&v"(hi[ks]):"v"(vb),"i"(d0*4096+ks*1024+512):"memory");}
    asm volatile("s_waitcnt lgkmcnt(0)":::"memory");SBAR();
    #define PK(k) (bf16x8){lo[k][0],lo[k][1],lo[k][2],lo[k][3],hi[k][0],hi[k][1],hi[k][2],hi[k][3]}
    o[d0]=__builtin_amdgcn_mfma_f32_32x32x16_bf16(pa0,PK(0),o[d0],0,0,0);
    o[d0]=__builtin_amdgcn_mfma_f32_32x32x16_bf16(pa1,PK(1),o[d0],0,0,0);
    o[d0]=__builtin_amdgcn_mfma_f32_32x32x16_bf16(pa2,PK(2),o[d0],0,0,0);
    o[d0]=__builtin_amdgcn_mfma_f32_32x32x16_bf16(pa3,PK(3),o[d0],0,0,0);
    #undef PK
  }
}

#ifndef ATTN_STORE16
#define ATTN_STORE16(p,v) (*(u32x4*)(p)=(v))
#endif
template<int THRL> __device__ __forceinline__ void attn_unit(int b,int h,int qb,const bf16*Q,const bf16*__restrict__ K,const bf16*__restrict__ V,unsigned short*O,const unsigned*__restrict__ BMK,const float*__restrict__ BIASG,char*shm){
  const int tid=threadIdx.x,lane=tid&63,r32=lane&31,hi=lane>>5; const int wid=__builtin_amdgcn_readfirstlane(tid>>6);
  const long rowbase=(long)b*SEQ; const int q0=qb*QB;
  const bf16*Qw=Q+(rowbase+q0+wid*QBLK)*DM+h*D;
  const bf16*Kh=K+rowbase*DM+h*D,*Vh=V+rowbase*DM+h*D;
  const unsigned lds0=(unsigned)(uintptr_t)shm;
  float*wsf=(float*)(shm+LDS_WS)+wid*64;
  float*btab=(float*)(shm+LDS_BIAS);
  if(tid<128)btab[tid]=BIASG[h*128+tid];
  const unsigned*bmw=BMK+((size_t)(b*256+qb*8+wid)*128)*64;
  unsigned mwc;
  const unsigned mdst=lds0+LDS_MASK+wid*512;
  #define MDMA(tt) glds4s(bmw+(size_t)(tt)*64,(unsigned)lane*4u,(unsigned)__builtin_amdgcn_readfirstlane(mdst+(((tt)&1)<<8)))
  #define MREAD(tt) (*(const __attribute__((address_space(3))) unsigned*)((lds_cptr)shm+LDS_MASK+wid*512+(((tt)&1)<<8)+lane*4))
  MDMA(0); MDMA(1);
  const bf16*ksrc=Kh+(long)lane*DM+wid*8;
  const bf16*vsrc=Vh+(long)(16*(wid&3)+(lane>>2))*DM+(wid>>2)*32+(lane&3)*8;
  const unsigned kdst=lds0+LDS_K+wid*1024, vdst=lds0+LDS_V+wid*1024;
  #define DMA_K(t,slot) glds16(ksrc+(long)(t)*KVBLK*DM,(unsigned)__builtin_amdgcn_readfirstlane(kdst+(slot)))
  #define DMA_V(t,slot) glds16(vsrc+(long)(t)*KVBLK*DM,(unsigned)__builtin_amdgcn_readfirstlane(vdst+(slot)))
  const int vb0=(int)(lds0+LDS_V)+((lane>>4)&1)*32+(lane&3)*8+(4*hi+((lane&15)>>2))*64;
  const char*Kbase=shm+LDS_K; bf16x8 kf[8];
  const lds_cptr shm3=(lds_cptr)shm; const lds_cptr kp0=shm3+LDS_K+hi*1024+r32*16; const lds_cptr vp0=shm3+LDS_V+((lane>>4)&1)*32+(lane&3)*8+(4*hi+((lane&15)>>2))*64;
  const int NT=(q0+QB)/KVBLK;
  DMA_K(0,0);DMA_V(0,0);DMA_K(1,SLOTB);
  bf16x8 qr[4];
  #pragma unroll
  for(int d0=0;d0<4;++d0)qr[d0]=*reinterpret_cast<const bf16x8*>(&Qw[(long)r32*DM+d0*16+hi*8]);
  float mhat=0.f,l_reg=0.f;f32x16 o[2];o[0]=f32x16{};o[1]=f32x16{};f32x16 negm=f32x16{};asm volatile("":"+v"(negm));
  const int qrel=wid*QBLK+r32;
  #define CMASK(P0,P1,t) do{ bmask(P0,P1,mwc); if((t)>=NT-7)addbias(P0,P1,btab,q0+qrel-64*(t)-4*hi); }while(0)
  bool resc=false;
  #define START(P0,P1) do{ const float rm=rowmax(P0,P1); resc=false; \
    { const float dl=(rm==-INFINITY)?0.f:rm; mhat=fadd_s(mhat,dl); \
      _Pragma("unroll") for(int r=0;r<16;++r){P0[r]=fsub_s(P0[r],dl);P1[r]=fsub_s(P1[r],dl);} \
      _Pragma("unroll") for(int r=0;r<16;++r)negm[r]=-mhat; asm volatile("":"+v"(negm)); } \
    _Pragma("unroll") for(int r=0;r<16;++r)P0[r]=__builtin_amdgcn_exp2f(P0[r]); }while(0)
  #define RESC() do{ if(resc){ asm volatile("s_waitcnt lgkmcnt(0)":::"memory"); \
      _Pragma("unroll") for(int d_=0;d_<2;++d_) _Pragma("unroll") for(int r=0;r<16;++r)o[d_][r]*=wsf[crow(r,hi)]; } }while(0)
  f32x16 pA0,pA1,pB0,pB1;
  int sl_prev=0,sl_cur=0,sl_next=SLOTB;
  #define ROT() do{sl_prev=sl_cur;sl_cur=sl_next;sl_next=(sl_next==(NSLOT-1)*SLOTB)?0:sl_next+SLOTB;}while(0)
  DMA_K(2,2*SLOTB);
  WAIT_BAR(3);
  mwc=MREAD(0);
  qkt(pA0,pA1,Kbase,qr,negm,r32,hi);asm volatile("s_nop 15\n\ts_nop 7":"+v"(pA0),"+v"(pA1));CMASK(pA0,pA1,0);
  START(pA0,pA1);
  _Pragma("unroll") for(int r=0;r<16;++r)pA1[r]=__builtin_amdgcn_exp2f(pA1[r]);
  WAIT_BAR(0);
  DMA_K(3,0);DMA_V(1,SLOTB);
  ROT();
  kload8(kf,kp0+sl_cur);
  WAIT_BAR(2);
  s16x4 vlo[8],vhi[8]; u32x4 pw0,pw1,pw2,pw3;
  #define PKW(P,B) cvtpk_s(P[B],P[B+1])
  #define PAF(k) __builtin_bit_cast(bf16x8,pw##k)
  #define VFR(i) (bf16x8){vlo[i][0],vlo[i][1],vlo[i][2],vlo[i][3],vhi[i][0],vhi[i][1],vhi[i][2],vhi[i][3]}
  #define PIN(x) asm volatile("":"+v"(x))
  #define MX3(a,b,c) __builtin_fmaxf(__builtin_fmaxf((a),(b)),(c))
  #define GAPA(MF,A0,A1,A2,A3,W0,W1,PW) do{ MF; sacc+=A0; sacc+=A1; sacc+=A2; sacc+=A3; PIN(sacc); W0; W1; PIN(PW); SBAR(); }while(0)
  #define EX(v) __builtin_amdgcn_exp2f(v)
  #define GAPB(MF,X,B) do{ MF; X[B]=EX(X[B]); X[B+1]=EX(X[B+1]); X[B+2]=EX(X[B+2]); X[B+3]=EX(X[B+3]); PIN(X); SBAR(); }while(0)
  #define VRD(i) do{ vlo[i]=vtr(vp_+(((i)>>2)*4096+((i)&3)*1024)); vhi[i]=vtr(vp_+(((i)>>2)*4096+((i)&3)*1024+512)); }while(0)
  #define KRD(G,j) do{ if(G){ kload2(kf,kp0+sl_next,j); SBAR(); } }while(0)
  #define STEP(C0,C1,P0,P1,t,GK,GV,GL) do{ SBAR(); mwc=MREAD(t); \
    const lds_cptr vp_=vp0+sl_prev; \
    VRD(0); SBAR(); float sacc=(P0[0]+P0[1]); \
    GAPA(C0=__builtin_amdgcn_mfma_f32_32x32x16_bf16(kf[0],qr[0],negm,0,0,0), P0[2],P0[3],P0[4],P0[5],     pw0[0]=PKW(P0,0), pw0[1]=PKW(P0,2), pw0); \
    VRD(4); SBAR(); GAPA(C1=__builtin_amdgcn_mfma_f32_32x32x16_bf16(kf[1],qr[0],negm,0,0,0), P0[6],P0[7],P0[8],P0[9],     pw0[2]=PKW(P0,4), pw0[3]=PKW(P0,6), pw0); \
    VRD(1); SBAR(); GAPA(C0=__builtin_amdgcn_mfma_f32_32x32x16_bf16(kf[2],qr[1],C0,0,0,0),   P0[10],P0[11],P0[12],P0[13], pw1[0]=PKW(P0,8), pw1[1]=PKW(P0,10), pw1); \
    VRD(5); SBAR(); GAPA(C1=__builtin_amdgcn_mfma_f32_32x32x16_bf16(kf[3],qr[1],C1,0,0,0),   P0[14],P0[15],P1[0],P1[1],   pw1[2]=PKW(P0,12),pw1[3]=PKW(P0,14), pw1); \
    VRD(2); SBAR(); GAPA(C0=__builtin_amdgcn_mfma_f32_32x32x16_bf16(kf[4],qr[2],C0,0,0,0),   P1[2],P1[3],P1[4],P1[5],     pw2[0]=PKW(P1,0), pw2[1]=PKW(P1,2), pw2); \
    VRD(6); SBAR(); GAPA(C1=__builtin_amdgcn_mfma_f32_32x32x16_bf16(kf[5],qr[2],C1,0,0,0),   P1[6],P1[7],P1[8],P1[9],     pw2[2]=PKW(P1,4), pw2[3]=PKW(P1,6), pw2); \
    VRD(3); SBAR(); GAPA(C0=__builtin_amdgcn_mfma_f32_32x32x16_bf16(kf[6],qr[3],C0,0,0,0),   P1[10],P1[11],P1[12],P1[13], pw3[0]=PKW(P1,8), pw3[1]=PKW(P1,10), pw3); \
    VRD(7); SBAR(); GAPA(C1=__builtin_amdgcn_mfma_f32_32x32x16_bf16(kf[7],qr[3],C1,0,0,0),   P1[14],P1[15],0.f,0.f,       pw3[2]=PKW(P1,12),pw3[3]=PKW(P1,14), pw3); \
    l_reg+=sacc; \
    if((t)+1<NT){MDMA((t)+1);} if(GK){DMA_K((t)+3,sl_cur);} if(GV){DMA_V((t)+1,sl_next);} \
    CMASK(C0,C1,t); \
    { float a=MX3(C0[0],C0[1],C1[0]),b=MX3(C0[2],C0[3],C1[1]); a=MX3(a,C1[2],C1[3]); \
      _Pragma("unroll") for(int r=4;r<16;r+=4){a=MX3(a,C0[r],C0[r+1]);b=MX3(b,C0[r+2],C0[r+3]);a=MX3(a,C1[r],C1[r+1]);b=MX3(b,C1[r+2],C1[r+3]);} \
      float rm=__builtin_fmaxf(a,b); { auto rr=__builtin_amdgcn_permlane32_swap(__float_as_uint(rm),__float_as_uint(rm),false,false); rm=__builtin_fmaxf(__uint_as_float(rr[0]),__uint_as_float(rr[1])); } \
      resc=false; \
      if(__builtin_expect(__any(rm>(float)THRL),0)){ const float dl=__builtin_fmaxf(rm,0.f); mhat+=dl; \
        _Pragma("unroll") for(int r=0;r<16;++r){C0[r]-=dl;C1[r]-=dl;} \
        _Pragma("unroll") for(int r=0;r<16;++r)negm[r]=-mhat; asm volatile("":"+v"(negm)); \
        const float f=__builtin_amdgcn_exp2f(-dl); l_reg*=f; if(hi==0)wsf[r32]=f; resc=true; } } \
    SBAR(); \
    GAPB(o[0]=__builtin_amdgcn_mfma_f32_32x32x16_bf16(PAF(0),VFR(0),o[0],0,0,0), C0,0); \
    GAPB(o[1]=__builtin_amdgcn_mfma_f32_32x32x16_bf16(PAF(0),VFR(4),o[1],0,0,0), C0,4); \
    KRD(GL,0); GAPB(o[0]=__builtin_amdgcn_mfma_f32_32x32x16_bf16(PAF(1),VFR(1),o[0],0,0,0), C0,8); \
    KRD(GL,1); GAPB(o[1]=__builtin_amdgcn_mfma_f32_32x32x16_bf16(PAF(1),VFR(5),o[1],0,0,0), C0,12); \
    KRD(GL,2); GAPB(o[0]=__builtin_amdgcn_mfma_f32_32x32x16_bf16(PAF(2),VFR(2),o[0],0,0,0), C1,0); \
    KRD(GL,3); GAPB(o[1]=__builtin_amdgcn_mfma_f32_32x32x16_bf16(PAF(2),VFR(6),o[1],0,0,0), C1,4); \
    GAPB(o[0]=__builtin_amdgcn_mfma_f32_32x32x16_bf16(PAF(3),VFR(3),o[0],0,0,0), C1,8); \
    GAPB(o[1]=__builtin_amdgcn_mfma_f32_32x32x16_bf16(PAF(3),VFR(7),o[1],0,0,0), C1,12); \
    }while(0)
  int t=1;
  #undef CMASK
  #define CMASK(P0,P1,t) do{ bmask(P0,P1,mwc); }while(0)
  for(;t+7<NT;t+=2){
    STEP(pB0,pB1,pA0,pA1,t,true,true,true);     WAIT_BAR(2); RESC(); ROT();
    STEP(pA0,pA1,pB0,pB1,t+1,true,true,true);   WAIT_BAR(2); RESC(); ROT();
  }
  #undef CMASK
  #define CMASK(P0,P1,t) do{ bmask(P0,P1,mwc); addbias(P0,P1,btab,q0+qrel-64*(t)-4*hi); }while(0)
  #define ENDW(tt) do{ if((tt)+3<NT){WAIT_BAR(2);} else if((tt)+2<NT){WAIT_BAR(1);} else {WAIT_BAR(0);} }while(0)
  for(;t+1<NT;t+=2){
    STEP(pB0,pB1,pA0,pA1,t,(t+3<NT),(t+1<NT),(t+1<NT));       ENDW(t);   RESC(); ROT();
    STEP(pA0,pA1,pB0,pB1,t+1,(t+4<NT),(t+2<NT),(t+2<NT));     ENDW(t+1); RESC(); ROT();
  }
  STEP(pB0,pB1,pA0,pA1,NT-1,false,false,false); RESC();
  { float sacc=pB0[0]+pB0[1]; _Pragma("unroll") for(int r=2;r<16;++r)sacc+=pB0[r]; _Pragma("unroll") for(int r=0;r<16;++r)sacc+=pB1[r]; l_reg+=sacc;
    pw0=(u32x4){PKW(pB0,0),PKW(pB0,2),PKW(pB0,4),PKW(pB0,6)};pw1=(u32x4){PKW(pB0,8),PKW(pB0,10),PKW(pB0,12),PKW(pB0,14)};pw2=(u32x4){PKW(pB1,0),PKW(pB1,2),PKW(pB1,4),PKW(pB1,6)};pw3=(u32x4){PKW(pB1,8),PKW(pB1,10),PKW(pB1,12),PKW(pB1,14)};
    SBAR(); pv(o,vb0+sl_cur,PAF(0),PAF(1),PAF(2),PAF(3)); }
  #undef PKW
  #undef PAF
  #undef VFR
  #undef PIN
  #undef MX3
  #undef GAPA
  #undef GAPB
  #undef EX
  #undef VRD
  #undef KRD
  #undef STEP
  #undef ENDW
  {auto rr=__builtin_amdgcn_permlane32_swap(__float_as_uint(l_reg),__float_as_uint(l_reg),false,false);l_reg=__uint_as_float(rr[0])+__uint_as_float(rr[1]);}
  if(hi==0)wsf[32+r32]=l_reg;asm volatile("s_waitcnt lgkmcnt(0)":::"memory");
  float rli[16];
  #pragma unroll
  for(int r=0;r<16;++r)rli[r]=__builtin_amdgcn_rcpf(wsf[32+crow(r,hi)]);
  unsigned short*Ow=O+(rowbase+q0+wid*QBLK)*OPITCH+h*D;
  { _Float16*stg=(_Float16*)(shm+LDS_OST)+wid*2048;
    #pragma unroll
    for(int r=0;r<16;++r){const int orow=crow(r,hi);
      #pragma unroll
      for(int d0=0;d0<2;++d0)stg[orow*64+d0*32+r32]=(_Float16)(o[d0][r]*rli[r]);}
    asm volatile("s_waitcnt lgkmcnt(0)":::"memory");
    #pragma unroll
    for(int i=0;i<4;++i){const int row=i*8+(lane>>3),ch=lane&7; const u32x4 v=*(const u32x4*)(stg+row*64+ch*8); ATTN_STORE16(Ow+(long)row*OPITCH+ch*8,v);} }
  asm volatile("s_waitcnt lgkmcnt(0)\n\ts_barrier":::"memory");
  #undef DMA_K
  #undef MDMA
  #undef MREAD
  #undef DMA_V
  #undef CMASK
  #undef START
  #undef RESC
  #undef ROT
}
constexpr int ATTN_LDS_BYTES=LDS_BYTES;
struct AttnTensors { const bf16* Q; const bf16* K; const bf16* V; unsigned short* O; const unsigned* BMK; const float* BIASG; };
struct AttnUnit { int bh; int qb; };
struct StaticOrder {
  int vcu;
  __device__ __forceinline__ explicit StaticOrder(int grid,int block):vcu((block%8)*(grid/8)+block/8){}
  __device__ __forceinline__ bool next(int i,AttnUnit&u)const{ if(i>=4)return false; const int s=vcu&7; u.bh=vcu>>3; u.qb=(i==0)?s:(i==1)?15-s:(i==2)?16+s:31-s; return true; }
  __device__ __forceinline__ void a_ready(const AttnUnit&)const{}
  __device__ __forceinline__ void done(const AttnUnit&)const{}
};
struct StridedOrder {
  int G,c;
  __device__ __forceinline__ explicit StridedOrder(int grid,int block):G(grid),c(block){}
  __device__ __forceinline__ bool next(int i,AttnUnit&u)const{ const int L=i*G+c; if(L>=BATCH*NHEAD*NQB)return false; u.bh=L/NQB; u.qb=L%NQB; return true; }
  __device__ __forceinline__ void a_ready(const AttnUnit&)const{}
  __device__ __forceinline__ void done(const AttnUnit&)const{}
};
template<class Sched,int THRL=8> __device__ __forceinline__ void attn_phase(char*lds,const AttnTensors&T,const Sched&S){
  AttnUnit u;
  for(int i=0;S.next(i,u);++i){ S.a_ready(u); attn_unit<THRL>(u.bh/NHEAD,u.bh%NHEAD,u.qb,T.Q,T.K,T.V,T.O,T.BMK,T.BIASG,lds); S.done(u); }
}
#undef SBAR
#undef WAIT_BAR
}

constexpr int NWAVES = 8;
#ifndef MK_N_LAUNCHES
#define MK_N_LAUNCHES 1
#endif
constexpr int N_PHASES = 9;
constexpr int N_LAUNCHES = MK_N_LAUNCHES;

constexpr size_t MiB = 1u << 20;
constexpr size_t WS_CTL = 0, CTL_ZERO_BYTES = 128 * 1024;
constexpr size_t WS_WIN = 2 * MiB, WS_WOUT = 11 * MiB, WS_WGU = 13 * MiB, WS_WD = 24 * MiB;
constexpr size_t WS_CS = 30 * MiB;
constexpr size_t WS_RINV1 = 34 * MiB, WS_PART2 = 35 * MiB, WS_PART3 = 37 * MiB, WS_WI = 39 * MiB;
constexpr size_t WS_BIAS = 34 * MiB + 512 * 1024;
constexpr size_t WS_KIRAW = 40 * MiB, WS_KIH = 48 * MiB;
constexpr size_t WS_XH = 52 * MiB, WS_MIX = 52 * MiB;
constexpr size_t WS_QA = 116 * MiB;
constexpr size_t WS_KA = WS_QA + 32 * MiB, WS_VA = WS_QA + 64 * MiB, WS_QI = WS_QA + 96 * MiB, WS_QB = WS_QA + 128 * MiB, WS_KB = WS_QA + 160 * MiB, WS_VB = WS_QA + 192 * MiB, WS_GB = WS_QA + 224 * MiB;
constexpr size_t WS_DS = 372 * MiB;
constexpr size_t WS_ST = 436 * MiB;
constexpr size_t WS_BM = 468 * MiB;
constexpr size_t WS_X2H = 372 * MiB;
constexpr size_t WS_U = 180 * MiB;
constexpr size_t WS_END = 512 * MiB;
static_assert(WS_BM + 32 * MiB <= WS_END && WS_U + (size_t)MTOK * DFF * 2 <= WS_DS + 64 * MiB, "d_ws map");
constexpr int CW_BAR = 4096;

constexpr int LCTL_BYTES = 4096;
constexpr int RING_OFF = LCTL_BYTES, RING_BYTES = 139264;
constexpr int LDS_BYTES = RING_OFF + RING_BYTES;
static_assert(LDS_BYTES <= 160 * 1024 - 1024, "LDS");

#define XB_TMO      128
#define XB_XCNT(j)  (256  + 64 * (j))
#define XB_XSUB(j)  (1280 + 64 * (j))
#define XB_XGEN(j)  (2304 + 64 * (j))
#define XB_TOP      3328
#define XB_TOPGEN   3392
#define XCD_BAR_WORDS 3456
#define XB_SPIN_CAP (1u << 18)

__device__ __forceinline__ unsigned xb_ld(unsigned* p)              { return __hip_atomic_load(p, __ATOMIC_RELAXED, __HIP_MEMORY_SCOPE_AGENT); }
__device__ __forceinline__ unsigned xb_add(unsigned* p, unsigned v) { return __hip_atomic_fetch_add(p, v, __ATOMIC_RELAXED, __HIP_MEMORY_SCOPE_AGENT); }
__device__ __forceinline__ unsigned xb_xcc_id() { return (unsigned)__builtin_amdgcn_s_getreg((3 << 11) | 20) & 0xFu; }
#define XB_SPIN(cond, bar) do { unsigned _sp = 0; while (cond) { __builtin_amdgcn_s_sleep(1); \
    if ((++_sp & 255u) == 0u) { if (xb_ld(&(bar)[XB_TMO])) break; if (_sp > XB_SPIN_CAP) { atomicAdd(&(bar)[XB_TMO], 1u); break; } } } } while (0)

struct XcdBarrier {
    unsigned* bar; unsigned x;
    volatile LAS unsigned* st;
};

__device__ __forceinline__ XcdBarrier xcd_barrier_post(unsigned* bar, volatile LAS unsigned* st) {
    XcdBarrier b; b.bar = bar; b.x = xb_xcc_id(); b.st = st;
    if (threadIdx.x == 0) (void)xb_add(&bar[XB_XCNT(b.x)], 1u);
    return b;
}
__device__ __forceinline__ void xcd_barrier_complete(unsigned* bar, unsigned x, unsigned& nloc, unsigned& nx) {
    const unsigned G = gridDim.x * gridDim.y * gridDim.z;
    unsigned sum, cnt, mine, sp = 0u;
    for (;;) {
        sum = 0u; cnt = 0u; mine = 0u;
#pragma unroll
        for (unsigned j = 0; j < 16; ++j) { const unsigned c = xb_ld(&bar[XB_XCNT(j)]); sum += c; cnt += (c > 0u) ? 1u : 0u; mine = (j == x) ? c : mine; }
        if (sum == G) break;
        __builtin_amdgcn_s_sleep(1);
        if ((++sp & 255u) == 0u) { if (xb_ld(&bar[XB_TMO])) break; if (sp > XB_SPIN_CAP) { atomicAdd(&bar[XB_TMO], 1u); break; } }
    }
    nloc = mine > 0u ? mine : 1u; nx = cnt > 0u ? cnt : 1u;
}

__device__ __forceinline__ void xcd_barrier(const XcdBarrier& b) {
    asm volatile("s_waitcnt vmcnt(0)" ::: "memory");
    __syncthreads();
    if (threadIdx.x == 0) {
        unsigned* bar = b.bar;
        __builtin_amdgcn_s_waitcnt(0);
        unsigned nloc = b.st[0], nx = b.st[1];
        if (nloc == 0u) { xcd_barrier_complete(bar, b.x, nloc, nx); b.st[0] = nloc; b.st[1] = nx; }
        const unsigned old = xb_add(&bar[XB_XSUB(b.x)], 1u);
        const unsigned gen = old / nloc;
        if (old + 1u == (gen + 1u) * nloc) {
            __builtin_amdgcn_fence(__ATOMIC_RELEASE, "agent");
            asm volatile("s_waitcnt vmcnt(0)" ::: "memory");
            const unsigned og = xb_add(&bar[XB_TOP], 1u);
            const unsigned tg = og / nx;
            if (og + 1u == (tg + 1u) * nx) xb_add(&bar[XB_TOPGEN], 1u);
            else XB_SPIN(xb_ld(&bar[XB_TOPGEN]) == tg, bar);
            __builtin_amdgcn_fence(__ATOMIC_ACQUIRE, "agent");
            xb_add(&bar[XB_XGEN(b.x)], 1u);
            asm volatile("s_waitcnt vmcnt(0)" ::: "memory");
        } else {
            XB_SPIN(xb_ld(&bar[XB_XGEN(b.x)]) == gen, bar);
            __builtin_amdgcn_fence(__ATOMIC_ACQUIRE, "agent");
            asm volatile("s_waitcnt vmcnt(0)" ::: "memory");
        }
    }
    __syncthreads();
}

struct Frame {
    LAS unsigned char* lds;
    unsigned char* ws;
    u16* mix;
    int tid, lane, wave;
    int vcu, G;
};
__device__ __forceinline__ float wave_sum(float v) {
#pragma unroll
    for (int o = 1; o < 64; o <<= 1) v += __shfl_xor(v, o);
    return v;
}

#ifdef PROBE_PHASE
#define SUB_BEGIN(k) const unsigned long long sb0_##k = ((k) == PROBE_PHASE) ? __builtin_amdgcn_s_memrealtime() : 0ull
#define SUB_END(k) do { if ((k) == PROBE_PHASE) { const unsigned long long t1_ = __builtin_amdgcn_s_memrealtime(), dt_ = t1_ - sb0_##k; while (__builtin_amdgcn_s_memrealtime() - t1_ < (unsigned long long)(PROBE_MULT) * dt_) __builtin_amdgcn_s_sleep(8); } } while (0)
#else
#define SUB_BEGIN(k) do {} while (0)
#define SUB_END(k) do {} while (0)
#endif
__device__ __forceinline__ void p0_tr_item(const float* W, int ldw, int scol0, int nvalid, const float* gain, u16* WT, int K, int drow0, int k0, LAS float* scr, int lane) {
    f32x4 v[8];
#pragma unroll
    for (int i = 0; i < 8; ++i) { const int kk = 8 * i + (lane >> 3), n4 = 4 * (lane & 7);
        v[i] = (n4 + 3 < nvalid) ? *(const f32x4*)(W + (size_t)(k0 + kk) * ldw + scol0 + n4) : (f32x4){0.f, 0.f, 0.f, 0.f}; }
#pragma unroll
    for (int i = 0; i < 8; ++i) { const int kk = 8 * i + (lane >> 3), n4 = 4 * (lane & 7); const float gk = gain ? gain[k0 + kk] : 1.0f;
        scr[kk * 33 + n4 + 0] = v[i][0] * gk; scr[kk * 33 + n4 + 1] = v[i][1] * gk; scr[kk * 33 + n4 + 2] = v[i][2] * gk; scr[kk * 33 + n4 + 3] = v[i][3] * gk; }
    LDS_WAIT(); asm volatile("" ::: "memory");
    const int c = lane & 7;
#pragma unroll
    for (int j = 0; j < 4; ++j) { const int n = (lane >> 3) + 8 * j; const LAS float* s = scr + (8 * c) * 33 + n;
        v4u o; o.x = cvt_pk_f16(s[0 * 33], s[1 * 33]); o.y = cvt_pk_f16(s[2 * 33], s[3 * 33]); o.z = cvt_pk_f16(s[4 * 33], s[5 * 33]); o.w = cvt_pk_f16(s[6 * 33], s[7 * 33]);
        *(v4u*)(WT + (size_t)(drow0 + n) * K + k0 + 8 * c) = o; }
    LDS_WAIT(); asm volatile("" ::: "memory");
}
__constant__ unsigned char T5_BUCKET[128] = {0, 1, 2, 3, 4, 5, 6, 7, 8, 9, 10, 11, 12, 13, 14, 15, 16, 16, 16, 17, 17, 18, 18, 18, 19, 19, 19, 20, 20, 20, 20, 21, 21, 21, 21, 22, 22, 22, 22, 22, 23, 23, 23, 23, 23, 23, 24, 24, 24, 24, 24, 24, 25, 25, 25, 25, 25, 25, 25, 26, 26, 26, 26, 26, 26, 26, 26, 27, 27, 27, 27, 27, 27, 27, 27, 27, 27, 28, 28, 28, 28, 28, 28, 28, 28, 28, 28, 29, 29, 29, 29, 29, 29, 29, 29, 29, 29, 29, 29, 30, 30, 30, 30, 30, 30, 30, 30, 30, 30, 30, 30, 30, 30, 31, 31, 31, 31, 31, 31, 31, 31, 31, 31, 31, 31, 31, 31, 31};
struct P0Args { const float *x, *g_mix, *w_in, *rel_bias, *w_out, *g_ffn, *w_gate, *w_up, *w_down; };
template <int PART> __device__ __forceinline__ void p0_prologue(Frame& F, const P0Args& A, int widx, int wg0, int nwg) {
    LAS float* scr = (LAS float*)(F.lds + RING_OFF + F.wave * 16384);
    const int gw = (widx - wg0) * NWAVES + F.wave, NGW = nwg * NWAVES;
    if (widx < wg0 || widx >= wg0 + nwg) return;
    u16* WinT = (u16*)(F.ws + WS_WIN); u16* WoutT = (u16*)(F.ws + WS_WOUT); u16* WguT = (u16*)(F.ws + WS_WGU); u16* WdT = (u16*)(F.ws + WS_WD);
    constexpr int I_IN = 16 * (N_IN / 32), I_OUT = 16 * 32, I_GU = 16 * 176, I_D = 44 * 32, NITEMS = I_IN + I_OUT + I_GU + I_D;
    SUB_BEGIN(20);
    for (int it = (PART == 0 ? gw : I_IN + gw); it < (PART == 0 ? I_IN : NITEMS); it += NGW) {
        int r = it;
        if (r < I_IN) { const int kb = r / (N_IN / 32), nb = r % (N_IN / 32), drow0 = 32 * nb; int scol0, nvalid = 32;
            if (drow0 < 2048) scol0 = drow0; else if (drow0 < 4096) scol0 = 2120 + (drow0 - 2048); else { const int off = drow0 - 4096; scol0 = 2048 + off; nvalid = 72 - off; nvalid = nvalid < 0 ? 0 : (nvalid > 32 ? 32 : nvalid); }
            p0_tr_item(A.w_in, 4168, scol0, nvalid, A.g_mix, WinT, 1024, drow0, 64 * kb, scr, F.lane); continue; }
        r -= I_IN;
        if (r < I_OUT) { const int kb = r / 32, nb = r % 32; p0_tr_item(A.w_out, 1024, 32 * nb, 32, nullptr, WoutT, 1024, 32 * nb, 64 * kb, scr, F.lane); continue; }
        r -= I_OUT;
        if (r < I_GU) { const int kb = r / 176, nb = r % 176, t = nb >> 3, w = nb & 7;
            p0_tr_item(w < 4 ? A.w_gate : A.w_up, DFF, 128 * t + 32 * (w & 3), 32, A.g_ffn, WguT, 1024, 256 * t + 32 * w, 64 * kb, scr, F.lane); continue; }
        r -= I_GU;
        { const int kb = r / 32, nb = r % 32; p0_tr_item(A.w_down, 1024, 32 * nb, 32, nullptr, WdT, DFF, 32 * nb, 64 * kb, scr, F.lane); }
    }
    SUB_END(20);
    SUB_BEGIN(21);
    if (PART == 0) {
    u16* XH = (u16*)(F.ws + WS_XH); float* rinv1 = (float*)(F.ws + WS_RINV1);
    for (int m0 = gw; m0 < MTOK; m0 += 4 * NGW) {
        f32x4 v[4][4]; float ss[4];
#pragma unroll
        for (int r = 0; r < 4; ++r) { const int m = m0 + r * NGW < MTOK ? m0 + r * NGW : m0; const f32x4* xr = (const f32x4*)(A.x + (size_t)m * DM) + F.lane;
#pragma unroll
            for (int j = 0; j < 4; ++j) v[r][j] = xr[64 * j]; }
#pragma unroll
        for (int r = 0; r < 4; ++r) { float s = 0.f;
#pragma unroll
            for (int j = 0; j < 4; ++j) s += (v[r][j][0] * v[r][j][0] + v[r][j][1] * v[r][j][1]) + (v[r][j][2] * v[r][j][2] + v[r][j][3] * v[r][j][3]);
            ss[r] = wave_sum(s); }
#pragma unroll
        for (int r = 0; r < 4; ++r) { const int m = m0 + r * NGW; if (m < MTOK) {
            if (F.lane == 0) rinv1[m] = 1.0f / sqrtf(ss[r] * (1.0f / DM) + EPS);
            v2u* o = (v2u*)(XH + (size_t)m * DM) + F.lane;
#pragma unroll
            for (int j = 0; j < 4; ++j) { v2u h; h.x = cvt_pk_f16(v[r][j][0], v[r][j][1]); h.y = cvt_pk_f16(v[r][j][2], v[r][j][3]); o[64 * j] = h; } } }
    }
    }
    SUB_END(21);
    SUB_BEGIN(22);
    if (PART == 1) {
    f32x2* CS = (f32x2*)(F.ws + WS_CS);
    for (int e = (widx - wg0) * (NWAVES * 64) + F.tid; e < SEQ * 64; e += nwg * NWAVES * 64) {
        const int pos = e >> 6, i = e & 63;
        const float theta = (float)(1.0 / exp2((double)i * (13.287712379549449 / 63.0)));
        const float ang = (float)pos * theta;
        const double rev = (double)ang * 0.15915494309189535; const double fr = rev - rint(rev);
        const double a = fr * 6.283185307179586;
        CS[e] = (f32x2){(float)cos(a), (float)sin(a)};
    }
    }
    SUB_END(22);
    if (PART == 0 && blockIdx.x == 0) { float* BT = (float*)(F.ws + WS_BIAS);
        for (int e = F.tid; e < 8 * 128; e += NWAVES * 64) { const int h = e >> 7, d = e & 127; BT[e] = (A.rel_bias[(int)T5_BUCKET[d] * 8 + h] - A.rel_bias[31 * 8 + h]) * 1.4426950408889634f; } }
}

__device__ __forceinline__ void ki_layernorm(Frame& F, const float* ln_g, const float* ln_b) {
    const float* KIR = (const float*)(F.ws + WS_KIRAW); u16* KIH = (u16*)(F.ws + WS_KIH);
    for (int e = F.vcu * (NWAVES * 64) + F.tid; e < MTOK * 4; e += F.G * NWAVES * 64) {
        const int tok = e >> 2, part = e & 3; const f32x4* src = (const f32x4*)(KIR + (size_t)tok * 64 + part * 16);
        f32x4 v[4]; float s = 0.f;
#pragma unroll
        for (int j = 0; j < 4; ++j) { v[j] = src[j]; s += (v[j][0] + v[j][1]) + (v[j][2] + v[j][3]); }
        s += __shfl_xor(s, 1); s += __shfl_xor(s, 2);
        const float mu = s * (1.0f / 64.0f); float q = 0.f;
#pragma unroll
        for (int j = 0; j < 4; ++j) { v[j] = v[j] - mu; q += (v[j][0] * v[j][0] + v[j][1] * v[j][1]) + (v[j][2] * v[j][2] + v[j][3] * v[j][3]); }
        q += __shfl_xor(q, 1); q += __shfl_xor(q, 2);
        const float rs = 1.0f / sqrtf(q * (1.0f / 64.0f) + EPS);
        v2u* dst = (v2u*)(KIH + (size_t)tok * 64 + part * 16);
#pragma unroll
        for (int j = 0; j < 4; ++j) { const f32x4 g = *(const f32x4*)(ln_g + part * 16 + 4 * j), bb = *(const f32x4*)(ln_b + part * 16 + 4 * j); const f32x4 y = v[j] * rs * g + bb;
            v2u h; h.x = cvt_pk_f16(y[0], y[1]); h.y = cvt_pk_f16(y[2], y[3]); dst[j] = h; }
    }
}

constexpr int RP = 136;
constexpr int RT_BYTES = 128 * RP * 2;
__device__ __forceinline__ float ret_log2g(int h) { return log2f(1.0f - exp2f(-5.0f - (float)h)); }
template <bool TR, bool DECAY> __device__ __forceinline__ void ret_stage_rot(Frame& F, const u16* src  , int row0, int pos0, int h, LAS _Float16* dst, float lg) {
    const f32x2* CS = (const f32x2*)(F.ws + WS_CS);
#pragma unroll
    for (int it = 0; it < 2; ++it) { const int ch = F.tid + 512 * it;
        const int j = TR ? (ch & 127) : (ch >> 3), fc = TR ? (ch >> 7) : (ch & 7);
        const u16* p = src + (size_t)(row0 + j) * 512 + h * 128 + 8 * fc;
        const v4u a = *(const v4u*)p, b = *(const v4u*)(p + 64);
        const f32x4* cs = (const f32x4*)(CS + (size_t)(pos0 + j) * 64 + 8 * fc);
        const f32x4 c0 = cs[0], c1 = cs[1], c2 = cs[2], c3 = cs[3];
        const float co[8] = {c0[0], c0[2], c1[0], c1[2], c2[0], c2[2], c3[0], c3[2]}, si[8] = {c0[1], c0[3], c1[1], c1[3], c2[1], c2[3], c3[1], c3[3]};
        const unsigned aw[4] = {a.x, a.y, a.z, a.w}, bw[4] = {b.x, b.y, b.z, b.w};
        const float sc = DECAY ? exp2f(lg * (float)(127 - j)) : 1.0f;
        float o1[8], o2[8];
#pragma unroll
        for (int i = 0; i < 8; ++i) { const float x1 = h2f((u16)(aw[i >> 1] >> (16 * (i & 1)))), x2 = h2f((u16)(bw[i >> 1] >> (16 * (i & 1))));
            o1[i] = (x1 * co[i] - x2 * si[i]) * sc; o2[i] = (x2 * co[i] + x1 * si[i]) * sc; }
        if (TR) {
#pragma unroll
            for (int i = 0; i < 8; ++i) { dst[(8 * fc + i) * RP + j] = (_Float16)o1[i]; dst[(64 + 8 * fc + i) * RP + j] = (_Float16)o2[i]; }
        } else {
            v4u w1, w2; w1.x = cvt_pk_f16(o1[0], o1[1]); w1.y = cvt_pk_f16(o1[2], o1[3]); w1.z = cvt_pk_f16(o1[4], o1[5]); w1.w = cvt_pk_f16(o1[6], o1[7]);
            w2.x = cvt_pk_f16(o2[0], o2[1]); w2.y = cvt_pk_f16(o2[2], o2[3]); w2.z = cvt_pk_f16(o2[4], o2[5]); w2.w = cvt_pk_f16(o2[6], o2[7]);
            *(LAS v4u*)(dst + j * RP + 8 * fc) = w1; *(LAS v4u*)(dst + j * RP + 64 + 8 * fc) = w2; }
    }
}
__device__ __forceinline__ void ret_stage_vt(Frame& F, const u16* src, int row0, int h, LAS _Float16* dst) {
#pragma unroll
    for (int it = 0; it < 4; ++it) { const int ch = F.tid + 512 * it, j = ch & 127, fc = ch >> 7;
        const v4u a = *(const v4u*)(src + (size_t)(row0 + j) * 512 + h * 128 + 8 * fc); const unsigned aw[4] = {a.x, a.y, a.z, a.w};
#pragma unroll
        for (int i = 0; i < 8; ++i) dst[(8 * fc + i) * RP + j] = __builtin_bit_cast(_Float16, (u16)(aw[i >> 1] >> (16 * (i & 1)))); }
}
__device__ __forceinline__ void ret_r1_unit(Frame& F, int u) {
    const int bh = u >> 6, c = u & 63, b = bh >> 2, h = bh & 3, row0 = b * SEQ + c * 128, r32 = F.lane & 31, hi = F.lane >> 5;
    LAS _Float16* KT = (LAS _Float16*)(F.lds + RING_OFF); LAS _Float16* VT = (LAS _Float16*)(F.lds + RING_OFF + RT_BYTES);
    ret_stage_rot<true, true>(F, (const u16*)(F.ws + WS_KB), row0, c * 128, h, KT, ret_log2g(h));
    ret_stage_vt(F, (const u16*)(F.ws + WS_VB), row0, h, VT);
    __syncthreads();
    const int eb = F.wave >> 1, db0 = 2 * (F.wave & 1);
    f32x16 acc0 = {}, acc1 = {};
#pragma unroll
    for (int s = 0; s < 8; ++s) {
        const f16x8 a = *(const LAS f16x8*)(VT + (32 * eb + r32) * RP + 16 * s + 8 * hi);
        const f16x8 b0 = *(const LAS f16x8*)(KT + (32 * db0 + r32) * RP + 16 * s + 8 * hi);
        const f16x8 b1 = *(const LAS f16x8*)(KT + (32 * (db0 + 1) + r32) * RP + 16 * s + 8 * hi);
        acc0 = __builtin_amdgcn_mfma_f32_32x32x16_f16(a, b0, acc0, 0, 0, 0);
        acc1 = __builtin_amdgcn_mfma_f32_32x32x16_f16(a, b1, acc1, 0, 0, 0);
    }
    float* DS = (float*)(F.ws + WS_DS) + (size_t)u * 16384;
#pragma unroll
    for (int r = 0; r < 16; ++r) { const int e = 32 * eb + crow(r, hi); DS[e * 128 + 32 * db0 + r32] = acc0[r]; DS[e * 128 + 32 * (db0 + 1) + r32] = acc1[r]; }
    __syncthreads();
}
__device__ __forceinline__ void ret_r2_scan(Frame& F) {
    const float* DS = (const float*)(F.ws + WS_DS); u16* ST = (u16*)(F.ws + WS_ST);
    for (int e = F.vcu * (NWAVES * 64) + F.tid; e < 16 * 8192; e += F.G * NWAVES * 64) {
        const int bh = e >> 13, off = (e & 8191) * 2; const float dec = exp2f(128.0f * ret_log2g(bh & 3));
        float s0 = 0.f, s1 = 0.f;
#pragma unroll 1
        for (int c0 = 0; c0 < 64; c0 += 32) { f32x2 d[32];
#pragma unroll
            for (int j = 0; j < 32; ++j) d[j] = *(const f32x2*)(DS + ((size_t)(bh * 64 + c0 + j)) * 16384 + off);
#pragma unroll
            for (int j = 0; j < 32; ++j) { *(unsigned*)(ST + ((size_t)(bh * 64 + c0 + j)) * 16384 + off) = cvt_pk_f16(s0, s1); s0 = dec * s0 + d[j][0]; s1 = dec * s1 + d[j][1]; } }
    }
}
__device__ __forceinline__ void ret_r3_unit(Frame& F, int u, const float* gn_g) {
    const int bh = u >> 6, c = u & 63, b = bh >> 2, h = bh & 3, row0 = b * SEQ + c * 128, r32 = F.lane & 31, hi = F.lane >> 5;
    LAS _Float16* Qs = (LAS _Float16*)(F.lds + RING_OFF); LAS _Float16* Ks = (LAS _Float16*)(F.lds + RING_OFF + RT_BYTES);
    LAS _Float16* VT = (LAS _Float16*)(F.lds + RING_OFF + 2 * RT_BYTES); LAS _Float16* Ps = (LAS _Float16*)(F.lds + RING_OFF + 3 * RT_BYTES);
    LAS float* rowpart = (LAS float*)(F.lds + 2048);
    const float lg = ret_log2g(h);
    const int ib = F.wave >> 1, xb0 = 2 * (F.wave & 1);
    SUB_BEGIN(30);
    ret_stage_rot<false, false>(F, (const u16*)(F.ws + WS_QB), row0, c * 128, h, Qs, lg);
    ret_stage_rot<false, false>(F, (const u16*)(F.ws + WS_KB), row0, c * 128, h, Ks, lg);
    ret_stage_vt(F, (const u16*)(F.ws + WS_VB), row0, h, VT);
    __syncthreads();
    SUB_END(30);
    SUB_BEGIN(31);
#pragma unroll
    for (int t = 0; t < 2; ++t) { const int jb = xb0 + t; f32x16 acc = {};
        if (jb <= ib) {
#pragma unroll
            for (int s = 0; s < 8; ++s) { const f16x8 a = *(const LAS f16x8*)(Qs + (32 * ib + r32) * RP + 16 * s + 8 * hi); const f16x8 bb = *(const LAS f16x8*)(Ks + (32 * jb + r32) * RP + 16 * s + 8 * hi);
                acc = __builtin_amdgcn_mfma_f32_32x32x16_f16(a, bb, acc, 0, 0, 0); } }
        const int j = 32 * jb + r32;
#pragma unroll
        for (int r = 0; r < 16; ++r) { const int i = 32 * ib + crow(r, hi); const float v = (i >= j) ? acc[r] * exp2f(lg * (float)(i - j)) : 0.f; Ps[i * RP + j] = (_Float16)v; } }
    __syncthreads();
    SUB_END(31);
    SUB_BEGIN(32);
    const u16* ST = (const u16*)(F.ws + WS_ST) + (size_t)u * 16384;
    f32x16 y[2];
#pragma unroll
    for (int t = 0; t < 2; ++t) { const int eb = xb0 + t; f32x16 intra = {}, cross = {};
#pragma unroll
        for (int s = 0; s < 8; ++s) { if (s < 2 * (ib + 1)) { const f16x8 a = *(const LAS f16x8*)(Ps + (32 * ib + r32) * RP + 16 * s + 8 * hi); const f16x8 bb = *(const LAS f16x8*)(VT + (32 * eb + r32) * RP + 16 * s + 8 * hi);
                intra = __builtin_amdgcn_mfma_f32_32x32x16_f16(a, bb, intra, 0, 0, 0); } }
#pragma unroll
        for (int s = 0; s < 8; ++s) { const f16x8 a = *(const LAS f16x8*)(Qs + (32 * ib + r32) * RP + 16 * s + 8 * hi); const f16x8 bb = *(const f16x8*)(ST + (32 * eb + r32) * 128 + 16 * s + 8 * hi);
            cross = __builtin_amdgcn_mfma_f32_32x32x16_f16(a, bb, cross, 0, 0, 0); }
#pragma unroll
        for (int r = 0; r < 16; ++r) { const int i = 32 * ib + crow(r, hi); y[t][r] = intra[r] + exp2f(lg * (float)(i + 1)) * cross[r]; } }
    SUB_END(32);
    SUB_BEGIN(33);
    float ss[16];
#pragma unroll
    for (int r = 0; r < 16; ++r) { float v = y[0][r] * y[0][r] + y[1][r] * y[1][r];
#pragma unroll
        for (int o = 1; o < 32; o <<= 1) v += __shfl_xor(v, o);
        ss[r] = v; }
    __syncthreads();
#pragma unroll
    for (int r = 0; r < 16; ++r) { const int i = 32 * ib + crow(r, hi);
#pragma unroll
        for (int t = 0; t < 2; ++t) Ps[i * RP + 32 * (xb0 + t) + r32] = (_Float16)y[t][r]; }
    if (r32 == 0) {
#pragma unroll
        for (int r = 0; r < 16; ++r) rowpart[(F.wave & 1) * 128 + 32 * ib + crow(r, hi)] = ss[r]; }
    __syncthreads();
    { const u16* GBp = (const u16*)(F.ws + WS_GB); u16* MIX = F.mix;
#pragma unroll
      for (int it = 0; it < 4; ++it) { const int ch = F.tid + 512 * it, i = ch >> 4, ec = ch & 15;
          const float rinv = 1.0f / sqrtf((rowpart[i] + rowpart[128 + i]) * (1.0f / 128.0f) + EPS);
          const v4u yv = *(const LAS v4u*)(Ps + i * RP + 8 * ec), gv = *(const v4u*)(GBp + (size_t)(row0 + i) * 512 + h * 128 + 8 * ec);
          const f32x4 g0 = *(const f32x4*)(gn_g + h * 128 + 8 * ec), g1 = *(const f32x4*)(gn_g + h * 128 + 8 * ec + 4);
          const unsigned yw[4] = {yv.x, yv.y, yv.z, yv.w}, gw[4] = {gv.x, gv.y, gv.z, gv.w}; float o[8];
#pragma unroll
          for (int k = 0; k < 8; ++k) o[k] = h2f((u16)(yw[k >> 1] >> (16 * (k & 1)))) * rinv * (k < 4 ? g0[k & 3] : g1[k & 3]) * h2f((u16)(gw[k >> 1] >> (16 * (k & 1))));
          v4u w; w.x = cvt_pk_f16(o[0], o[1]); w.y = cvt_pk_f16(o[2], o[3]); w.z = cvt_pk_f16(o[4], o[5]); w.w = cvt_pk_f16(o[6], o[7]);
          *(v4u*)(MIX + (size_t)(row0 + i) * 1024 + 512 + h * 128 + 8 * ec) = w; } }
    SUB_END(33);
    __syncthreads();
}

constexpr int IDX_CAP = 64, IDX_SEG = 28, IDX_LCAP = 16 * IDX_SEG, IDX_OVF = 64;
struct IdxSt { unsigned lo, hi, need, shift, cnt, above, ready, pad; };
__device__ __forceinline__ unsigned ok_key(float s) { const unsigned u = __builtin_bit_cast(unsigned, s); return u ^ ((unsigned)((int)u >> 31) | 0x80000000u); }

__device__ __forceinline__ void lds_add(LAS unsigned* p, unsigned v) { (void)__hip_atomic_fetch_add(p, v, __ATOMIC_RELAXED, __HIP_MEMORY_SCOPE_WORKGROUP); }
__device__ __forceinline__ unsigned lds_add_rtn(LAS unsigned* p, unsigned v) { return __hip_atomic_fetch_add(p, v, __ATOMIC_RELAXED, __HIP_MEMORY_SCOPE_WORKGROUP); }
__device__ __forceinline__ void idx_unit(Frame& F, int b, int g) {
    int lane_u = F.lane; asm volatile("" : "+v"(lane_u));
    const int lane = lane_u, wid = F.wave, l15 = lane & 15, fq = lane >> 4, set = wid >> 2, wsub = wid & 3;
    const int q0 = 32 * g, NT64 = 4 * (g >> 3) + 4, qloc = 16 * set + l15, qpos = q0 + qloc;
    unsigned* BMu = (unsigned*)(F.ws + WS_BM) + ((size_t)(b * 256 + g) * 128) * 64;
    if (g < 8) {
        const int r32 = lane & 31, hi = lane >> 5;
        for (int T = wid; T < NT64; T += 8) { unsigned w = 0u; const int lim = q0 + r32 - 64 * T - 4 * hi;
#pragma unroll 1
            for (int gi = 0; gi < 8; ++gi) { int c = lim - 8 * (gi & 3) - 32 * (gi >> 2) + 1; c = c < 0 ? 0 : (c > 4 ? 4 : c); w |= ((1u << c) - 1u) << (4 * gi); }
            BMu[T * 64 + lane] = w; }
        return;
    }
    LAS unsigned* hist = (LAS unsigned*)(F.lds + RING_OFF);
    LAS unsigned* okarr = hist;
    LAS u16* keyarr = (LAS u16*)(hist + 32 * IDX_LCAP);
    LAS unsigned* ovf = hist + 32 * IDX_LCAP + 16 * IDX_LCAP;
    LAS unsigned* img = ovf + 32 * IDX_OVF * 2;
    volatile LAS unsigned* segcnt = (volatile LAS unsigned*)(F.lds + 2048);
    volatile LAS IdxSt* st = (volatile LAS IdxSt*)(F.lds + 1024);
    volatile LAS unsigned* flag = (volatile LAS unsigned*)(F.lds + 512);
    const size_t row = (size_t)b * SEQ + qpos;
    const u16* QI = (const u16*)(F.ws + WS_QI) + row * 512; const float* WI = (const float*)(F.ws + WS_WI) + row * 8;
    const u16* KIb = (const u16*)(F.ws + WS_KIH) + (size_t)b * SEQ * 64;
    float ch[8];
    { const f32x4 w0 = *(const f32x4*)WI, w1 = *(const f32x4*)(WI + 4);
      const float ssq_ = ((w0[0] * w0[0] + w0[1] * w0[1]) + (w0[2] * w0[2] + w0[3] * w0[3])) + ((w1[0] * w1[0] + w1[1] * w1[1]) + (w1[2] * w1[2] + w1[3] * w1[3]));
      const float fac_ = 0.0625f * 90.5f / sqrtf(ssq_ > 1e-30f ? ssq_ : 1e-30f);
      for (int j = 0; j < 4; ++j) { ch[j] = w0[j] * fac_; ch[4 + j] = w1[j] * fac_; } }
    f16x8 qf[8][2], qt[2];
#pragma unroll
    for (int h = 0; h < 8; ++h)
#pragma unroll
        for (int s = 0; s < 2; ++s) qf[h][s] = *(const f16x8*)(QI + h * 64 + 32 * s + 8 * fq);
#pragma unroll
    for (int s = 0; s < 2; ++s) {
#pragma unroll
        for (int i = 0; i < 8; ++i) { float a = 0.f;
#pragma unroll
            for (int h = 0; h < 8; ++h) a += ch[h] * (float)qf[h][s][i];
            qt[s][i] = (_Float16)a; } }
    const int nT = (g >> 1) + 1;
#define IDX_TILE(k0_, k1_, sc) do { \
        sc = __builtin_amdgcn_mfma_f32_16x16x32_f16(k0_, qt[0], (f32x4){0.f, 0.f, 0.f, 0.f}, 0, 0, 0); sc = __builtin_amdgcn_mfma_f32_16x16x32_f16(k1_, qt[1], sc, 0, 0, 0); \
        _Pragma("unroll") for (int h = 0; h < 8; ++h) { f32x4 dh_ = __builtin_amdgcn_mfma_f32_16x16x32_f16(k0_, qf[h][0], (f32x4){0.f, 0.f, 0.f, 0.f}, 0, 0, 0); dh_ = __builtin_amdgcn_mfma_f32_16x16x32_f16(k1_, qf[h][1], dh_, 0, 0, 0); \
            _Pragma("unroll") for (int i = 0; i < 4; ++i) sc[i] = __builtin_fmaf(__builtin_fabsf(dh_[i]), ch[h], sc[i]); } } while (0)
#define IDX_TILE_NS(k0_, k1_, sc) do {   \
        sc = __builtin_amdgcn_mfma_f32_16x16x32_f16(k0_, qt[0], (f32x4){0.f, 0.f, 0.f, 0.f}, 0, 0, 0); sc = __builtin_amdgcn_mfma_f32_16x16x32_f16(k1_, qt[1], sc, 0, 0, 0); \
        _Pragma("unroll") for (int h = 0; h < 8; ++h) { f32x4 dh_ = __builtin_amdgcn_mfma_f32_16x16x32_f16(k0_, qf[h][0], (f32x4){0.f, 0.f, 0.f, 0.f}, 0, 0, 0); dh_ = __builtin_amdgcn_mfma_f32_16x16x32_f16(k1_, qf[h][1], dh_, 0, 0, 0); \
            _Pragma("unroll") for (int i = 0; i < 4; ++i) { float a_ = __builtin_fmaf(__builtin_fabsf(dh_[i]), ch[h], sc[i]); if (i) asm("" : "+v"(a_)); sc[i] = a_; } } } while (0)
#define IDX_KTILE(dst, T, m) do { const u16* kp_ = KIb + (size_t)(64 * (T) + 16 * (m) + l15_) * 64 + 8 * fq_; dst[0] = *(const f16x8*)kp_; dst[1] = *(const f16x8*)(kp_ + 32); } while (0)

    const int floorb = 0;
#pragma unroll 1
    for (int attempt = (g >= 16) ? 0 : 1; attempt < 2; ++attempt) {
        const bool sampled = (attempt == 0);
        for (int i = F.tid; i < 8192; i += NWAVES * 64) ((LAS v4u*)hist)[i] = (v4u){0u, 0u, 0u, 0u};
        if (F.tid < 32) { st[F.tid].lo = 0u; st[F.tid].hi = 0xFFFFFFFFu; st[F.tid].need = 256u; st[F.tid].shift = 0u; st[F.tid].cnt = 0u; st[F.tid].above = 0u; st[F.tid].ready = 0u; st[F.tid].pad = 0u; }
        if (F.tid < 2) flag[F.tid] = 0u;
        __syncthreads();
        for (int level = 0; level < 8; ++level) {
            int l15_ = l15, fq_ = fq; asm volatile("" : "+v"(l15_), "+v"(fq_)); const int qloc_ = 16 * set + l15_; LAS unsigned* hq = hist + qloc_ * 1024;
            const unsigned rdy = st[qloc_].ready, lo = rdy ? 1u : st[qloc_].lo, width = rdy ? 0u : st[qloc_].hi - lo, sh = st[qloc_].shift;
            LDS_WAIT();
            const int Tstep = sampled ? 16 : 4, fl_ = sampled ? 0 : floorb;
            f16x8 kc[4][2];
#pragma unroll
            for (int m = 0; m < 4; ++m) IDX_KTILE(kc[m], wsub < nT ? wsub : 0, m);
            if (level == 0) {
                for (int T = wsub; T < nT; T += Tstep) { const int Tn = T + Tstep < nT ? T + Tstep : T;
#pragma unroll
                    for (int m = 0; m < 4; ++m) { const int kt = 64 * T + 16 * m;
                        f32x4 sc; IDX_TILE(kc[m][0], kc[m][1], sc);
                        IDX_KTILE(kc[m], Tn, m);
                        const int lim = qpos - kt - 4 * fq_;
#pragma unroll
                        for (int i = 0; i < 4; ++i) { int bin = (int)__builtin_floorf(sc[i]) + 512; bin = bin < 0 ? 0 : (bin > 1023 ? 1023 : bin);
                            if ((bin >= fl_) & (i <= lim)) lds_add(hq + bin, 1u); } } }
            } else {
                for (int T = wsub; T < nT; T += 4) { const int Tn = T + 4 < nT ? T + 4 : T;
#pragma unroll
                    for (int m = 0; m < 4; ++m) { const int kt = 64 * T + 16 * m;
                        f32x4 sc; IDX_TILE(kc[m][0], kc[m][1], sc);
                        IDX_KTILE(kc[m], Tn, m);
                        const int lim = qpos - kt - 4 * fq_;
#pragma unroll
                        for (int i = 0; i < 4; ++i) { const unsigned d = ok_key(sc[i]) - lo; unsigned bin = d >> sh; bin = bin > 1023u ? 1023u : bin;
                            if ((d <= width) & (i <= lim)) lds_add(hq + bin, 1u); } } }
            }
            __syncthreads();
#pragma unroll 1
            for (int qq = 0; qq < 4; ++qq) { const int q = 4 * wid + qq; if (st[q].ready) continue;
                int ln = lane; asm volatile("" : "+v"(ln));
                LAS unsigned* hw = hist + q * 1024 + 16 * ln; unsigned wv[16]; unsigned s_ = 0u;
#pragma unroll
                for (int i = 0; i < 16; ++i) { wv[i] = hw[i]; s_ += wv[i]; }
                unsigned suf = s_;
#pragma unroll
                for (int o = 1; o < 64; o <<= 1) { const unsigned t = __shfl_down(suf, o); if (ln + o < 64) suf += t; }
                const unsigned total = __shfl(suf, 0), aboveL = suf - s_;
                const unsigned qlo = st[q].lo, qhi = st[q].hi, qsh = st[q].shift, qneed = st[q].need;
                if (sampled) {
                    const int p_ = q0 + q, tm_ = p_ >> 6; const int ns_ = 64 * (4 * (tm_ >> 4) + ((tm_ & 15) < 4 ? (tm_ & 15) : 4)) + (((tm_ & 15) < 4) ? (p_ & 63) + 1 : 0);
                    const float f_ = (float)ns_ / (float)(p_ + 1), mean_ = 256.0f * f_, sd_ = sqrtf(256.0f * f_ * (1.0f - f_));
                    const int rhi_ = (int)(mean_ - 4.0f * sd_), rlo_ = (int)(mean_ + 4.0f * sd_) + 1; const unsigned thi_ = rhi_ < 1 ? 1u : (unsigned)rhi_, tlo_ = (unsigned)rlo_;
                    if (total < tlo_) { if (ln == 0) flag[1] = 1u; }
                    else {
#pragma unroll 1
                        for (int which = 0; which < 2; ++which) { const unsigned tgt = which ? tlo_ : thi_;
                            if (aboveL < tgt && tgt <= aboveL + s_) { unsigned accu = aboveL, bin = 0u; bool found = false;
#pragma unroll
                                for (int i = 15; i >= 0; --i) { if (!found && accu + wv[i] >= tgt) { found = true; bin = 16u * (unsigned)ln + i; } if (!found) accu += wv[i]; }
                                if (which) st[q].lo = ok_key((float)((int)bin - 512)); else st[q].hi = (bin == 1023u) ? 0xFFFFFFFFu : ok_key((float)((int)bin - 511)) - 1u; } }
                    }
                    if (ln == 0) st[q].ready = 1u;
                } else if (qneed > total) {
                    if (ln == 0) { if (level == 0) { st[q].hi = ok_key((float)(floorb - 512)) - 1u; st[q].lo = 0u; } else { st[q].hi = qlo - 1u; st[q].lo = 0u; } st[q].need = qneed - total; } }
                else if (aboveL < qneed && qneed <= aboveL + s_) {
                    unsigned accu = aboveL, bin = 0u, cbin = 0u; bool found = false;
#pragma unroll
                    for (int i = 15; i >= 0; --i) { if (!found && accu + wv[i] >= qneed) { found = true; bin = 16u * (unsigned)ln + i; cbin = wv[i]; } if (!found) accu += wv[i]; }
                    unsigned nlo, nhi;
                    if (level == 0) { nlo = (bin == 0u) ? 0u : ok_key((float)((int)bin - 512)); nhi = (bin == 1023u) ? 0xFFFFFFFFu : ok_key((float)((int)bin - 511)) - 1u; }
                    else { nlo = qlo + (bin << qsh); nhi = nlo + ((1u << qsh) - 1u); if (nhi < nlo || nhi > qhi || bin == 1023u) nhi = qhi; }
                    st[q].lo = nlo; st[q].hi = nhi; st[q].need = qneed - accu;
                    if (cbin <= (unsigned)IDX_CAP || (level > 0 && qsh == 0u)) st[q].ready = 1u; }
                LDS_WAIT();
                if (!st[q].ready) { const unsigned w_ = st[q].hi - st[q].lo; const unsigned nb = 32u - (unsigned)__builtin_clz(w_ | 1u); if (ln == 0) { st[q].shift = nb > 10u ? nb - 10u : 0u; flag[0] = 1u; } }
#pragma unroll
                for (int i = 0; i < 16; ++i) hw[i] = 0u;
            }
            __syncthreads();
            const unsigned again = flag[0];
            __syncthreads();
            if (F.tid == 0) flag[0] = 0u;
            if (!again) break;
        }
        { const unsigned fail_ = flag[1]; __syncthreads(); if (sampled && fail_) continue; }
        {
            int l15_ = l15, fq_ = fq; asm volatile("" : "+v"(l15_), "+v"(fq_)); const int qloc_ = 16 * set + l15_;
            const unsigned lo = st[qloc_].lo, hiK = st[qloc_].hi, width = hiK - lo;
            LDS_WAIT();
            float flo = __builtin_bit_cast(float, (lo & 0x80000000u) ? (lo ^ 0x80000000u) : ~lo), fhi = __builtin_bit_cast(float, (hiK & 0x80000000u) ? (hiK ^ 0x80000000u) : ~hiK);
            if (!(flo == flo)) flo = -INFINITY; if (!(fhi == fhi)) fhi = INFINITY;
            const int seg_ = wsub * 4 + fq_; LAS unsigned* okl = okarr + qloc_ * IDX_LCAP + seg_ * IDX_SEG; LAS u16* keyl = keyarr + qloc_ * IDX_LCAP + seg_ * IDX_SEG;
            unsigned nabove = 0u, mycnt = 0u;
            f16x8 kc[4][2];
#pragma unroll
            for (int m = 0; m < 4; ++m) IDX_KTILE(kc[m], wsub < nT ? wsub : 0, m);
            for (int T = wsub; T < NT64; T += 4) { unsigned part = 0u;
                if (T < nT) { const int Tn = T + 4 < nT ? T + 4 : T; const bool diag = (64 * T + 63 > q0);
#pragma unroll
                    for (int m = 0; m < 4; ++m) { const int kt = 64 * T + 16 * m;
                        f32x4 sc; IDX_TILE_NS(kc[m][0], kc[m][1], sc);
                        IDX_KTILE(kc[m], Tn, m);
                        if (diag) { const int lim = qpos - kt - 4 * fq_;
#pragma unroll
                            for (int i = 0; i < 4; ++i) sc[i] = (i <= lim) ? sc[i] : __builtin_nanf(""); }
                        const unsigned kb = (unsigned)(kt + 4 * fq_);
                        if (__builtin_amdgcn_ballot_w64(mycnt > (unsigned)(IDX_SEG - 4)) != 0ull) {
#pragma unroll
                            for (int i = 0; i < 4; ++i) { const bool sure = sc[i] > fhi;
                                part |= sure ? (1u << (16 * (m >> 1) + 8 * (m & 1) + i)) : 0u;
                                if ((sc[i] >= flo) & !sure) { if (mycnt < (unsigned)IDX_SEG) { okl[mycnt] = ok_key(sc[i]); keyl[mycnt] = (u16)(kb + i); }
                                    else { const unsigned pos = lds_add_rtn((LAS unsigned*)&st[qloc_].pad, 1u); if (pos < (unsigned)IDX_OVF) { ovf[(qloc_ * IDX_OVF + pos) * 2] = ok_key(sc[i]); ovf[(qloc_ * IDX_OVF + pos) * 2 + 1] = kb + i; } }
                                    mycnt += 1u; } }
                        } else {
#pragma unroll
                            for (int i = 0; i < 4; ++i) { const bool sure = sc[i] > fhi;
                                part |= sure ? (1u << (16 * (m >> 1) + 8 * (m & 1) + i)) : 0u;
                                okl[mycnt] = ok_key(sc[i]); keyl[mycnt] = (u16)(kb + i);
                                mycnt += ((sc[i] >= flo) & !sure) ? 1u : 0u; } }
                    }
                    nabove += (unsigned)__builtin_popcount(part);
                }
                part <<= 4 * (fq_ >> 1);
                const unsigned word = part | (unsigned)__shfl_xor((int)part, 32);
                if (fq_ < 2) img[T * 64 + qloc_ + 32 * (fq_ & 1)] = word; }
            lds_add((LAS unsigned*)&st[qloc_].above, nabove); lds_add((LAS unsigned*)&st[qloc_].cnt, mycnt);
            segcnt[qloc_ * 16 + seg_] = mycnt < (unsigned)IDX_SEG ? mycnt : (unsigned)IDX_SEG;
        }
        __syncthreads();
        if (sampled) {
            if (F.tid < 32) { const unsigned a = st[F.tid].above, c = st[F.tid].cnt; if (!(a < 256u && a + c >= 256u && st[F.tid].pad <= (unsigned)IDX_OVF)) flag[1] = 1u; else st[F.tid].need = 256u - a; }
            __syncthreads();
            const unsigned fail_ = flag[1]; __syncthreads();
            if (fail_) continue;
        }
#pragma unroll 1
        for (int qq = 0; qq < 4; ++qq) { int ln = lane; asm volatile("" : "+v"(ln)); const int q = 4 * wid + qq;
            const unsigned need = st[q].need;
            const LAS unsigned* lw = okarr + q * IDX_LCAP; const LAS u16* lk = keyarr + q * IDX_LCAP;
            const LAS unsigned* lo_ = ovf + q * IDX_OVF * 2; const unsigned novf = st[q].pad < (unsigned)IDX_OVF ? st[q].pad : (unsigned)IDX_OVF;
            unsigned ek[8];
#pragma unroll
            for (int k = 0; k < 7; ++k) { const unsigned j = (unsigned)ln + 64u * k; ek[k] = ((j % IDX_SEG) < segcnt[q * 16 + (j / IDX_SEG)]) ? lw[j] : 0u; }
            ek[7] = ((unsigned)ln < novf) ? lo_[2 * ln] : 0u;
            const unsigned rlo_ = st[q].lo, rhi_ = st[q].hi; const int topbit = 31 - (int)__builtin_clz((rlo_ ^ rhi_) | 1u);
            unsigned Tv = (topbit >= 31) ? 0u : (rlo_ & ~((2u << topbit) - 1u));
#pragma unroll 1
            for (int bit = topbit; bit >= 0; --bit) { const unsigned cand = Tv | (1u << bit); unsigned c = 0u;
#pragma unroll
                for (int k = 0; k < 8; ++k) c += (unsigned)__popcll(__ballot(ek[k] >= cand));
                if (c >= need) Tv = cand; }
            unsigned cgt = 0u, ceq = 0u;
#pragma unroll
            for (int k = 0; k < 8; ++k) { cgt += (unsigned)__popcll(__ballot(ek[k] > Tv)); ceq += (unsigned)__popcll(__ballot(ek[k] == Tv && ek[k] != 0u)); }
            const unsigned need_eq = need > cgt ? need - cgt : 0u;
#pragma unroll
            for (int k = 0; k < 8; ++k) { bool sel = ek[k] > Tv; const unsigned myj = (unsigned)ln + 64u * k;
                const unsigned mykey = (k < 7) ? (unsigned)lk[myj < (unsigned)IDX_LCAP ? myj : 0u] : lo_[2 * ln + 1];
                if (ek[k] == Tv && ek[k] != 0u) { if (need_eq >= ceq) sel = true; else { unsigned rk = 0u;
                        for (unsigned j = 0; j < (unsigned)IDX_LCAP; ++j) rk += ((j % IDX_SEG) < segcnt[q * 16 + (j / IDX_SEG)] && lw[j] == Tv && lk[j] < mykey) ? 1u : 0u;
                        for (unsigned j = 0; j < novf; ++j) rk += (lo_[2 * j] == Tv && lo_[2 * j + 1] < mykey) ? 1u : 0u; sel = rk < need_eq; } }
                if (sel) { const unsigned ki = mykey, T = ki >> 6, k64 = ki & 63u, half = k64 >> 5, k32 = k64 & 31u, khi = (k32 >> 2) & 1u, r = (k32 & 3u) + 4u * (k32 >> 3);
                    (void)__hip_atomic_fetch_or(img + T * 64 + (unsigned)q + 32u * khi, 1u << (16u * half + r), __ATOMIC_RELAXED, __HIP_MEMORY_SCOPE_WORKGROUP); } }
        }
        __syncthreads();
        { int t_ = F.tid; asm volatile("" : "+v"(t_)); for (int i = t_; i < NT64 * 16; i += NWAVES * 64) ((v4u*)BMu)[i] = ((const LAS v4u*)img)[i]; }
        break;
    }
    __syncthreads();
#undef IDX_TILE
#undef IDX_TILE_NS
#undef IDX_KTILE
}

__device__ __forceinline__ void final_norm(Frame& F, float* out, const float* part, const float* gfin) {
    const int gw = F.vcu * NWAVES + F.wave, NGW = F.G * NWAVES;
    for (int m = gw; m < MTOK; m += NGW) {
        float p = (F.lane < 16) ? part[(size_t)m * 16 + F.lane] : 0.f; p = wave_sum(p);
        const float r = 1.0f / sqrtf(p * (1.0f / DM) + EPS);
        f32x4* xr = (f32x4*)(out + (size_t)m * DM) + F.lane; const f32x4* gr = (const f32x4*)gfin + F.lane;
#pragma unroll
        for (int j = 0; j < 4; ++j) { const f32x4 v = xr[64 * j] * r * gr[64 * j]; xr[64 * j] = v; }
    }
}

struct Args { const float* in[13]; float* out; unsigned char* ws; int ph_lo, ph_hi, li, pad; };
__global__ void __launch_bounds__(NWAVES * 64, 2) hymba_fwd(Args args) {
    extern __shared__ __attribute__((aligned(16))) unsigned char lds_raw[];
    Frame F;
    F.lds = (LAS unsigned char*)lds_raw; F.ws = args.ws; F.mix = (u16*)args.out;
    F.tid = threadIdx.x; F.lane = F.tid & 63; F.wave = __builtin_amdgcn_readfirstlane(F.tid >> 6);
    F.G = gridDim.x; { const int bx = blockIdx.x; F.vcu = (F.G % 8 == 0) ? (bx % 8) * (F.G / 8) + bx / 8 : bx; }
    for (int u = F.tid; u < LCTL_BYTES / 4; u += NWAVES * 64) ((LAS unsigned*)F.lds)[u] = 0u;
    __syncthreads();
    gu32* ctl = (gu32*)(args.ws + WS_CTL);
    XcdBarrier bar; bar.bar = (unsigned*)(ctl + CW_BAR) + args.li * XCD_BAR_WORDS; bar.x = 0; bar.st = nullptr;
    if (N_LAUNCHES != N_PHASES) bar = xcd_barrier_post((unsigned*)(ctl + CW_BAR) + args.li * XCD_BAR_WORDS, (volatile LAS unsigned*)(F.lds + 64));
#define GRID_BAR() do { if (N_LAUNCHES != N_PHASES) xcd_barrier(bar); } while (0)
    const int lo = args.ph_lo, hi = args.ph_hi;
#ifndef PHASE_MASK
#define PHASE_MASK 0x1ff
#endif
#define IN(k) (((PHASE_MASK >> (k)) & 1) && lo <= (k) && (k) < hi)
#define BOTH(k) (IN(k) && IN((k) + 1))
#define PH_TID() do { int t_ = threadIdx.x; asm volatile("" : "+v"(t_)); F.tid = t_; F.lane = t_ & 63; F.wave = __builtin_amdgcn_readfirstlane(t_ >> 6); } while (0)
#ifdef PROBE_PHASE
#define PH_BEGIN(k) const unsigned long long t0_##k = ((k) == PROBE_PHASE) ? __builtin_amdgcn_s_memrealtime() : 0ull
#define PH_END(k) do { if ((k) == PROBE_PHASE) { const unsigned long long t1_ = __builtin_amdgcn_s_memrealtime(), dt_ = t1_ - t0_##k; while (__builtin_amdgcn_s_memrealtime() - t1_ < (unsigned long long)(PROBE_MULT) * dt_) __builtin_amdgcn_s_sleep(8); } } while (0)
#else
#define PH_BEGIN(k) do {} while (0)
#define PH_END(k) do {} while (0)
#endif
    const float* x = args.in[0];
    unsigned char* ws = args.ws;
    LAS unsigned char* ring = F.lds + RING_OFF;

    if (IN(0)) { PH_TID(); PH_BEGIN(0);
        P0Args A{x, args.in[1], args.in[2], args.in[5], args.in[7], args.in[8], args.in[9], args.in[10], args.in[11]};
        p0_prologue<0>(F, A, F.vcu, 0, F.G);
        if (F.G != 256) p0_prologue<1>(F, A, F.vcu, 0, F.G);
        PH_END(0);
        if (BOTH(0)) GRID_BAR();
    }
    if (IN(1)) { PH_TID(); PH_BEGIN(1);
        pg8::Gemm g{(const u16*)(ws + WS_XH), (const u16*)(ws + WS_WIN), MTOK, N_IN, DM}; pg8::StaticOrder S; S.init(MTOK, N_IN, F.G, (int)blockIdx.x);
        pg8::EpiProj E{ws + WS_QA, (float*)(ws + WS_KIRAW), (float*)(ws + WS_WI), (const float*)(ws + WS_RINV1)};
        pg8::gemm_phase<pg8::EpiProj, pg8::StaticOrder, true, true>(ring, g, S, E);
        if (F.G == 256) { P0Args A{x, args.in[1], args.in[2], args.in[5], args.in[7], args.in[8], args.in[9], args.in[10], args.in[11]}; __syncthreads(); p0_prologue<1>(F, A, (int)blockIdx.x, 128, 128); }
        PH_END(1);
        if (BOTH(1)) GRID_BAR();
    }
    if (IN(2)) { PH_TID(); PH_BEGIN(2);
        ki_layernorm(F, args.in[3], args.in[4]);
        for (int u = F.vcu; u < 1024; u += F.G) ret_r1_unit(F, u);
        PH_END(2);
        if (BOTH(2)) GRID_BAR();
    }
    if (IN(3)) { PH_TID(); PH_BEGIN(3);
        { PH_BEGIN(9); ret_r2_scan(F); PH_END(9); }
        PH_BEGIN(10);
        { const bool deal = (F.G == 256); const int bb = F.vcu >> 6, s = F.vcu & 63, nun = deal ? 4 : (1024 - F.vcu + F.G - 1) / F.G;
          _Pragma("unroll 1") for (int i = 0; i < nun; ++i) { int ub, ug; if (deal) { ub = bb; ug = (i == 0) ? 255 - s : (i == 1) ? 128 + s : (i == 2) ? 127 - s : s; } else { const int u = F.vcu + i * F.G; ub = u >> 8; ug = u & 255; }
              idx_unit(F, ub, ug); } }
        PH_END(10);
        PH_END(3);
        if (BOTH(3)) GRID_BAR();
    }
    if (IN(4)) { PH_TID(); PH_BEGIN(4);
        { PH_BEGIN(11); for (int u = F.vcu; u < 1024; u += F.G) ret_r3_unit(F, u, args.in[6]); PH_END(11); }
        PH_BEGIN(12);
        const attn_body::AttnTensors AT{(const attn_body::bf16*)(ws + WS_QA), (const attn_body::bf16*)(ws + WS_KA), (const attn_body::bf16*)(ws + WS_VA), F.mix, (const unsigned*)(ws + WS_BM), (const float*)(ws + WS_BIAS)};
        if (F.G == 256) { const attn_body::StaticOrder S((int)F.G, (int)blockIdx.x); attn_body::attn_phase<attn_body::StaticOrder>((char*)lds_raw + RING_OFF, AT, S); }
        else { const attn_body::StridedOrder S((int)F.G, (int)blockIdx.x); attn_body::attn_phase<attn_body::StridedOrder>((char*)lds_raw + RING_OFF, AT, S); }
        PH_END(12);
        PH_END(4);
        if (BOTH(4)) GRID_BAR();
    }
    if (IN(5)) { PH_TID(); PH_BEGIN(5);
        pg8::Gemm g{(const u16*)F.mix, (const u16*)(ws + WS_WOUT), MTOK, DM, DM}; pg8::StaticOrder S; S.init(MTOK, DM, F.G, (int)blockIdx.x);
        pg8::EpiX2 E{(const u16*)(ws + WS_XH), (u16*)(ws + WS_X2H), (float*)(ws + WS_PART2)};
        pg8::gemm_phase<pg8::EpiX2, pg8::StaticOrder, true, true>(ring, g, S, E);
        PH_END(5);
        if (BOTH(5)) GRID_BAR();
    }
    if (IN(6)) { PH_TID(); PH_BEGIN(6);
        pg8::Gemm g{(const u16*)(ws + WS_X2H), (const u16*)(ws + WS_WGU), MTOK, 2 * DFF, DM}; pg8::StaticOrder S; S.init(MTOK, 2 * DFF, F.G, (int)blockIdx.x);
        pg8::EpiGU E{(u16*)(ws + WS_U), (const float*)(ws + WS_PART2)};
        pg8::gemm_phase<pg8::EpiGU, pg8::StaticOrder, true, true>(ring, g, S, E);
        PH_END(6);
        if (BOTH(6)) GRID_BAR();
    }
    if (IN(7)) { PH_TID(); PH_BEGIN(7);
        pg8::Gemm g{(const u16*)(ws + WS_U), (const u16*)(ws + WS_WD), MTOK, DM, DFF}; pg8::StaticOrder S; S.init(MTOK, DM, F.G, (int)blockIdx.x);
#ifdef UNFUSED_FINAL_NORM
        pg8::EpiDown E{(const u16*)(ws + WS_X2H), args.out, (float*)(ws + WS_PART3)};
        pg8::gemm_phase<pg8::EpiDown, pg8::StaticOrder, true, true>(ring, g, S, E);
        PH_END(7);
        if (BOTH(7)) GRID_BAR();
#else
        pg8::EpiDownNorm E{(const u16*)(ws + WS_X2H), args.out, (float*)(ws + WS_PART3), (unsigned*)(ctl + 16384), args.in[12]};
        pg8::gemm_phase<pg8::EpiDownNorm, pg8::StaticOrder, true, true>(ring, g, S, E);
        PH_END(7);
#endif
    }
#ifdef UNFUSED_FINAL_NORM
    if (IN(8)) { PH_TID(); PH_BEGIN(8); final_norm(F, args.out, (const float*)(ws + WS_PART3), args.in[12]); PH_END(8); }
#endif
#undef IN
#undef BOTH
#undef GRID_BAR
}


#ifdef DIAG_DETERMINISM
__global__ void k_checksum(const unsigned* p, size_t nwords, unsigned long long* slot) {
    unsigned long long s = 0; for (size_t i = (size_t)blockIdx.x * blockDim.x + threadIdx.x; i < nwords; i += (size_t)gridDim.x * blockDim.x) s += (unsigned long long)p[i] * (unsigned long long)((i & 1023u) + 1u);
    for (int o = 32; o >= 1; o >>= 1) s += __shfl_xor(s, o);
    if ((threadIdx.x & 63) == 0) atomicAdd(slot, s);
}
#ifndef DIAG_PASSES
#define DIAG_PASSES 4
#endif
__global__ void k_checksum_cols(const unsigned* p, int rows, int pitchw, int c0, int c1, unsigned long long* slot) {
    unsigned long long s = 0; const int w = c1 - c0; for (size_t i = (size_t)blockIdx.x * blockDim.x + threadIdx.x; i < (size_t)rows * w; i += (size_t)gridDim.x * blockDim.x) { const size_t r = i / w, c = c0 + i % w; s += (unsigned long long)p[r * pitchw + c] * (unsigned long long)((i & 1023u) + 1u); }
    for (int o = 32; o >= 1; o >>= 1) s += __shfl_xor(s, o);
    if ((threadIdx.x & 63) == 0) atomicAdd(slot, s);
}
__global__ void k_report(float* out, const unsigned long long* cs, const int* phase_of, int nbuf, size_t n) {
    int ph = -1; for (int i = 0; i < nbuf && ph < 0; ++i) for (int p = 1; p < DIAG_PASSES; ++p) if (cs[i] != cs[64 * p + i]) { ph = phase_of[i]; break; }
    if (ph < 0) return; const float delta = 0.1f * (float)(ph + 1);
    for (size_t i = (size_t)blockIdx.x * blockDim.x + threadIdx.x; i < n; i += (size_t)gridDim.x * blockDim.x) out[i] += delta;
}
__global__ void k_setphase(int* phase_of, unsigned long long packed_lo, unsigned long long packed_hi) { const int i = threadIdx.x; if (i < 32) phase_of[i] = (int)(((i < 16 ? packed_lo : packed_hi) >> (4 * (i & 15))) & 15ull); }
extern "C" void kernel_launch(void* const* d_in, const int* in_sizes, int n_in, void* d_out, int out_size, void* d_ws, size_t ws_size, hipStream_t stream) {
    static int grid = 0;
    if (grid == 0) { int dev = 0, cus = 0; hipGetDevice(&dev); hipDeviceGetAttribute(&cus, hipDeviceAttributeMultiprocessorCount, dev);
        if (hipFuncSetAttribute((const void*)hymba_fwd, hipFuncAttributeMaxDynamicSharedMemorySize, LDS_BYTES) != hipSuccess) { grid = -1; return; } grid = cus; }
    if (grid < 0) return;
    hipMemsetAsync((char*)d_ws + WS_CTL, 0, CTL_ZERO_BYTES, stream);
    Args a{}; for (int i = 0; i < 13; ++i) a.in[i] = (const float*)d_in[i]; a.out = (float*)d_out; a.ws = (unsigned char*)d_ws;
    unsigned char* ws = (unsigned char*)d_ws; unsigned long long* cs = (unsigned long long*)(ws + 100 * 1024);
    struct B { int ph; const void* p; size_t bytes; };
    const B bufs[] = { {0, ws + WS_XH, (size_t)MTOK * DM * 2}, {0, ws + WS_RINV1, (size_t)MTOK * 4}, {0, ws + WS_WIN, (size_t)N_IN * 1024 * 2}, {1, ws + WS_WOUT, (size_t)1024 * 1024 * 2}, {1, ws + WS_WGU, (size_t)5632 * 1024 * 2}, {1, ws + WS_WD, (size_t)1024 * DFF * 2}, {1, ws + WS_CS, (size_t)SEQ * 64 * 8}, {0, ws + WS_BIAS, (size_t)8 * 128 * 4},
        {1, ws + WS_QA, 32 * MiB}, {1, ws + WS_KA, 32 * MiB}, {1, ws + WS_VA, 32 * MiB}, {1, ws + WS_QI, 32 * MiB}, {1, ws + WS_QB, 32 * MiB}, {1, ws + WS_KB, 32 * MiB}, {1, ws + WS_VB, 32 * MiB}, {1, ws + WS_GB, 32 * MiB}, {1, ws + WS_KIRAW, 8 * MiB}, {1, ws + WS_WI, 1 * MiB},
        {2, ws + WS_KIH, 4 * MiB}, {2, ws + WS_DS, 64 * MiB}, {3, ws + WS_ST, 32 * MiB}, {3, ws + WS_BM, 32 * MiB}, {4, d_out, 1}, {9, d_out, 2},
        {5, ws + WS_X2H, 64 * MiB}, {5, ws + WS_PART2, 2 * MiB}, {6, ws + WS_U, (size_t)MTOK * DFF * 2}, {7, d_out, 128 * MiB}, {7, ws + WS_PART3, 2 * MiB} };
    const int nbuf = (int)(sizeof(bufs) / sizeof(bufs[0]));
    for (int pass = 0; pass < DIAG_PASSES; ++pass)
        for (int li = 0; li < N_PHASES; ++li) {
            a.ph_lo = li; a.ph_hi = li + 1; a.li = 0; a.pad = 0;
            hipLaunchKernelGGL(hymba_fwd, dim3(grid), dim3(NWAVES * 64), LDS_BYTES, stream, a);
            for (int k = 0; k < nbuf; ++k) { if (bufs[k].bytes <= 2) { if (li == 4) hipLaunchKernelGGL(k_checksum_cols, dim3(1024), dim3(256), 0, stream, (const unsigned*)bufs[k].p, MTOK, 512, bufs[k].bytes == 1 ? 0 : 256, bufs[k].bytes == 1 ? 256 : 512, cs + pass * 64 + k); }
                else if (bufs[k].ph == li) hipLaunchKernelGGL(k_checksum, dim3(1024), dim3(256), 0, stream, (const unsigned*)bufs[k].p, bufs[k].bytes / 4, cs + pass * 64 + k); }
        }
    unsigned long long plo = 0, phi = 0; for (int k = 0; k < nbuf; ++k) { if (k < 16) plo |= (unsigned long long)bufs[k].ph << (4 * k); else phi |= (unsigned long long)bufs[k].ph << (4 * (k - 16)); }
    int* phase_of = (int*)(ws + 104 * 1024);
    hipLaunchKernelGGL(k_setphase, dim3(1), dim3(64), 0, stream, phase_of, plo, phi);
    hipLaunchKernelGGL(k_report, dim3(1024), dim3(256), 0, stream, (float*)d_out, (const unsigned long long*)cs, (const int*)phase_of, nbuf, (size_t)MTOK * DM);
}
#else
extern "C" void kernel_launch(void* const* d_in, const int* in_sizes, int n_in, void* d_out, int out_size, void* d_ws, size_t ws_size, hipStream_t stream) {
    static int grid = 0;
    if (grid == 0) {
        if (n_in != 13 || in_sizes[0] != MTOK * DM || out_size != MTOK * DM || ws_size < WS_END) { fprintf(stderr, "kernel_launch: unexpected shapes / workspace (%d inputs, ws %zu)\n", n_in, ws_size); grid = -1; return; }
        int dev = 0, cus = 0, per_cu = 0;
        if (hipGetDevice(&dev) != hipSuccess || hipDeviceGetAttribute(&cus, hipDeviceAttributeMultiprocessorCount, dev) != hipSuccess) { grid = -1; return; }
        if (hipFuncSetAttribute((const void*)hymba_fwd, hipFuncAttributeMaxDynamicSharedMemorySize, LDS_BYTES) != hipSuccess) { fprintf(stderr, "kernel_launch: hipFuncSetAttribute failed\n"); grid = -1; return; }
        if (hipOccupancyMaxActiveBlocksPerMultiprocessor(&per_cu, (const void*)hymba_fwd, NWAVES * 64, LDS_BYTES) != hipSuccess || per_cu < 1) { fprintf(stderr, "kernel_launch: occupancy query reports %d workgroups per CU\n", per_cu); }
        (void)hipGetLastError();
        grid = cus;
    }
    if (grid < 0) return;
    if (hipMemsetAsync((char*)d_ws + WS_CTL, 0, CTL_ZERO_BYTES, stream) != hipSuccess) return;
    Args a{};
    for (int i = 0; i < 13; ++i) a.in[i] = (const float*)d_in[i];
    a.out = (float*)d_out; a.ws = (unsigned char*)d_ws;
    for (int li = 0; li < N_LAUNCHES; ++li) {
        a.ph_lo = (N_LAUNCHES == N_PHASES) ? li : 0; a.ph_hi = (N_LAUNCHES == N_PHASES) ? li + 1 : N_PHASES; a.li = (N_LAUNCHES == N_PHASES) ? 0 : li; a.pad = 0;
        hipLaunchKernelGGL(hymba_fwd, dim3(grid), dim3(NWAVES * 64), LDS_BYTES, stream, a);
    }
}
#endif
```

```cpp
#include <hip/hip_runtime.h>
#include <hip/hip_bf16.h>
#include <cstdio>
#include <cstdint>
#include <cmath>

#define GAS __attribute__((address_space(1)))
#define LAS __attribute__((address_space(3)))
typedef unsigned short u16;
typedef _Float16 f16x8 __attribute__((ext_vector_type(8)));
typedef _Float16 f16x2 __attribute__((ext_vector_type(2)));
typedef float f32x2 __attribute__((ext_vector_type(2)));
typedef float f32x4 __attribute__((ext_vector_type(4)));
typedef float f32x16 __attribute__((ext_vector_type(16)));
typedef unsigned v4u __attribute__((ext_vector_type(4)));
typedef unsigned v2u __attribute__((ext_vector_type(2)));
typedef GAS unsigned gu32;
#define RLX_AGENT __ATOMIC_RELAXED, __HIP_MEMORY_SCOPE_AGENT
#define LDS_WAIT() asm volatile("s_waitcnt lgkmcnt(0)" ::: "memory")
#define VM_WAIT() asm volatile("s_waitcnt vmcnt(0)" ::: "memory")

__device__ __forceinline__ unsigned cvt_pk_f16(float lo, float hi) { f32x2 v = {lo, hi}; f16x2 h = __builtin_convertvector(v, f16x2); return __builtin_bit_cast(unsigned, h); }
__device__ __forceinline__ unsigned cvt_pk_bf16(float lo, float hi) { unsigned r; asm volatile("v_cvt_pk_bf16_f32 %0, %1, %2" : "=v"(r) : "v"(lo), "v"(hi)); return r; }
__device__ __forceinline__ float h2f(u16 h) { return (float)__builtin_bit_cast(_Float16, h); }
__device__ __forceinline__ float silu_f(float x) { return x * __builtin_amdgcn_rcpf(1.0f + __builtin_amdgcn_exp2f(-1.4426950408889634f * x)); }
__device__ __forceinline__ int crow(int r, int hi) { return (r & 3) + 8 * (r >> 2) + 4 * hi; }

constexpr int BATCH = 4, SEQ = 8192, DM = 1024, MTOK = BATCH * SEQ;
constexpr int NHA = 8, DHA = 64, NHB = 4, DHB = 128, DFF = 2816;
constexpr int N_IN = 4352;
constexpr float EPS = 1e-6f;
constexpr float C2 = 0.125f * 1.4426950408889634f;

namespace pg8 {
#define PG8_LAS __attribute__((address_space(3)))
constexpr int BM = 256, BK = 64, HALF = 128, HTB = HALF * BK * 2, STAGE_BYTES = 8 * HTB, NXCD = 8, WGM = 8;
__host__ __device__ __forceinline__ int lds_byte(int r, int c) { const int st = (r >> 4) * 2 + (c >> 5), rr = r & 15, cc = c & 31, ob = rr * 64 + cc * 2; return st * 1024 + (ob ^ (((ob >> 9) & 1) << 5)); }
__host__ __device__ __forceinline__ void stage_rc(int b, int& R, int& C) { const int st = b / 1024, sb = b % 1024, swz = sb ^ (((sb >> 9) & 1) << 5); R = (st >> 1) * 16 + swz / 64; C = (st & 1) * 32 + (swz % 64) / 2; }
__host__ __device__ __forceinline__ int perm32(int rho) { const int n = rho >> 4, i = rho & 15; return 8 * (i >> 2) + 4 * n + (i & 3); }
struct Unit { int pm, pn; };
struct Gemm { const u16* A; const u16* Bt; int M, N, K; };
struct StaticOrder {
    int nM, nN, nwg, G, c;
    __host__ __device__ void init(int M, int N, int G_, int c_) { nM = M / BM; nN = N / BM; nwg = nM * nN; G = G_; c = c_; }
    __host__ __device__ bool next(int i, Unit& u) const {
        const long L = (long)i * G + c; if (L >= nwg) return false;
        int wgid = (int)L; { const int q = nwg / NXCD, r = nwg % NXCD, xcd = wgid % NXCD, off = wgid / NXCD; wgid = (xcd < r ? xcd * (q + 1) : r * (q + 1) + (xcd - r) * q) + off; }
        const int nig = WGM * nN, gid = wgid / nig, fm = gid * WGM, gsz = (nM - fm) < WGM ? (nM - fm) : WGM;
        u.pm = fm + ((wgid % nig) % gsz); u.pn = (wgid % nig) / gsz; return true;
    }
    __device__ __forceinline__ void a_ready(const Unit&) const {}
    __device__ __forceinline__ void done(const Unit&) const {}
};

struct EpiProj {
    static constexpr int PROBE_ID = 40;
    static constexpr bool PERM = true, AFTER_DRAIN = false;
    unsigned char* tbase; float* kiraw; float* wi; const float* rinv;
    __device__ __forceinline__ void operator()(const f32x4 (&acc)[2][2][4][2], const Unit& u, int wr, int wc, int fr, int fq) const {
        const int row0 = u.pm * BM + wr * 64 + fr; const int pn = u.pn;
        float rr[2][4];
#pragma unroll
        for (int ai = 0; ai < 2; ++ai)
#pragma unroll
            for (int m = 0; m < 4; ++m) rr[ai][m] = rinv[row0 + ai * HALF + m * 16];
        if (pn < 16) {
            const int tsel = pn >> 1; u16* T = (u16*)(tbase + (size_t)tsel * (32u << 20));
            const int colt = (pn & 1) * 256 + wc * 32 + 8 * fq;
            const float sc = (tsel == 0) ? C2 : ((tsel == 5) ? 0.08838834764831845f : 1.0f);
#pragma unroll
            for (int ai = 0; ai < 2; ++ai)
#pragma unroll
                for (int m = 0; m < 4; ++m) { const int row = row0 + ai * HALF + m * 16; const float r = rr[ai][m] * sc; u16* rowp = T + (size_t)row * 512 + colt;
#pragma unroll
                    for (int bj = 0; bj < 2; ++bj) { f32x4 v0 = acc[ai][bj][m][0] * r, v1 = acc[ai][bj][m][1] * r;
                        if (tsel == 7) {
#pragma unroll
                            for (int j = 0; j < 4; ++j) { v0[j] = silu_f(v0[j]); v1[j] = silu_f(v1[j]); } }
                        v4u w;
                        if (tsel < 3) { w.x = cvt_pk_bf16(v0[0], v0[1]); w.y = cvt_pk_bf16(v0[2], v0[3]); w.z = cvt_pk_bf16(v1[0], v1[1]); w.w = cvt_pk_bf16(v1[2], v1[3]); }
                        else { w.x = cvt_pk_f16(v0[0], v0[1]); w.y = cvt_pk_f16(v0[2], v0[3]); w.z = cvt_pk_f16(v1[0], v1[1]); w.w = cvt_pk_f16(v1[2], v1[3]); }
                        *(v4u*)(rowp + bj * HALF) = w; } }
        } else {
            const int c0 = wc * 32 + 8 * fq;
            if (c0 <= 64) {
                float* dst = (c0 < 64) ? kiraw + c0 : wi; const int stride = (c0 < 64) ? 64 : 8; const float s2 = (c0 < 64) ? 1.0f : 0.35355339059327373f;
#pragma unroll
                for (int ai = 0; ai < 2; ++ai)
#pragma unroll
                    for (int m = 0; m < 4; ++m) { const int row = row0 + ai * HALF + m * 16; const float r = rr[ai][m] * s2;
                        *(f32x4*)(dst + (size_t)row * stride) = acc[ai][0][m][0] * r; *(f32x4*)(dst + (size_t)row * stride + 4) = acc[ai][0][m][1] * r; } }
        }
    }
};
struct EpiX2 {
    static constexpr int PROBE_ID = 41;
    static constexpr bool PERM = true, AFTER_DRAIN = false;
    const u16* xh; u16* x2h; float* part;
    __device__ __forceinline__ void operator()(const f32x4 (&acc)[2][2][4][2], const Unit& u, int wr, int wc, int fr, int fq) const {
        const int row0 = u.pm * BM + wr * 64 + fr, col0 = u.pn * BM + wc * 32 + 8 * fq;
        v4u xx[2][4][2];
#pragma unroll
        for (int ai = 0; ai < 2; ++ai)
#pragma unroll
            for (int m = 0; m < 4; ++m)
#pragma unroll
                for (int bj = 0; bj < 2; ++bj) xx[ai][m][bj] = *(const v4u*)(xh + (size_t)(row0 + ai * HALF + m * 16) * DM + col0 + bj * HALF);
#pragma unroll
        for (int ai = 0; ai < 2; ++ai)
#pragma unroll
            for (int m = 0; m < 4; ++m) { const int row = row0 + ai * HALF + m * 16; const size_t off = (size_t)row * DM + col0; float ss = 0.f;
#pragma unroll
                for (int bj = 0; bj < 2; ++bj) { const v4u x = xx[ai][m][bj];
                    const f32x4 v0 = (f32x4){h2f((u16)(x.x & 0xffffu)), h2f((u16)(x.x >> 16)), h2f((u16)(x.y & 0xffffu)), h2f((u16)(x.y >> 16))} + acc[ai][bj][m][0];
                    const f32x4 v1 = (f32x4){h2f((u16)(x.z & 0xffffu)), h2f((u16)(x.z >> 16)), h2f((u16)(x.w & 0xffffu)), h2f((u16)(x.w >> 16))} + acc[ai][bj][m][1];
                    v4u h; h.x = cvt_pk_f16(v0[0], v0[1]); h.y = cvt_pk_f16(v0[2], v0[3]); h.z = cvt_pk_f16(v1[0], v1[1]); h.w = cvt_pk_f16(v1[2], v1[3]); *(v4u*)(x2h + off + bj * HALF) = h;
                    ss += ((v0[0] * v0[0] + v0[1] * v0[1]) + (v0[2] * v0[2] + v0[3] * v0[3])) + ((v1[0] * v1[0] + v1[1] * v1[1]) + (v1[2] * v1[2] + v1[3] * v1[3])); }
                ss += __shfl_xor(ss, 16); ss += __shfl_xor(ss, 32);
                if (fq == 0) part[(size_t)row * 16 + u.pn * 4 + wc] = ss; }
    }
};
struct EpiGU {
    static constexpr int PROBE_ID = 42;
    static constexpr bool PERM = true, AFTER_DRAIN = false;
    u16* U; const float* part;
    __device__ __forceinline__ void operator()(const f32x4 (&acc)[2][2][4][2], const Unit& u, int wr, int wc, int fr, int fq) const {
        const int row0 = u.pm * BM + wr * 64 + fr, colt = u.pn * HALF + wc * 32 + 8 * fq;
        f32x4 pq[2][4]; float rr[2][4];
#pragma unroll
        for (int ai = 0; ai < 2; ++ai)
#pragma unroll
            for (int m = 0; m < 4; ++m) pq[ai][m] = *(const f32x4*)(part + (size_t)(row0 + ai * HALF + m * 16) * 16 + 4 * fq);
#pragma unroll
        for (int ai = 0; ai < 2; ++ai)
#pragma unroll
            for (int m = 0; m < 4; ++m) { float sq = (pq[ai][m][0] + pq[ai][m][1]) + (pq[ai][m][2] + pq[ai][m][3]); sq += __shfl_xor(sq, 16); sq += __shfl_xor(sq, 32);
                rr[ai][m] = __builtin_amdgcn_rsqf(sq * (1.0f / DM) + EPS); }
#pragma unroll
        for (int ai = 0; ai < 2; ++ai)
#pragma unroll
            for (int m = 0; m < 4; ++m) { const int row = row0 + ai * HALF + m * 16;
                const float r = rr[ai][m];
                float o[8];
#pragma unroll
                for (int n = 0; n < 2; ++n)
#pragma unroll
                    for (int j = 0; j < 4; ++j) o[4 * n + j] = silu_f(acc[ai][0][m][n][j] * r) * (acc[ai][1][m][n][j] * r);
                v4u w; w.x = cvt_pk_f16(o[0], o[1]); w.y = cvt_pk_f16(o[2], o[3]); w.z = cvt_pk_f16(o[4], o[5]); w.w = cvt_pk_f16(o[6], o[7]);
                *(v4u*)(U + (size_t)row * DFF + colt) = w; }
    }
};
struct EpiDownNorm {
    static constexpr int PROBE_ID = 43;
    static constexpr bool PERM = true, AFTER_DRAIN = false;
    const u16* x2h; float* out; float* part; unsigned* cnt; const float* gfin;
    __device__ __forceinline__ void operator()(f32x4 (&acc)[2][2][4][2], const Unit& u, int wr, int wc, int fr, int fq) const {
        const int row0 = u.pm * BM + wr * 64 + fr, col0 = u.pn * BM + wc * 32 + 8 * fq;
        { v4u xx[2][4][2];
#pragma unroll
          for (int ai = 0; ai < 2; ++ai)
#pragma unroll
              for (int m = 0; m < 4; ++m)
#pragma unroll
                  for (int bj = 0; bj < 2; ++bj) xx[ai][m][bj] = *(const v4u*)(x2h + (size_t)(row0 + ai * HALF + m * 16) * DM + col0 + bj * HALF);
#pragma unroll
          for (int ai = 0; ai < 2; ++ai)
#pragma unroll
              for (int m = 0; m < 4; ++m) { const int row = row0 + ai * HALF + m * 16; float ss = 0.f;
#pragma unroll
                  for (int bj = 0; bj < 2; ++bj) { const v4u x = xx[ai][m][bj];
                      const f32x4 v0 = (f32x4){h2f((u16)(x.x & 0xffffu)), h2f((u16)(x.x >> 16)), h2f((u16)(x.y & 0xffffu)), h2f((u16)(x.y >> 16))} + acc[ai][bj][m][0];
                      const f32x4 v1 = (f32x4){h2f((u16)(x.z & 0xffffu)), h2f((u16)(x.z >> 16)), h2f((u16)(x.w & 0xffffu)), h2f((u16)(x.w >> 16))} + acc[ai][bj][m][1];
                      acc[ai][bj][m][0] = v0; acc[ai][bj][m][1] = v1;
                      ss += ((v0[0] * v0[0] + v0[1] * v0[1]) + (v0[2] * v0[2] + v0[3] * v0[3])) + ((v1[0] * v1[0] + v1[1] * v1[1]) + (v1[2] * v1[2] + v1[3] * v1[3])); }
                  ss += __shfl_xor(ss, 16); ss += __shfl_xor(ss, 32);
                  if (fq == 0) __hip_atomic_store((unsigned*)(part + (size_t)row * 16 + u.pn * 4 + wc), __builtin_bit_cast(unsigned, ss), __ATOMIC_RELAXED, __HIP_MEMORY_SCOPE_AGENT); } }
        asm volatile("s_waitcnt vmcnt(0)" ::: "memory");
        __builtin_amdgcn_s_barrier(); asm volatile("" ::: "memory");
        unsigned* cw = cnt + 64 * u.pm;
        if (threadIdx.x == 0) (void)__hip_atomic_fetch_add(cw, 1u, __ATOMIC_RELAXED, __HIP_MEMORY_SCOPE_AGENT);
        if (threadIdx.x < 64) { unsigned spins = 0u;
            while ((unsigned)__builtin_amdgcn_readfirstlane(__hip_atomic_load(cw, __ATOMIC_RELAXED, __HIP_MEMORY_SCOPE_AGENT)) < 4u) { __builtin_amdgcn_s_sleep(2); if (++spins > (1u << 22)) break; }
            __builtin_amdgcn_fence(__ATOMIC_ACQUIRE, "agent");
            asm volatile("s_waitcnt vmcnt(0)" ::: "memory"); }
        asm volatile("" ::: "memory"); __builtin_amdgcn_s_barrier(); asm volatile("" ::: "memory");
        f32x4 gv[2][2], pq[2][4]; float rr[2][4];
#pragma unroll
        for (int ai = 0; ai < 2; ++ai)
#pragma unroll
            for (int m = 0; m < 4; ++m) pq[ai][m] = *(const f32x4*)(part + (size_t)(row0 + ai * HALF + m * 16) * 16 + 4 * fq);
#pragma unroll
        for (int bj = 0; bj < 2; ++bj)
#pragma unroll
            for (int n = 0; n < 2; ++n) gv[bj][n] = *(const f32x4*)(gfin + col0 + bj * HALF + 4 * n);
#pragma unroll
        for (int ai = 0; ai < 2; ++ai)
#pragma unroll
            for (int m = 0; m < 4; ++m) { float sq = (pq[ai][m][0] + pq[ai][m][1]) + (pq[ai][m][2] + pq[ai][m][3]); sq += __shfl_xor(sq, 16); sq += __shfl_xor(sq, 32);
                rr[ai][m] = __builtin_amdgcn_rsqf(sq * (1.0f / DM) + EPS); }
#pragma unroll
        for (int ai = 0; ai < 2; ++ai)
#pragma unroll
            for (int m = 0; m < 4; ++m) { const size_t off = (size_t)(row0 + ai * HALF + m * 16) * DM + col0; const float r = rr[ai][m];
#pragma unroll
                for (int bj = 0; bj < 2; ++bj)
#pragma unroll
                    for (int n = 0; n < 2; ++n) *(f32x4*)(out + off + bj * HALF + 4 * n) = acc[ai][bj][m][n] * r * gv[bj][n]; }
    }
};
struct EpiDown {
    static constexpr int PROBE_ID = 44;
    static constexpr bool PERM = false, AFTER_DRAIN = false;
    const u16* x2h; float* x3; float* part;
    __device__ __forceinline__ void operator()(const f32x4 (&acc)[2][2][4][2], const Unit& u, int wr, int wc, int fr, int fq) const {
        const int row0 = u.pm * BM + wr * 64 + fr, col0 = u.pn * BM + wc * 32 + 4 * fq;
#pragma unroll
        for (int ai = 0; ai < 2; ++ai)
#pragma unroll
            for (int m = 0; m < 4; ++m) { const int row = row0 + ai * HALF + m * 16; const size_t off = (size_t)row * DM + col0; float ss = 0.f;
#pragma unroll
                for (int bj = 0; bj < 2; ++bj)
#pragma unroll
                    for (int n = 0; n < 2; ++n) { const size_t o = off + bj * HALF + n * 16; const v2u hh = *(const v2u*)(x2h + o);
                        const f32x4 r2 = {h2f((u16)(hh.x & 0xffffu)), h2f((u16)(hh.x >> 16)), h2f((u16)(hh.y & 0xffffu)), h2f((u16)(hh.y >> 16))}; const f32x4 v = r2 + acc[ai][bj][m][n];
                        *(f32x4*)(x3 + o) = v; ss += (v[0] * v[0] + v[1] * v[1]) + (v[2] * v[2] + v[3] * v[3]); }
                ss += __shfl_xor(ss, 16); ss += __shfl_xor(ss, 32);
                if (fq == 0) part[(size_t)row * 16 + u.pn * 4 + wc] = ss; }
    }
};

template <class Epi, class Sched, bool ALIGN_EPI = false, bool SP2 = false>
__device__ __forceinline__ void gemm_phase(PG8_LAS unsigned char* lds, const Gemm g, const Sched& S, const Epi& E) {
    const int tid = threadIdx.x, wid = __builtin_amdgcn_readfirstlane(tid >> 6), lane = tid & 63, wr = wid >> 2, wc = wid & 3, fr = lane & 15, fq = lane >> 4;
    const int K = g.K, nt = K / BK;
    unsigned voffA[2], voffB[2];
#pragma unroll
    for (int i = 0; i < 2; ++i) { int R, C; stage_rc(tid * 16 + i * 8192, R, C); const int Rb = Epi::PERM ? ((R & ~31) + perm32(R & 31)) : R;
        voffA[i] = (unsigned)(R * K + C) * 2u; voffB[i] = (unsigned)(Rb * K + C) * 2u; }
    const size_t kstep = (size_t)(BK * 2);
    const size_t hstep = (size_t)HALF * K * 2;
    const size_t tstep = 2 * hstep;
    const unsigned ldsw = (unsigned)wid * 1024u;
    const int aoff = lds_byte(wr * 64 + fr, fq * 8), boff = lds_byte(wc * 32 + fr, fq * 8);
#define PG8_SA(b, h) (((b) * 2 + (h)) * HTB)
#define PG8_SB(b, h) ((4 + (b) * 2 + (h)) * HTB)
#define PG8_STAGE(bufoff, gbase, voff) do { _Pragma("unroll") for (int _i = 0; _i < 2; ++_i) \
        __builtin_amdgcn_global_load_lds((const unsigned*)((const char*)(gbase) + (voff)[_i]), (PG8_LAS unsigned*)(lds + (bufoff) + ldsw + _i * 8192), 16, 0, 0); } while (0)
#define PG8_LDA(dst, b, h) do { _Pragma("unroll") for (int m = 0; m < 4; ++m) _Pragma("unroll") for (int k = 0; k < 2; ++k) dst[m][k] = *(const PG8_LAS f16x8*)(lds + PG8_SA(b, h) + aoff + m * 2048 + k * 1024); } while (0)
#define PG8_LDB(dst, b, h) do { _Pragma("unroll") for (int n = 0; n < 2; ++n) _Pragma("unroll") for (int k = 0; k < 2; ++k) dst[n][k] = *(const PG8_LAS f16x8*)(lds + PG8_SB(b, h) + boff + n * 2048 + k * 1024); } while (0)
#define PG8_MMA(ai, bj, At, Bt) do { __builtin_amdgcn_s_setprio(1); _Pragma("unroll") for (int m = 0; m < 4; ++m) _Pragma("unroll") for (int n = 0; n < 2; ++n) _Pragma("unroll") for (int k = 0; k < 2; ++k) \
        acc[ai][bj][m][n] = __builtin_amdgcn_mfma_f32_16x16x32_f16(Bt[n][k], At[m][k], acc[ai][bj][m][n], 0, 0, 0); __builtin_amdgcn_s_setprio(0); } while (0)
#define PG8_WAIT_V(n) asm volatile("s_waitcnt vmcnt(" #n ")" ::: "memory")
#define PG8_WAIT_L(n) asm volatile("s_waitcnt lgkmcnt(" #n ")" ::: "memory")
#define PG8_BAR __builtin_amdgcn_s_barrier()
#define PG8_SCHED __builtin_amdgcn_sched_barrier(0)
    Unit cur, nxt; int ui = 0;
    if (!S.next(0, cur)) return;
    f32x4 acc[2][2][4][2];
#pragma unroll
    for (int a = 0; a < 2; ++a)
#pragma unroll
        for (int b = 0; b < 2; ++b)
#pragma unroll
            for (int m = 0; m < 4; ++m)
#pragma unroll
                for (int n = 0; n < 2; ++n) acc[a][b][m][n] = (f32x4){0.f, 0.f, 0.f, 0.f};
    f16x8 At[4][2], B0[2][2], B1[2][2];
    const char* cA = (const char*)g.A + (size_t)cur.pm * tstep; const char* cB = (const char*)g.Bt + (size_t)cur.pn * tstep;
    S.a_ready(cur);
    if constexpr (SP2) {
        PG8_STAGE(PG8_SB(0, 0), cB, voffB); PG8_STAGE(PG8_SB(0, 1), cB + hstep, voffB); PG8_STAGE(PG8_SA(0, 0), cA, voffA); PG8_STAGE(PG8_SA(0, 1), cA + hstep, voffA);
        if (wr == 1) PG8_BAR;
        PG8_WAIT_V(2); PG8_BAR;
        PG8_STAGE(PG8_SB(1, 0), cB + kstep, voffB); PG8_STAGE(PG8_SA(1, 0), cA + kstep, voffA); PG8_STAGE(PG8_SB(1, 1), cB + hstep + kstep, voffB);
        PG8_WAIT_V(6); PG8_BAR;
    } else {
        PG8_STAGE(PG8_SB(0, 0), cB, voffB); PG8_STAGE(PG8_SA(0, 0), cA, voffA); PG8_STAGE(PG8_SB(0, 1), cB + hstep, voffB); PG8_STAGE(PG8_SA(0, 1), cA + hstep, voffA);
        if (wr == 1) PG8_BAR;
        PG8_WAIT_V(4); PG8_BAR;
        PG8_STAGE(PG8_SB(1, 0), cB + kstep, voffB); PG8_STAGE(PG8_SA(1, 0), cA + kstep, voffA); PG8_STAGE(PG8_SB(1, 1), cB + hstep + kstep, voffB);
        PG8_WAIT_V(6); PG8_BAR;
    }
    for (;;) {
        const bool has_next = S.next(ui + 1, nxt);
        const char* nA = has_next ? (const char*)g.A + (size_t)nxt.pm * tstep : cA; const char* nB = has_next ? (const char*)g.Bt + (size_t)nxt.pn * tstep : cB;
        for (int t = 0; t < nt; t += 2) {
            const bool last = (t == nt - 2);
            const char* a1 = cA + (size_t)(t + 1) * kstep;
            const char* a2 = last ? nA : cA + (size_t)(t + 2) * kstep; const char* b2 = last ? nB : cB + (size_t)(t + 2) * kstep;
            const char* a3 = a2 + kstep; const char* b3 = b2 + kstep;
            if (last && has_next) S.a_ready(nxt);
            if constexpr (SP2) {
            PG8_LDB(B0, 0, 0); PG8_LDB(B1, 0, 1); PG8_SCHED; PG8_LDA(At, 0, 0); PG8_STAGE(PG8_SA(1, 1), a1 + hstep, voffA);
            PG8_WAIT_V(8); PG8_WAIT_L(0); PG8_BAR; PG8_MMA(0, 0, At, B0); PG8_MMA(0, 1, At, B1); PG8_BAR; PG8_SCHED;
            PG8_LDA(At, 0, 1); PG8_STAGE(PG8_SB(0, 0), b2, voffB); PG8_STAGE(PG8_SB(0, 1), b2 + hstep, voffB); PG8_STAGE(PG8_SA(0, 0), a2, voffA);
            PG8_WAIT_V(8); PG8_WAIT_L(0); PG8_BAR; PG8_MMA(1, 0, At, B0); PG8_MMA(1, 1, At, B1); PG8_BAR; PG8_SCHED;
            PG8_LDB(B0, 1, 0); PG8_LDB(B1, 1, 1); PG8_SCHED; PG8_LDA(At, 1, 0); PG8_STAGE(PG8_SA(0, 1), a2 + hstep, voffA);
            PG8_WAIT_V(8); PG8_WAIT_L(0); PG8_BAR; PG8_MMA(0, 0, At, B0); PG8_MMA(0, 1, At, B1); PG8_BAR; PG8_SCHED;
            PG8_LDA(At, 1, 1); PG8_STAGE(PG8_SB(1, 0), b3, voffB); PG8_STAGE(PG8_SB(1, 1), b3 + hstep, voffB); PG8_STAGE(PG8_SA(1, 0), a3, voffA);
            PG8_WAIT_V(8); PG8_WAIT_L(0); PG8_BAR; PG8_MMA(1, 0, At, B0); PG8_MMA(1, 1, At, B1); PG8_BAR; PG8_SCHED;
            } else {
            PG8_LDB(B0, 0, 0); PG8_SCHED; PG8_LDA(At, 0, 0); PG8_STAGE(PG8_SA(1, 1), a1 + hstep, voffA);
            PG8_WAIT_L(8); PG8_BAR; PG8_WAIT_L(0); PG8_MMA(0, 0, At, B0); PG8_BAR; PG8_SCHED;
            PG8_LDB(B1, 0, 1); PG8_STAGE(PG8_SB(0, 0), b2, voffB);
            PG8_BAR; PG8_WAIT_L(0); PG8_MMA(0, 1, At, B1); PG8_BAR;
            PG8_LDA(At, 0, 1); PG8_STAGE(PG8_SA(0, 0), a2, voffA);
            PG8_BAR; PG8_WAIT_L(0); PG8_MMA(1, 0, At, B0); PG8_BAR; PG8_SCHED;
            PG8_STAGE(PG8_SB(0, 1), b2 + hstep, voffB);
            PG8_WAIT_V(6); PG8_BAR; PG8_MMA(1, 1, At, B1); PG8_BAR;
            PG8_LDB(B0, 1, 0); PG8_SCHED; PG8_LDA(At, 1, 0); PG8_STAGE(PG8_SA(0, 1), a2 + hstep, voffA);
            PG8_WAIT_L(8); PG8_BAR; PG8_WAIT_L(0); PG8_MMA(0, 0, At, B0); PG8_BAR; PG8_SCHED;
            PG8_LDB(B1, 1, 1); PG8_STAGE(PG8_SB(1, 0), b3, voffB);
            PG8_BAR; PG8_WAIT_L(0); PG8_MMA(0, 1, At, B1); PG8_BAR;
            PG8_LDA(At, 1, 1); PG8_STAGE(PG8_SA(1, 0), a3, voffA);
            PG8_BAR; PG8_WAIT_L(0); PG8_MMA(1, 0, At, B0); PG8_BAR; PG8_SCHED;
            PG8_STAGE(PG8_SB(1, 1), b3 + hstep, voffB);
            PG8_WAIT_V(6); PG8_BAR; PG8_MMA(1, 1, At, B1); PG8_BAR;
            }
        }
        if constexpr (ALIGN_EPI) { if (wr == 0) PG8_BAR; }
#ifdef PROBE_PHASE
        const unsigned long long pe0_ = (Epi::PROBE_ID == PROBE_PHASE) ? __builtin_amdgcn_s_memrealtime() : 0ull;
#endif
        if constexpr (!Epi::AFTER_DRAIN) { E(acc, cur, wr, wc, fr, fq); S.done(cur); }
#ifdef PROBE_PHASE
        if (Epi::PROBE_ID == PROBE_PHASE) { const unsigned long long t1_ = __builtin_amdgcn_s_memrealtime(), dt_ = t1_ - pe0_; while (__builtin_amdgcn_s_memrealtime() - t1_ < (unsigned long long)(PROBE_MULT) * dt_) __builtin_amdgcn_s_sleep(8); }
#endif
        if (!has_next) break;
#pragma unroll
        for (int a = 0; a < 2; ++a)
#pragma unroll
            for (int b = 0; b < 2; ++b)
#pragma unroll
                for (int m = 0; m < 4; ++m)
#pragma unroll
                    for (int n = 0; n < 2; ++n) acc[a][b][m][n] = (f32x4){0.f, 0.f, 0.f, 0.f};
        cur = nxt; cA = nA; cB = nB; ++ui;
        if constexpr (ALIGN_EPI) { if (wr == 1) PG8_BAR; }
    }
    PG8_WAIT_V(0);
    if constexpr (!ALIGN_EPI) { if (wr == 0) PG8_BAR; }
    PG8_BAR;
    if constexpr (Epi::AFTER_DRAIN) { E.fused(acc, cur, wr, wc, fr, fq, lds, wid, lane); S.done(cur); }
#undef PG8_SA
#undef PG8_SB
#undef PG8_STAGE
#undef PG8_LDA
#undef PG8_LDB
#undef PG8_MMA
#undef PG8_WAIT_V
#undef PG8_WAIT_L
#undef PG8_BAR
#undef PG8_SCHED
}

}

namespace attn_body {
using bf16=__hip_bfloat16;
using bf16x8=__attribute__((ext_vector_type(8)))short;
using s16x4=__attribute__((ext_vector_type(4)))short;
using f32x16=__attribute__((ext_vector_type(16)))float;
using u32x4=__attribute__((ext_vector_type(4)))unsigned;
constexpr int BATCH=4,NHEAD=8,SEQ=8192,D=64,DM=NHEAD*D,OPITCH=1024;
constexpr int NW=8,QBLK=32,QB=QBLK*NW,KVBLK=64,NQB=SEQ/QB;
constexpr int ATTN_PITCH=DM, ATTN_UNIT_ROWS=QB;
__device__ __forceinline__ int crow(int r,int hi){return (r&3)+8*(r>>2)+4*hi;}
#define SBAR() __builtin_amdgcn_sched_barrier(0)
__device__ __forceinline__ float bsel(float x,unsigned m){ return __builtin_bit_cast(float,__builtin_amdgcn_bitop3_b32(__builtin_bit_cast(unsigned,x),0xFF800000u,m,0xE4)); }
__device__ __forceinline__ void bmask(f32x16&p0,f32x16&p1,unsigned mw){
  #pragma unroll
  for(int r=0;r<16;++r){
    const unsigned m0=(unsigned)__builtin_amdgcn_sbfe((int)mw,r,1), m1=(unsigned)__builtin_amdgcn_sbfe((int)mw,16+r,1);
    const float x0=p0[r], x1=p1[r]; p0[r]=bsel(x0,m0); p1[r]=bsel(x1,m1); }
}
__device__ __forceinline__ void addbias(f32x16&p0,f32x16&p1,const float*btab,int dbase){
  #pragma unroll
  for(int r=0;r<16;++r){ int d0=dbase-((r&3)+8*(r>>2)); int d1=d0-32; d0=d0<0?0:(d0>127?127:d0); d1=d1<0?0:(d1>127?127:d1); p0[r]+=btab[d0]; p1[r]+=btab[d1]; }
}

constexpr int NSLOT=3, SLOTB=8192;
constexpr int LDS_K=0, LDS_V=NSLOT*SLOTB, LDS_WS=2*NSLOT*SLOTB, LDS_OST=LDS_WS+NW*64*4, LDS_BIAS=LDS_OST+NW*4096, LDS_MASK=LDS_BIAS+512, LDS_BYTES=LDS_MASK+NW*512;
constexpr float C2=0.125f*1.4426950408889634f;
__device__ __forceinline__ void glds16(const void*gsrc,unsigned lds_dst){unsigned keep;
  asm volatile("s_mov_b32 %0, m0\n\ts_mov_b32 m0, %2\n\ts_nop 0\n\tglobal_load_lds_dwordx4 %1, off\n\ts_mov_b32 m0, %0":"=&s"(keep):"v"(gsrc),"s"(lds_dst):"memory");}
__device__ __forceinline__ void glds4(const void*gsrc,unsigned lds_dst){unsigned keep;
  asm volatile("s_mov_b32 %0, m0\n\ts_mov_b32 m0, %2\n\ts_nop 0\n\tglobal_load_lds_dword %1, off\n\ts_mov_b32 m0, %0":"=&s"(keep):"v"(gsrc),"s"(lds_dst):"memory");}
__device__ __forceinline__ void glds4s(const void*sbase,unsigned voff,unsigned lds_dst){unsigned keep;
  asm volatile("s_mov_b32 %0, m0\n\ts_mov_b32 m0, %3\n\ts_nop 0\n\tglobal_load_lds_dword %1, %2\n\ts_mov_b32 m0, %0":"=&s"(keep):"v"(voff),"s"(sbase),"s"(lds_dst):"memory");}
__device__ __forceinline__ float max3f(float a,float b,float c){float r;asm("v_max3_f32 %0, %1, %2, %3":"=v"(r):"v"(a),"v"(b),"v"(c));return r;}
__device__ __forceinline__ float max2f(float a,float b){float r;asm("v_max_f32_e32 %0, %1, %2":"=v"(r):"v"(a),"v"(b));return r;}
__device__ __forceinline__ float fadd_s(float a,float b){float r;asm("v_add_f32_e32 %0, %1, %2":"=v"(r):"v"(a),"v"(b));return r;}
__device__ __forceinline__ float fsub_s(float a,float b){float r;asm("v_sub_f32_e32 %0, %1, %2":"=v"(r):"v"(a),"v"(b));return r;}
typedef float f32x2_t __attribute__((ext_vector_type(2))); typedef __bf16 bf16x2_t __attribute__((ext_vector_type(2)));
__device__ __forceinline__ unsigned cvtpk_s(float lo,float hi){f32x2_t v={lo,hi};bf16x2_t b=__builtin_convertvector(v,bf16x2_t);return __builtin_bit_cast(unsigned,b);}
#define WAIT_BAR(N) asm volatile("s_waitcnt vmcnt(" #N ") lgkmcnt(0)\n\ts_barrier":::"memory")

__device__ __forceinline__ void qkt(f32x16&p0,f32x16&p1,const char*Kslot,const bf16x8*qr,const f32x16&negm,int r32,int hi){
  const char*kb=Kslot+hi*1024+r32*16;
  #pragma unroll
  for(int d0=0;d0<4;++d0){
    const bf16x8 b0=*reinterpret_cast<const bf16x8*>(kb+d0*2048);
    const bf16x8 b1=*reinterpret_cast<const bf16x8*>(kb+d0*2048+512);
    if(d0==0){p0=__builtin_amdgcn_mfma_f32_32x32x16_bf16(b0,qr[0],negm,0,0,0);p1=__builtin_amdgcn_mfma_f32_32x32x16_bf16(b1,qr[0],negm,0,0,0);}
    else{p0=__builtin_amdgcn_mfma_f32_32x32x16_bf16(b0,qr[d0],p0,0,0,0);p1=__builtin_amdgcn_mfma_f32_32x32x16_bf16(b1,qr[d0],p1,0,0,0);}}
}
typedef __attribute__((address_space(3))) const char* lds_cptr;
typedef short v4i16_t __attribute__((ext_vector_type(4)));
__device__ __forceinline__ void kload8(bf16x8*kf,lds_cptr kp){
  kf[0]=*(const __attribute__((address_space(3))) bf16x8*)(kp);      kf[1]=*(const __attribute__((address_space(3))) bf16x8*)(kp+512);
  kf[2]=*(const __attribute__((address_space(3))) bf16x8*)(kp+2048); kf[3]=*(const __attribute__((address_space(3))) bf16x8*)(kp+2560);
  kf[4]=*(const __attribute__((address_space(3))) bf16x8*)(kp+4096); kf[5]=*(const __attribute__((address_space(3))) bf16x8*)(kp+4608);
  kf[6]=*(const __attribute__((address_space(3))) bf16x8*)(kp+6144); kf[7]=*(const __attribute__((address_space(3))) bf16x8*)(kp+6656);
}
__device__ __forceinline__ void kload2(bf16x8*kf,lds_cptr kp,int j){ kf[2*j]=*(const __attribute__((address_space(3))) bf16x8*)(kp+j*2048); kf[2*j+1]=*(const __attribute__((address_space(3))) bf16x8*)(kp+j*2048+512); }
__device__ __forceinline__ s16x4 vtr(lds_cptr p){ return __builtin_bit_cast(s16x4,__builtin_amdgcn_ds_read_tr16_b64_v4i16((__attribute__((address_space(3))) v4i16_t*)p)); }
__device__ __forceinline__ float rowmax(const f32x16&p0,const f32x16&p1){
  float a=max3f(p0[0],p0[1],p1[0]),b=max3f(p0[2],p0[3],p1[1]);a=max3f(a,p1[2],p1[3]);
  #pragma unroll
  for(int r=4;r<16;r+=4){a=max3f(a,p0[r],p0[r+1]);b=max3f(b,p0[r+2],p0[r+3]);a=max3f(a,p1[r],p1[r+1]);b=max3f(b,p1[r+2],p1[r+3]);}
  const float m=max2f(a,b);
  auto rr=__builtin_amdgcn_permlane32_swap(__float_as_uint(m),__float_as_uint(m),false,false);
  return max2f(__uint_as_float(rr[0]),__uint_as_float(rr[1]));
}
__device__ __forceinline__ void pv(f32x16*o,int vb,bf16x8 pa0,bf16x8 pa1,bf16x8 pa2,bf16x8 pa3){
  #pragma unroll
  for(int d0=0;d0<2;++d0){s16x4 lo[4],hi[4];
    #pragma unroll
    for(int ks=0;ks<4;++ks){
      asm volatile("ds_read_b64_tr_b16 %0,%1 offset:%c2":"=&v"(lo[ks]):"v"(vb),"i"(d0*4096+ks*1024):"memory");
      asm volatile("ds_read_b64_tr_b16 %0,%1 offset:%c2":"=&v"(hi[ks]):"v"(vb),"i"(d0*4096+ks*1024+512):"memory");}
    asm volatile("s_waitcnt lgkmcnt(0)":::"memory");SBAR();
    #define PK(k) (bf16x8){lo[k][0],lo[k][1],lo[k][2],lo[k][3],hi[k][0],hi[k][1],hi[k][2],hi[k][3]}
    o[d0]=__builtin_amdgcn_mfma_f32_32x32x16_bf16(pa0,PK(0),o[d0],0,0,0);
    o[d0]=__builtin_amdgcn_mfma_f32_32x32x16_bf16(pa1,PK(1),o[d0],0,0,0);
    o[d0]=__builtin_amdgcn_mfma_f32_32x32x16_bf16(pa2,PK(2),o[d0],0,0,0);
    o[d0]=__builtin_amdgcn_mfma_f32_32x32x16_bf16(pa3,PK(3),o[d0],0,0,0);
    #undef PK
  }
}

#ifndef ATTN_STORE16
#define ATTN_STORE16(p,v) (*(u32x4*)(p)=(v))
#endif
template<int THRL> __device__ __forceinline__ void attn_unit(int b,int h,int qb,const bf16*Q,const bf16*__restrict__ K,const bf16*__restrict__ V,unsigned short*O,const unsigned*__restrict__ BMK,const float*__restrict__ BIASG,char*shm){
  const int tid=threadIdx.x,lane=tid&63,r32=lane&31,hi=lane>>5; const int wid=__builtin_amdgcn_readfirstlane(tid>>6);
  const long rowbase=(long)b*SEQ; const int q0=qb*QB;
  const bf16*Qw=Q+(rowbase+q0+wid*QBLK)*DM+h*D;
  const bf16*Kh=K+rowbase*DM+h*D,*Vh=V+rowbase*DM+h*D;
  const unsigned lds0=(unsigned)(uintptr_t)shm;
  float*wsf=(float*)(shm+LDS_WS)+wid*64;
  float*btab=(float*)(shm+LDS_BIAS);
  if(tid<128)btab[tid]=BIASG[h*128+tid];
  const unsigned*bmw=BMK+((size_t)(b*256+qb*8+wid)*128)*64;
  unsigned mwc;
  const unsigned mdst=lds0+LDS_MASK+wid*512;
  #define MDMA(tt) glds4s(bmw+(size_t)(tt)*64,(unsigned)lane*4u,(unsigned)__builtin_amdgcn_readfirstlane(mdst+(((tt)&1)<<8)))
  #define MREAD(tt) (*(const __attribute__((address_space(3))) unsigned*)((lds_cptr)shm+LDS_MASK+wid*512+(((tt)&1)<<8)+lane*4))
  MDMA(0); MDMA(1);
  const bf16*ksrc=Kh+(long)lane*DM+wid*8;
  const bf16*vsrc=Vh+(long)(16*(wid&3)+(lane>>2))*DM+(wid>>2)*32+(lane&3)*8;
  const unsigned kdst=lds0+LDS_K+wid*1024, vdst=lds0+LDS_V+wid*1024;
  #define DMA_K(t,slot) glds16(ksrc+(long)(t)*KVBLK*DM,(unsigned)__builtin_amdgcn_readfirstlane(kdst+(slot)))
  #define DMA_V(t,slot) glds16(vsrc+(long)(t)*KVBLK*DM,(unsigned)__builtin_amdgcn_readfirstlane(vdst+(slot)))
  const int vb0=(int)(lds0+LDS_V)+((lane>>4)&1)*32+(lane&3)*8+(4*hi+((lane&15)>>2))*64;
  const char*Kbase=shm+LDS_K; bf16x8 kf[8];
  const lds_cptr shm3=(lds_cptr)shm; const lds_cptr kp0=shm3+LDS_K+hi*1024+r32*16; const lds_cptr vp0=shm3+LDS_V+((lane>>4)&1)*32+(lane&3)*8+(4*hi+((lane&15)>>2))*64;
  const int NT=(q0+QB)/KVBLK;
  DMA_K(0,0);DMA_V(0,0);DMA_K(1,SLOTB);
  bf16x8 qr[4];
  #pragma unroll
  for(int d0=0;d0<4;++d0)qr[d0]=*reinterpret_cast<const bf16x8*>(&Qw[(long)r32*DM+d0*16+hi*8]);
  float mhat=0.f,l_reg=0.f;f32x16 o[2];o[0]=f32x16{};o[1]=f32x16{};f32x16 negm=f32x16{};asm volatile("":"+v"(negm));
  const int qrel=wid*QBLK+r32;
  #define CMASK(P0,P1,t) do{ bmask(P0,P1,mwc); if((t)>=NT-7)addbias(P0,P1,btab,q0+qrel-64*(t)-4*hi); }while(0)
  bool resc=false;
  #define START(P0,P1) do{ const float rm=rowmax(P0,P1); resc=false; \
    { const float dl=(rm==-INFINITY)?0.f:rm; mhat=fadd_s(mhat,dl); \
      _Pragma("unroll") for(int r=0;r<16;++r){P0[r]=fsub_s(P0[r],dl);P1[r]=fsub_s(P1[r],dl);} \
      _Pragma("unroll") for(int r=0;r<16;++r)negm[r]=-mhat; asm volatile("":"+v"(negm)); } \
    _Pragma("unroll") for(int r=0;r<16;++r)P0[r]=__builtin_amdgcn_exp2f(P0[r]); }while(0)
  #define RESC() do{ if(resc){ asm volatile("s_waitcnt lgkmcnt(0)":::"memory"); \
      _Pragma("unroll") for(int d_=0;d_<2;++d_) _Pragma("unroll") for(int r=0;r<16;++r)o[d_][r]*=wsf[crow(r,hi)]; } }while(0)
  f32x16 pA0,pA1,pB0,pB1;
  int sl_prev=0,sl_cur=0,sl_next=SLOTB;
  #define ROT() do{sl_prev=sl_cur;sl_cur=sl_next;sl_next=(sl_next==(NSLOT-1)*SLOTB)?0:sl_next+SLOTB;}while(0)
  DMA_K(2,2*SLOTB);
  WAIT_BAR(3);
  mwc=MREAD(0);
  qkt(pA0,pA1,Kbase,qr,negm,r32,hi);asm volatile("s_nop 15\n\ts_nop 7":"+v"(pA0),"+v"(pA1));CMASK(pA0,pA1,0);
  START(pA0,pA1);
  _Pragma("unroll") for(int r=0;r<16;++r)pA1[r]=__builtin_amdgcn_exp2f(pA1[r]);
  WAIT_BAR(0);
  DMA_K(3,0);DMA_V(1,SLOTB);
  ROT();
  kload8(kf,kp0+sl_cur);
  WAIT_BAR(2);
  s16x4 vlo[8],vhi[8]; u32x4 pw0,pw1,pw2,pw3;
  #define PKW(P,B) cvtpk_s(P[B],P[B+1])
  #define PAF(k) __builtin_bit_cast(bf16x8,pw##k)
  #define VFR(i) (bf16x8){vlo[i][0],vlo[i][1],vlo[i][2],vlo[i][3],vhi[i][0],vhi[i][1],vhi[i][2],vhi[i][3]}
  #define PIN(x) asm volatile("":"+v"(x))
  #define MX3(a,b,c) __builtin_fmaxf(__builtin_fmaxf((a),(b)),(c))
  #define GAPA(MF,A0,A1,A2,A3,W0,W1,PW) do{ MF; sacc+=A0; sacc+=A1; sacc+=A2; sacc+=A3; PIN(sacc); W0; W1; PIN(PW); SBAR(); }while(0)
  #define EX(v) __builtin_amdgcn_exp2f(v)
  #define GAPB(MF,X,B) do{ MF; X[B]=EX(X[B]); X[B+1]=EX(X[B+1]); X[B+2]=EX(X[B+2]); X[B+3]=EX(X[B+3]); PIN(X); SBAR(); }while(0)
  #define VRD(i) do{ vlo[i]=vtr(vp_+(((i)>>2)*4096+((i)&3)*1024)); vhi[i]=vtr(vp_+(((i)>>2)*4096+((i)&3)*1024+512)); }while(0)
  #define KRD(G,j) do{ if(G){ kload2(kf,kp0+sl_next,j); SBAR(); } }while(0)
  #define STEP(C0,C1,P0,P1,t,GK,GV,GL) do{ SBAR(); mwc=MREAD(t); \
    const lds_cptr vp_=vp0+sl_prev; \
    VRD(0); SBAR(); float sacc=(P0[0]+P0[1]); \
    GAPA(C0=__builtin_amdgcn_mfma_f32_32x32x16_bf16(kf[0],qr[0],negm,0,0,0), P0[2],P0[3],P0[4],P0[5],     pw0[0]=PKW(P0,0), pw0[1]=PKW(P0,2), pw0); \
    VRD(4); SBAR(); GAPA(C1=__builtin_amdgcn_mfma_f32_32x32x16_bf16(kf[1],qr[0],negm,0,0,0), P0[6],P0[7],P0[8],P0[9],     pw0[2]=PKW(P0,4), pw0[3]=PKW(P0,6), pw0); \
    VRD(1); SBAR(); GAPA(C0=__builtin_amdgcn_mfma_f32_32x32x16_bf16(kf[2],qr[1],C0,0,0,0),   P0[10],P0[11],P0[12],P0[13], pw1[0]=PKW(P0,8), pw1[1]=PKW(P0,10), pw1); \
    VRD(5); SBAR(); GAPA(C1=__builtin_amdgcn_mfma_f32_32x32x16_bf16(kf[3],qr[1],C1,0,0,0),   P0[14],P0[15],P1[0],P1[1],   pw1[2]=PKW(P0,12),pw1[3]=PKW(P0,14), pw1); \
    VRD(2); SBAR(); GAPA(C0=__builtin_amdgcn_mfma_f32_32x32x16_bf16(kf[4],qr[2],C0,0,0,0),   P1[2],P1[3],P1[4],P1[5],     pw2[0]=PKW(P1,0), pw2[1]=PKW(P1,2), pw2); \
    VRD(6); SBAR(); GAPA(C1=__builtin_amdgcn_mfma_f32_32x32x16_bf16(kf[5],qr[2],C1,0,0,0),   P1[6],P1[7],P1[8],P1[9],     pw2[2]=PKW(P1,4), pw2[3]=PKW(P1,6), pw2); \
    VRD(3); SBAR(); GAPA(C0=__builtin_amdgcn_mfma_f32_32x32x16_bf16(kf[6],qr[3],C0,0,0,0),   P1[10],P1[11],P1[12],P1[13], pw3[0]=PKW(P1,8), pw3[1]=PKW(P1,10), pw3); \
    VRD(7); SBAR(); GAPA(C1=__builtin_amdgcn_mfma_f32_32x32x16_bf16(kf[7],qr[3],C1,0,0,0),   P1[14],P1[15],0.f,0.f,       pw3[2]=PKW(P1,12),pw3[3]=PKW(P1,14), pw3); \
    l_reg+=sacc; \
    if((t)+1<NT){MDMA((t)+1);} if(GK){DMA_K((t)+3,sl_cur);} if(GV){DMA_V((t)+1,sl_next);} \
    CMASK(C0,C1,t); \
    { float a=MX3(C0[0],C0[1],C1[0]),b=MX3(C0[2],C0[3],C1[1]); a=MX3(a,C1[2],C1[3]); \
      _Pragma("unroll") for(int r=4;r<16;r+=4){a=MX3(a,C0[r],C0[r+1]);b=MX3(b,C0[r+2],C0[r+3]);a=MX3(a,C1[r],C1[r+1]);b=MX3(b,C1[r+2],C1[r+3]);} \
      float rm=__builtin_fmaxf(a,b); { auto rr=__builtin_amdgcn_permlane32_swap(__float_as_uint(rm),__float_as_uint(rm),false,false); rm=__builtin_fmaxf(__uint_as_float(rr[0]),__uint_as_float(rr[1])); } \
      resc=false; \
      if(__builtin_expect(__any(rm>(float)THRL),0)){ const float dl=__builtin_fmaxf(rm,0.f); mhat+=dl; \
        _Pragma("unroll") for(int r=0;r<16;++r){C0[r]-=dl;C1[r]-=dl;} \
        _Pragma("unroll") for(int r=0;r<16;++r)negm[r]=-mhat; asm volatile("":"+v"(negm)); \
        const float f=__builtin_amdgcn_exp2f(-dl); l_reg*=f; if(hi==0)wsf[r32]=f; resc=true; } } \
    SBAR(); \
    GAPB(o[0]=__builtin_amdgcn_mfma_f32_32x32x16_bf16(PAF(0),VFR(0),o[0],0,0,0), C0,0); \
    GAPB(o[1]=__builtin_amdgcn_mfma_f32_32x32x16_bf16(PAF(0),VFR(4),o[1],0,0,0), C0,4); \
    KRD(GL,0); GAPB(o[0]=__builtin_amdgcn_mfma_f32_32x32x16_bf16(PAF(1),VFR(1),o[0],0,0,0), C0,8); \
    KRD(GL,1); GAPB(o[1]=__builtin_amdgcn_mfma_f32_32x32x16_bf16(PAF(1),VFR(5),o[1],0,0,0), C0,12); \
    KRD(GL,2); GAPB(o[0]=__builtin_amdgcn_mfma_f32_32x32x16_bf16(PAF(2),VFR(2),o[0],0,0,0), C1,0); \
    KRD(GL,3); GAPB(o[1]=__builtin_amdgcn_mfma_f32_32x32x16_bf16(PAF(2),VFR(6),o[1],0,0,0), C1,4); \
    GAPB(o[0]=__builtin_amdgcn_mfma_f32_32x32x16_bf16(PAF(3),VFR(3),o[0],0,0,0), C1,8); \
    GAPB(o[1]=__builtin_amdgcn_mfma_f32_32x32x16_bf16(PAF(3),VFR(7),o[1],0,0,0), C1,12); \
    }while(0)
  int t=1;
  #undef CMASK
  #define CMASK(P0,P1,t) do{ bmask(P0,P1,mwc); }while(0)
  for(;t+7<NT;t+=2){
    STEP(pB0,pB1,pA0,pA1,t,true,true,true);     WAIT_BAR(2); RESC(); ROT();
    STEP(pA0,pA1,pB0,pB1,t+1,true,true,true);   WAIT_BAR(2); RESC(); ROT();
  }
  #undef CMASK
  #define CMASK(P0,P1,t) do{ bmask(P0,P1,mwc); addbias(P0,P1,btab,q0+qrel-64*(t)-4*hi); }while(0)
  #define ENDW(tt) do{ if((tt)+3<NT){WAIT_BAR(2);} else if((tt)+2<NT){WAIT_BAR(1);} else {WAIT_BAR(0);} }while(0)
  for(;t+1<NT;t+=2){
    STEP(pB0,pB1,pA0,pA1,t,(t+3<NT),(t+1<NT),(t+1<NT));       ENDW(t);   RESC(); ROT();
    STEP(pA0,pA1,pB0,pB1,t+1,(t+4<NT),(t+2<NT),(t+2<NT));     ENDW(t+1); RESC(); ROT();
  }
  STEP(pB0,pB1,pA0,pA1,NT-1,false,false,false); RESC();
  { float sacc=pB0[0]+pB0[1]; _Pragma("unroll") for(int r=2;r<16;++r)sacc+=pB0[r]; _Pragma("unroll") for(int r=0;r<16;++r)sacc+=pB1[r]; l_reg+=sacc;
    pw0=(u32x4){PKW(pB0,0),PKW(pB0,2),PKW(pB0,4),PKW(pB0,6)};pw1=(u32x4){PKW(pB0,8),PKW(pB0,10),PKW(pB0,12),PKW(pB0,14)};pw2=(u32x4){PKW(pB1,0),PKW(pB1,2),PKW(pB1,4),PKW(pB1,6)};pw3=(u32x4){PKW(pB1,8),PKW(pB1,10),PKW(pB1,12),PKW(pB1,14)};
    SBAR(); pv(o,vb0+sl_cur,PAF(0),PAF(1),PAF(2),PAF(3)); }
  #undef PKW
  #undef PAF
  #undef VFR
  #undef PIN
  #undef MX3
  #undef GAPA
  #undef GAPB
  #undef EX
  #undef VRD
  #undef KRD
  #undef STEP
  #undef ENDW
  {auto rr=__builtin_amdgcn_permlane32_swap(__float_as_uint(l_reg),__float_as_uint(l_reg),false,false);l_reg=__uint_as_float(rr[0])+__uint_as_float(rr[1]);}
  if(hi==0)wsf[32+r32]=l_reg;asm volatile("s_waitcnt lgkmcnt(0)":::"memory");
  float rli[16];
  #pragma unroll
  for(int r=0;r<16;++r)rli[r]=__builtin_amdgcn_rcpf(wsf[32+crow(r,hi)]);
  unsigned short*Ow=O+(rowbase+q0+wid*QBLK)*OPITCH+h*D;
  { _Float16*stg=(_Float16*)(shm+LDS_OST)+wid*2048;
    #pragma unroll
    for(int r=0;r<16;++r){const int orow=crow(r,hi);
      #pragma unroll
      for(int d0=0;d0<2;++d0)stg[orow*64+d0*32+r32]=(_Float16)(o[d0][r]*rli[r]);}
    asm volatile("s_waitcnt lgkmcnt(0)":::"memory");
    #pragma unroll
    for(int i=0;i<4;++i){const int row=i*8+(lane>>3),ch=lane&7; const u32x4 v=*(const u32x4*)(stg+row*64+ch*8); ATTN_STORE16(Ow+(long)row*OPITCH+ch*8,v);} }
  asm volatile("s_waitcnt lgkmcnt(0)\n\ts_barrier":::"memory");
  #undef DMA_K
  #undef MDMA
  #undef MREAD
  #undef DMA_V
  #undef CMASK
  #undef START
  #undef RESC
  #undef ROT
}
constexpr int ATTN_LDS_BYTES=LDS_BYTES;
struct AttnTensors { const bf16* Q; const bf16* K; const bf16* V; unsigned short* O; const unsigned* BMK; const float* BIASG; };
struct AttnUnit { int bh; int qb; };
struct StaticOrder {
  int vcu;
  __device__ __forceinline__ explicit StaticOrder(int grid,int block):vcu((block%8)*(grid/8)+block/8){}
  __device__ __forceinline__ bool next(int i,AttnUnit&u)const{ if(i>=4)return false; const int s=vcu&7; u.bh=vcu>>3; u.qb=(i==0)?s:(i==1)?15-s:(i==2)?16+s:31-s; return true; }
  __device__ __forceinline__ void a_ready(const AttnUnit&)const{}
  __device__ __forceinline__ void done(const AttnUnit&)const{}
};
struct StridedOrder {
  int G,c;
  __device__ __forceinline__ explicit StridedOrder(int grid,int block):G(grid),c(block){}
  __device__ __forceinline__ bool next(int i,AttnUnit&u)const{ const int L=i*G+c; if(L>=BATCH*NHEAD*NQB)return false; u.bh=L/NQB; u.qb=L%NQB; return true; }
  __device__ __forceinline__ void a_ready(const AttnUnit&)const{}
  __device__ __forceinline__ void done(const AttnUnit&)const{}
};
template<class Sched,int THRL=8> __device__ __forceinline__ void attn_phase(char*lds,const AttnTensors&T,const Sched&S){
  AttnUnit u;
  for(int i=0;S.next(i,u);++i){ S.a_ready(u); attn_unit<THRL>(u.bh/NHEAD,u.bh%NHEAD,u.qb,T.Q,T.K,T.V,T.O,T.BMK,T.BIASG,lds); S.done(u); }
}
#undef SBAR
#undef WAIT_BAR
}

constexpr int NWAVES = 8;
#ifndef MK_N_LAUNCHES
#define MK_N_LAUNCHES 1
#endif
constexpr int N_PHASES = 9;
constexpr int N_LAUNCHES = MK_N_LAUNCHES;

constexpr size_t MiB = 1u << 20;
constexpr size_t WS_CTL = 0, CTL_ZERO_BYTES = 128 * 1024;
constexpr size_t WS_WIN = 2 * MiB, WS_WOUT = 11 * MiB, WS_WGU = 13 * MiB, WS_WD = 24 * MiB;
constexpr size_t WS_CS = 30 * MiB;
constexpr size_t WS_RINV1 = 34 * MiB, WS_PART2 = 35 * MiB, WS_PART3 = 37 * MiB, WS_WI = 39 * MiB;
constexpr size_t WS_BIAS = 34 * MiB + 512 * 1024;
constexpr size_t WS_KIRAW = 40 * MiB, WS_KIH = 48 * MiB;
constexpr size_t WS_XH = 52 * MiB, WS_MIX = 52 * MiB;
constexpr size_t WS_QA = 116 * MiB;
constexpr size_t WS_KA = WS_QA + 32 * MiB, WS_VA = WS_QA + 64 * MiB, WS_QI = WS_QA + 96 * MiB, WS_QB = WS_QA + 128 * MiB, WS_KB = WS_QA + 160 * MiB, WS_VB = WS_QA + 192 * MiB, WS_GB = WS_QA + 224 * MiB;
constexpr size_t WS_DS = 372 * MiB;
constexpr size_t WS_ST = 436 * MiB;
constexpr size_t WS_BM = 468 * MiB;
constexpr size_t WS_X2H = 372 * MiB;
constexpr size_t WS_U = 180 * MiB;
constexpr size_t WS_END = 512 * MiB;
static_assert(WS_BM + 32 * MiB <= WS_END && WS_U + (size_t)MTOK * DFF * 2 <= WS_DS + 64 * MiB, "d_ws map");
constexpr int CW_BAR = 4096;

constexpr int LCTL_BYTES = 4096;
constexpr int RING_OFF = LCTL_BYTES, RING_BYTES = 139264;
constexpr int LDS_BYTES = RING_OFF + RING_BYTES;
static_assert(LDS_BYTES <= 160 * 1024 - 1024, "LDS");

#define XB_TMO      128
#define XB_XCNT(j)  (256  + 64 * (j))
#define XB_XSUB(j)  (1280 + 64 * (j))
#define XB_XGEN(j)  (2304 + 64 * (j))
#define XB_TOP      3328
#define XB_TOPGEN   3392
#define XCD_BAR_WORDS 3456
#define XB_SPIN_CAP (1u << 18)

__device__ __forceinline__ unsigned xb_ld(unsigned* p)              { return __hip_atomic_load(p, __ATOMIC_RELAXED, __HIP_MEMORY_SCOPE_AGENT); }
__device__ __forceinline__ unsigned xb_add(unsigned* p, unsigned v) { return __hip_atomic_fetch_add(p, v, __ATOMIC_RELAXED, __HIP_MEMORY_SCOPE_AGENT); }
__device__ __forceinline__ unsigned xb_xcc_id() { return (unsigned)__builtin_amdgcn_s_getreg((3 << 11) | 20) & 0xFu; }
#define XB_SPIN(cond, bar) do { unsigned _sp = 0; while (cond) { __builtin_amdgcn_s_sleep(1); \
    if ((++_sp & 255u) == 0u) { if (xb_ld(&(bar)[XB_TMO])) break; if (_sp > XB_SPIN_CAP) { atomicAdd(&(bar)[XB_TMO], 1u); break; } } } } while (0)

struct XcdBarrier {
    unsigned* bar; unsigned x;
    volatile LAS unsigned* st;
};

__device__ __forceinline__ XcdBarrier xcd_barrier_post(unsigned* bar, volatile LAS unsigned* st) {
    XcdBarrier b; b.bar = bar; b.x = xb_xcc_id(); b.st = st;
    if (threadIdx.x == 0) (void)xb_add(&bar[XB_XCNT(b.x)], 1u);
    return b;
}
__device__ __forceinline__ void xcd_barrier_complete(unsigned* bar, unsigned x, unsigned& nloc, unsigned& nx) {
    const unsigned G = gridDim.x * gridDim.y * gridDim.z;
    unsigned sum, cnt, mine, sp = 0u;
    for (;;) {
        sum = 0u; cnt = 0u; mine = 0u;
#pragma unroll
        for (unsigned j = 0; j < 16; ++j) { const unsigned c = xb_ld(&bar[XB_XCNT(j)]); sum += c; cnt += (c > 0u) ? 1u : 0u; mine = (j == x) ? c : mine; }
        if (sum == G) break;
        __builtin_amdgcn_s_sleep(1);
        if ((++sp & 255u) == 0u) { if (xb_ld(&bar[XB_TMO])) break; if (sp > XB_SPIN_CAP) { atomicAdd(&bar[XB_TMO], 1u); break; } }
    }
    nloc = mine > 0u ? mine : 1u; nx = cnt > 0u ? cnt : 1u;
}

__device__ __forceinline__ void xcd_barrier(const XcdBarrier& b) {
    asm volatile("s_waitcnt vmcnt(0)" ::: "memory");
    __syncthreads();
    if (threadIdx.x == 0) {
        unsigned* bar = b.bar;
        __builtin_amdgcn_s_waitcnt(0);
        unsigned nloc = b.st[0], nx = b.st[1];
        if (nloc == 0u) { xcd_barrier_complete(bar, b.x, nloc, nx); b.st[0] = nloc; b.st[1] = nx; }
        const unsigned old = xb_add(&bar[XB_XSUB(b.x)], 1u);
        const unsigned gen = old / nloc;
        if (old + 1u == (gen + 1u) * nloc) {
            __builtin_amdgcn_fence(__ATOMIC_RELEASE, "agent");
            asm volatile("s_waitcnt vmcnt(0)" ::: "memory");
            const unsigned og = xb_add(&bar[XB_TOP], 1u);
            const unsigned tg = og / nx;
            if (og + 1u == (tg + 1u) * nx) xb_add(&bar[XB_TOPGEN], 1u);
            else XB_SPIN(xb_ld(&bar[XB_TOPGEN]) == tg, bar);
            __builtin_amdgcn_fence(__ATOMIC_ACQUIRE, "agent");
            xb_add(&bar[XB_XGEN(b.x)], 1u);
            asm volatile("s_waitcnt vmcnt(0)" ::: "memory");
        } else {
            XB_SPIN(xb_ld(&bar[XB_XGEN(b.x)]) == gen, bar);
            __builtin_amdgcn_fence(__ATOMIC_ACQUIRE, "agent");
            asm volatile("s_waitcnt vmcnt(0)" ::: "memory");
        }
    }
    __syncthreads();
}

struct Frame {
    LAS unsigned char* lds;
    unsigned char* ws;
    u16* mix;
    int tid, lane, wave;
    int vcu, G;
};
__device__ __forceinline__ float wave_sum(float v) {
#pragma unroll
    for (int o = 1; o < 64; o <<= 1) v += __shfl_xor(v, o);
    return v;
}

#ifdef PROBE_PHASE
#define SUB_BEGIN(k) const unsigned long long sb0_##k = ((k) == PROBE_PHASE) ? __builtin_amdgcn_s_memrealtime() : 0ull
#define SUB_END(k) do { if ((k) == PROBE_PHASE) { const unsigned long long t1_ = __builtin_amdgcn_s_memrealtime(), dt_ = t1_ - sb0_##k; while (__builtin_amdgcn_s_memrealtime() - t1_ < (unsigned long long)(PROBE_MULT) * dt_) __builtin_amdgcn_s_sleep(8); } } while (0)
#else
#define SUB_BEGIN(k) do {} while (0)
#define SUB_END(k) do {} while (0)
#endif
__device__ __forceinline__ void p0_tr_item(const float* W, int ldw, int scol0, int nvalid, const float* gain, u16* WT, int K, int drow0, int k0, LAS float* scr, int lane) {
    f32x4 v[8];
#pragma unroll
    for (int i = 0; i < 8; ++i) { const int kk = 8 * i + (lane >> 3), n4 = 4 * (lane & 7);
        v[i] = (n4 + 3 < nvalid) ? *(const f32x4*)(W + (size_t)(k0 + kk) * ldw + scol0 + n4) : (f32x4){0.f, 0.f, 0.f, 0.f}; }
#pragma unroll
    for (int i = 0; i < 8; ++i) { const int kk = 8 * i + (lane >> 3), n4 = 4 * (lane & 7); const float gk = gain ? gain[k0 + kk] : 1.0f;
        scr[kk * 33 + n4 + 0] = v[i][0] * gk; scr[kk * 33 + n4 + 1] = v[i][1] * gk; scr[kk * 33 + n4 + 2] = v[i][2] * gk; scr[kk * 33 + n4 + 3] = v[i][3] * gk; }
    LDS_WAIT(); asm volatile("" ::: "memory");
    const int c = lane & 7;
#pragma unroll
    for (int j = 0; j < 4; ++j) { const int n = (lane >> 3) + 8 * j; const LAS float* s = scr + (8 * c) * 33 + n;
        v4u o; o.x = cvt_pk_f16(s[0 * 33], s[1 * 33]); o.y = cvt_pk_f16(s[2 * 33], s[3 * 33]); o.z = cvt_pk_f16(s[4 * 33], s[5 * 33]); o.w = cvt_pk_f16(s[6 * 33], s[7 * 33]);
        *(v4u*)(WT + (size_t)(drow0 + n) * K + k0 + 8 * c) = o; }
    LDS_WAIT(); asm volatile("" ::: "memory");
}
__constant__ unsigned char T5_BUCKET[128] = {0, 1, 2, 3, 4, 5, 6, 7, 8, 9, 10, 11, 12, 13, 14, 15, 16, 16, 16, 17, 17, 18, 18, 18, 19, 19, 19, 20, 20, 20, 20, 21, 21, 21, 21, 22, 22, 22, 22, 22, 23, 23, 23, 23, 23, 23, 24, 24, 24, 24, 24, 24, 25, 25, 25, 25, 25, 25, 25, 26, 26, 26, 26, 26, 26, 26, 26, 27, 27, 27, 27, 27, 27, 27, 27, 27, 27, 28, 28, 28, 28, 28, 28, 28, 28, 28, 28, 29, 29, 29, 29, 29, 29, 29, 29, 29, 29, 29, 29, 30, 30, 30, 30, 30, 30, 30, 30, 30, 30, 30, 30, 30, 30, 31, 31, 31, 31, 31, 31, 31, 31, 31, 31, 31, 31, 31, 31, 31};
struct P0Args { const float *x, *g_mix, *w_in, *rel_bias, *w_out, *g_ffn, *w_gate, *w_up, *w_down; };
template <int PART> __device__ __forceinline__ void p0_prologue(Frame& F, const P0Args& A, int widx, int wg0, int nwg) {
    LAS float* scr = (LAS float*)(F.lds + RING_OFF + F.wave * 16384);
    const int gw = (widx - wg0) * NWAVES + F.wave, NGW = nwg * NWAVES;
    if (widx < wg0 || widx >= wg0 + nwg) return;
    u16* WinT = (u16*)(F.ws + WS_WIN); u16* WoutT = (u16*)(F.ws + WS_WOUT); u16* WguT = (u16*)(F.ws + WS_WGU); u16* WdT = (u16*)(F.ws + WS_WD);
    constexpr int I_IN = 16 * (N_IN / 32), I_OUT = 16 * 32, I_GU = 16 * 176, I_D = 44 * 32, NITEMS = I_IN + I_OUT + I_GU + I_D;
    SUB_BEGIN(20);
    for (int it = (PART == 0 ? gw : I_IN + gw); it < (PART == 0 ? I_IN : NITEMS); it += NGW) {
        int r = it;
        if (r < I_IN) { const int kb = r / (N_IN / 32), nb = r % (N_IN / 32), drow0 = 32 * nb; int scol0, nvalid = 32;
            if (drow0 < 2048) scol0 = drow0; else if (drow0 < 4096) scol0 = 2120 + (drow0 - 2048); else { const int off = drow0 - 4096; scol0 = 2048 + off; nvalid = 72 - off; nvalid = nvalid < 0 ? 0 : (nvalid > 32 ? 32 : nvalid); }
            p0_tr_item(A.w_in, 4168, scol0, nvalid, A.g_mix, WinT, 1024, drow0, 64 * kb, scr, F.lane); continue; }
        r -= I_IN;
        if (r < I_OUT) { const int kb = r / 32, nb = r % 32; p0_tr_item(A.w_out, 1024, 32 * nb, 32, nullptr, WoutT, 1024, 32 * nb, 64 * kb, scr, F.lane); continue; }
        r -= I_OUT;
        if (r < I_GU) { const int kb = r / 176, nb = r % 176, t = nb >> 3, w = nb & 7;
            p0_tr_item(w < 4 ? A.w_gate : A.w_up, DFF, 128 * t + 32 * (w & 3), 32, A.g_ffn, WguT, 1024, 256 * t + 32 * w, 64 * kb, scr, F.lane); continue; }
        r -= I_GU;
        { const int kb = r / 32, nb = r % 32; p0_tr_item(A.w_down, 1024, 32 * nb, 32, nullptr, WdT, DFF, 32 * nb, 64 * kb, scr, F.lane); }
    }
    SUB_END(20);
    SUB_BEGIN(21);
    if (PART == 0) {
    u16* XH = (u16*)(F.ws + WS_XH); float* rinv1 = (float*)(F.ws + WS_RINV1);
    for (int m0 = gw; m0 < MTOK; m0 += 4 * NGW) {
        f32x4 v[4][4]; float ss[4];
#pragma unroll
        for (int r = 0; r < 4; ++r) { const int m = m0 + r * NGW < MTOK ? m0 + r * NGW : m0; const f32x4* xr = (const f32x4*)(A.x + (size_t)m * DM) + F.lane;
#pragma unroll
            for (int j = 0; j < 4; ++j) v[r][j] = xr[64 * j]; }
#pragma unroll
        for (int r = 0; r < 4; ++r) { float s = 0.f;
#pragma unroll
            for (int j = 0; j < 4; ++j) s += (v[r][j][0] * v[r][j][0] + v[r][j][1] * v[r][j][1]) + (v[r][j][2] * v[r][j][2] + v[r][j][3] * v[r][j][3]);
            ss[r] = wave_sum(s); }
#pragma unroll
        for (int r = 0; r < 4; ++r) { const int m = m0 + r * NGW; if (m < MTOK) {
            if (F.lane == 0) rinv1[m] = 1.0f / sqrtf(ss[r] * (1.0f / DM) + EPS);
            v2u* o = (v2u*)(XH + (size_t)m * DM) + F.lane;
#pragma unroll
            for (int j = 0; j < 4; ++j) { v2u h; h.x = cvt_pk_f16(v[r][j][0], v[r][j][1]); h.y = cvt_pk_f16(v[r][j][2], v[r][j][3]); o[64 * j] = h; } } }
    }
    }
    SUB_END(21);
    SUB_BEGIN(22);
    if (PART == 1) {
    f32x2* CS = (f32x2*)(F.ws + WS_CS);
    for (int e = (widx - wg0) * (NWAVES * 64) + F.tid; e < SEQ * 64; e += nwg * NWAVES * 64) {
        const int pos = e >> 6, i = e & 63;
        const float theta = (float)(1.0 / exp2((double)i * (13.287712379549449 / 63.0)));
        const float ang = (float)pos * theta;
        const double rev = (double)ang * 0.15915494309189535; const double fr = rev - rint(rev);
        const double a = fr * 6.283185307179586;
        CS[e] = (f32x2){(float)cos(a), (float)sin(a)};
    }
    }
    SUB_END(22);
    if (PART == 0 && blockIdx.x == 0) { float* BT = (float*)(F.ws + WS_BIAS);
        for (int e = F.tid; e < 8 * 128; e += NWAVES * 64) { const int h = e >> 7, d = e & 127; BT[e] = (A.rel_bias[(int)T5_BUCKET[d] * 8 + h] - A.rel_bias[31 * 8 + h]) * 1.4426950408889634f; } }
}

__device__ __forceinline__ void ki_layernorm(Frame& F, const float* ln_g, const float* ln_b) {
    const float* KIR = (const float*)(F.ws + WS_KIRAW); u16* KIH = (u16*)(F.ws + WS_KIH);
    for (int e = F.vcu * (NWAVES * 64) + F.tid; e < MTOK * 4; e += F.G * NWAVES * 64) {
        const int tok = e >> 2, part = e & 3; const f32x4* src = (const f32x4*)(KIR + (size_t)tok * 64 + part * 16);
        f32x4 v[4]; float s = 0.f;
#pragma unroll
        for (int j = 0; j < 4; ++j) { v[j] = src[j]; s += (v[j][0] + v[j][1]) + (v[j][2] + v[j][3]); }
        s += __shfl_xor(s, 1); s += __shfl_xor(s, 2);
        const float mu = s * (1.0f / 64.0f); float q = 0.f;
#pragma unroll
        for (int j = 0; j < 4; ++j) { v[j] = v[j] - mu; q += (v[j][0] * v[j][0] + v[j][1] * v[j][1]) + (v[j][2] * v[j][2] + v[j][3] * v[j][3]); }
        q += __shfl_xor(q, 1); q += __shfl_xor(q, 2);
        const float rs = 1.0f / sqrtf(q * (1.0f / 64.0f) + EPS);
        v2u* dst = (v2u*)(KIH + (size_t)tok * 64 + part * 16);
#pragma unroll
        for (int j = 0; j < 4; ++j) { const f32x4 g = *(const f32x4*)(ln_g + part * 16 + 4 * j), bb = *(const f32x4*)(ln_b + part * 16 + 4 * j); const f32x4 y = v[j] * rs * g + bb;
            v2u h; h.x = cvt_pk_f16(y[0], y[1]); h.y = cvt_pk_f16(y[2], y[3]); dst[j] = h; }
    }
}

constexpr int RP = 136;
constexpr int RT_BYTES = 128 * RP * 2;
__device__ __forceinline__ float ret_log2g(int h) { return log2f(1.0f - exp2f(-5.0f - (float)h)); }
template <bool TR, bool DECAY> __device__ __forceinline__ void ret_stage_rot(Frame& F, const u16* src  , int row0, int pos0, int h, LAS _Float16* dst, float lg) {
    const f32x2* CS = (const f32x2*)(F.ws + WS_CS);
#pragma unroll
    for (int it = 0; it < 2; ++it) { const int ch = F.tid + 512 * it;
        const int j = TR ? (ch & 127) : (ch >> 3), fc = TR ? (ch >> 7) : (ch & 7);
        const u16* p = src + (size_t)(row0 + j) * 512 + h * 128 + 8 * fc;
        const v4u a = *(const v4u*)p, b = *(const v4u*)(p + 64);
        const f32x4* cs = (const f32x4*)(CS + (size_t)(pos0 + j) * 64 + 8 * fc);
        const f32x4 c0 = cs[0], c1 = cs[1], c2 = cs[2], c3 = cs[3];
        const float co[8] = {c0[0], c0[2], c1[0], c1[2], c2[0], c2[2], c3[0], c3[2]}, si[8] = {c0[1], c0[3], c1[1], c1[3], c2[1], c2[3], c3[1], c3[3]};
        const unsigned aw[4] = {a.x, a.y, a.z, a.w}, bw[4] = {b.x, b.y, b.z, b.w};
        const float sc = DECAY ? exp2f(lg * (float)(127 - j)) : 1.0f;
        float o1[8], o2[8];
#pragma unroll
        for (int i = 0; i < 8; ++i) { const float x1 = h2f((u16)(aw[i >> 1] >> (16 * (i & 1)))), x2 = h2f((u16)(bw[i >> 1] >> (16 * (i & 1))));
            o1[i] = (x1 * co[i] - x2 * si[i]) * sc; o2[i] = (x2 * co[i] + x1 * si[i]) * sc; }
        if (TR) {
#pragma unroll
            for (int i = 0; i < 8; ++i) { dst[(8 * fc + i) * RP + j] = (_Float16)o1[i]; dst[(64 + 8 * fc + i) * RP + j] = (_Float16)o2[i]; }
        } else {
            v4u w1, w2; w1.x = cvt_pk_f16(o1[0], o1[1]); w1.y = cvt_pk_f16(o1[2], o1[3]); w1.z = cvt_pk_f16(o1[4], o1[5]); w1.w = cvt_pk_f16(o1[6], o1[7]);
            w2.x = cvt_pk_f16(o2[0], o2[1]); w2.y = cvt_pk_f16(o2[2], o2[3]); w2.z = cvt_pk_f16(o2[4], o2[5]); w2.w = cvt_pk_f16(o2[6], o2[7]);
            *(LAS v4u*)(dst + j * RP + 8 * fc) = w1; *(LAS v4u*)(dst + j * RP + 64 + 8 * fc) = w2; }
    }
}
__device__ __forceinline__ void ret_stage_vt(Frame& F, const u16* src, int row0, int h, LAS _Float16* dst) {
#pragma unroll
    for (int it = 0; it < 4; ++it) { const int ch = F.tid + 512 * it, j = ch & 127, fc = ch >> 7;
        const v4u a = *(const v4u*)(src + (size_t)(row0 + j) * 512 + h * 128 + 8 * fc); const unsigned aw[4] = {a.x, a.y, a.z, a.w};
#pragma unroll
        for (int i = 0; i < 8; ++i) dst[(8 * fc + i) * RP + j] = __builtin_bit_cast(_Float16, (u16)(aw[i >> 1] >> (16 * (i & 1)))); }
}
__device__ __forceinline__ void ret_r1_unit(Frame& F, int u) {
    const int bh = u >> 6, c = u & 63, b = bh >> 2, h = bh & 3, row0 = b * SEQ + c * 128, r32 = F.lane & 31, hi = F.lane >> 5;
    LAS _Float16* KT = (LAS _Float16*)(F.lds + RING_OFF); LAS _Float16* VT = (LAS _Float16*)(F.lds + RING_OFF + RT_BYTES);
    ret_stage_rot<true, true>(F, (const u16*)(F.ws + WS_KB), row0, c * 128, h, KT, ret_log2g(h));
    ret_stage_vt(F, (const u16*)(F.ws + WS_VB), row0, h, VT);
    __syncthreads();
    const int eb = F.wave >> 1, db0 = 2 * (F.wave & 1);
    f32x16 acc0 = {}, acc1 = {};
#pragma unroll
    for (int s = 0; s < 8; ++s) {
        const f16x8 a = *(const LAS f16x8*)(VT + (32 * eb + r32) * RP + 16 * s + 8 * hi);
        const f16x8 b0 = *(const LAS f16x8*)(KT + (32 * db0 + r32) * RP + 16 * s + 8 * hi);
        const f16x8 b1 = *(const LAS f16x8*)(KT + (32 * (db0 + 1) + r32) * RP + 16 * s + 8 * hi);
        acc0 = __builtin_amdgcn_mfma_f32_32x32x16_f16(a, b0, acc0, 0, 0, 0);
        acc1 = __builtin_amdgcn_mfma_f32_32x32x16_f16(a, b1, acc1, 0, 0, 0);
    }
    float* DS = (float*)(F.ws + WS_DS) + (size_t)u * 16384;
#pragma unroll
    for (int r = 0; r < 16; ++r) { const int e = 32 * eb + crow(r, hi); DS[e * 128 + 32 * db0 + r32] = acc0[r]; DS[e * 128 + 32 * (db0 + 1) + r32] = acc1[r]; }
    __syncthreads();
}
__device__ __forceinline__ void ret_r2_scan(Frame& F) {
    const float* DS = (const float*)(F.ws + WS_DS); u16* ST = (u16*)(F.ws + WS_ST);
    for (int e = F.vcu * (NWAVES * 64) + F.tid; e < 16 * 8192; e += F.G * NWAVES * 64) {
        const int bh = e >> 13, off = (e & 8191) * 2; const float dec = exp2f(128.0f * ret_log2g(bh & 3));
        float s0 = 0.f, s1 = 0.f;
#pragma unroll 1
        for (int c0 = 0; c0 < 64; c0 += 32) { f32x2 d[32];
#pragma unroll
            for (int j = 0; j < 32; ++j) d[j] = *(const f32x2*)(DS + ((size_t)(bh * 64 + c0 + j)) * 16384 + off);
#pragma unroll
            for (int j = 0; j < 32; ++j) { *(unsigned*)(ST + ((size_t)(bh * 64 + c0 + j)) * 16384 + off) = cvt_pk_f16(s0, s1); s0 = dec * s0 + d[j][0]; s1 = dec * s1 + d[j][1]; } }
    }
}
__device__ __forceinline__ void ret_r3_unit(Frame& F, int u, const float* gn_g) {
    const int bh = u >> 6, c = u & 63, b = bh >> 2, h = bh & 3, row0 = b * SEQ + c * 128, r32 = F.lane & 31, hi = F.lane >> 5;
    LAS _Float16* Qs = (LAS _Float16*)(F.lds + RING_OFF); LAS _Float16* Ks = (LAS _Float16*)(F.lds + RING_OFF + RT_BYTES);
    LAS _Float16* VT = (LAS _Float16*)(F.lds + RING_OFF + 2 * RT_BYTES); LAS _Float16* Ps = (LAS _Float16*)(F.lds + RING_OFF + 3 * RT_BYTES);
    LAS float* rowpart = (LAS float*)(F.lds + 2048);
    const float lg = ret_log2g(h);
    const int ib = F.wave >> 1, xb0 = 2 * (F.wave & 1);
    SUB_BEGIN(30);
    ret_stage_rot<false, false>(F, (const u16*)(F.ws + WS_QB), row0, c * 128, h, Qs, lg);
    ret_stage_rot<false, false>(F, (const u16*)(F.ws + WS_KB), row0, c * 128, h, Ks, lg);
    ret_stage_vt(F, (const u16*)(F.ws + WS_VB), row0, h, VT);
    __syncthreads();
    SUB_END(30);
    SUB_BEGIN(31);
#pragma unroll
    for (int t = 0; t < 2; ++t) { const int jb = xb0 + t; f32x16 acc = {};
        if (jb <= ib) {
#pragma unroll
            for (int s = 0; s < 8; ++s) { const f16x8 a = *(const LAS f16x8*)(Qs + (32 * ib + r32) * RP + 16 * s + 8 * hi); const f16x8 bb = *(const LAS f16x8*)(Ks + (32 * jb + r32) * RP + 16 * s + 8 * hi);
                acc = __builtin_amdgcn_mfma_f32_32x32x16_f16(a, bb, acc, 0, 0, 0); } }
        const int j = 32 * jb + r32;
#pragma unroll
        for (int r = 0; r < 16; ++r) { const int i = 32 * ib + crow(r, hi); const float v = (i >= j) ? acc[r] * exp2f(lg * (float)(i - j)) : 0.f; Ps[i * RP + j] = (_Float16)v; } }
    __syncthreads();
    SUB_END(31);
    SUB_BEGIN(32);
    const u16* ST = (const u16*)(F.ws + WS_ST) + (size_t)u * 16384;
    f32x16 y[2];
#pragma unroll
    for (int t = 0; t < 2; ++t) { const int eb = xb0 + t; f32x16 intra = {}, cross = {};
#pragma unroll
        for (int s = 0; s < 8; ++s) { if (s < 2 * (ib + 1)) { const f16x8 a = *(const LAS f16x8*)(Ps + (32 * ib + r32) * RP + 16 * s + 8 * hi); const f16x8 bb = *(const LAS f16x8*)(VT + (32 * eb + r32) * RP + 16 * s + 8 * hi);
                intra = __builtin_amdgcn_mfma_f32_32x32x16_f16(a, bb, intra, 0, 0, 0); } }
#pragma unroll
        for (int s = 0; s < 8; ++s) { const f16x8 a = *(const LAS f16x8*)(Qs + (32 * ib + r32) * RP + 16 * s + 8 * hi); const f16x8 bb = *(const f16x8*)(ST + (32 * eb + r32) * 128 + 16 * s + 8 * hi);
            cross = __builtin_amdgcn_mfma_f32_32x32x16_f16(a, bb, cross, 0, 0, 0); }
#pragma unroll
        for (int r = 0; r < 16; ++r) { const int i = 32 * ib + crow(r, hi); y[t][r] = intra[r] + exp2f(lg * (float)(i + 1)) * cross[r]; } }
    SUB_END(32);
    SUB_BEGIN(33);
    float ss[16];
#pragma unroll
    for (int r = 0; r < 16; ++r) { float v = y[0][r] * y[0][r] + y[1][r] * y[1][r];
#pragma unroll
        for (int o = 1; o < 32; o <<= 1) v += __shfl_xor(v, o);
        ss[r] = v; }
    __syncthreads();
#pragma unroll
    for (int r = 0; r < 16; ++r) { const int i = 32 * ib + crow(r, hi);
#pragma unroll
        for (int t = 0; t < 2; ++t) Ps[i * RP + 32 * (xb0 + t) + r32] = (_Float16)y[t][r]; }
    if (r32 == 0) {
#pragma unroll
        for (int r = 0; r < 16; ++r) rowpart[(F.wave & 1) * 128 + 32 * ib + crow(r, hi)] = ss[r]; }
    __syncthreads();
    { const u16* GBp = (const u16*)(F.ws + WS_GB); u16* MIX = F.mix;
#pragma unroll
      for (int it = 0; it < 4; ++it) { const int ch = F.tid + 512 * it, i = ch >> 4, ec = ch & 15;
          const float rinv = 1.0f / sqrtf((rowpart[i] + rowpart[128 + i]) * (1.0f / 128.0f) + EPS);
          const v4u yv = *(const LAS v4u*)(Ps + i * RP + 8 * ec), gv = *(const v4u*)(GBp + (size_t)(row0 + i) * 512 + h * 128 + 8 * ec);
          const f32x4 g0 = *(const f32x4*)(gn_g + h * 128 + 8 * ec), g1 = *(const f32x4*)(gn_g + h * 128 + 8 * ec + 4);
          const unsigned yw[4] = {yv.x, yv.y, yv.z, yv.w}, gw[4] = {gv.x, gv.y, gv.z, gv.w}; float o[8];
#pragma unroll
          for (int k = 0; k < 8; ++k) o[k] = h2f((u16)(yw[k >> 1] >> (16 * (k & 1)))) * rinv * (k < 4 ? g0[k & 3] : g1[k & 3]) * h2f((u16)(gw[k >> 1] >> (16 * (k & 1))));
          v4u w; w.x = cvt_pk_f16(o[0], o[1]); w.y = cvt_pk_f16(o[2], o[3]); w.z = cvt_pk_f16(o[4], o[5]); w.w = cvt_pk_f16(o[6], o[7]);
          *(v4u*)(MIX + (size_t)(row0 + i) * 1024 + 512 + h * 128 + 8 * ec) = w; } }
    SUB_END(33);
    __syncthreads();
}

constexpr int IDX_CAP = 64, IDX_SEG = 28, IDX_LCAP = 16 * IDX_SEG, IDX_OVF = 64;
struct IdxSt { unsigned lo, hi, need, shift, cnt, above, ready, pad; };
__device__ __forceinline__ unsigned ok_key(float s) { const unsigned u = __builtin_bit_cast(unsigned, s); return u ^ ((unsigned)((int)u >> 31) | 0x80000000u); }

__device__ __forceinline__ void lds_add(LAS unsigned* p, unsigned v) { (void)__hip_atomic_fetch_add(p, v, __ATOMIC_RELAXED, __HIP_MEMORY_SCOPE_WORKGROUP); }
__device__ __forceinline__ unsigned lds_add_rtn(LAS unsigned* p, unsigned v) { return __hip_atomic_fetch_add(p, v, __ATOMIC_RELAXED, __HIP_MEMORY_SCOPE_WORKGROUP); }
__device__ __forceinline__ void idx_unit(Frame& F, int b, int g) {
    int lane_u = F.lane; asm volatile("" : "+v"(lane_u));
    const int lane = lane_u, wid = F.wave, l15 = lane & 15, fq = lane >> 4, set = wid >> 2, wsub = wid & 3;
    const int q0 = 32 * g, NT64 = 4 * (g >> 3) + 4, qloc = 16 * set + l15, qpos = q0 + qloc;
    unsigned* BMu = (unsigned*)(F.ws + WS_BM) + ((size_t)(b * 256 + g) * 128) * 64;
    if (g < 8) {
        const int r32 = lane & 31, hi = lane >> 5;
        for (int T = wid; T < NT64; T += 8) { unsigned w = 0u; const int lim = q0 + r32 - 64 * T - 4 * hi;
#pragma unroll 1
            for (int gi = 0; gi < 8; ++gi) { int c = lim - 8 * (gi & 3) - 32 * (gi >> 2) + 1; c = c < 0 ? 0 : (c > 4 ? 4 : c); w |= ((1u << c) - 1u) << (4 * gi); }
            BMu[T * 64 + lane] = w; }
        return;
    }
    LAS unsigned* hist = (LAS unsigned*)(F.lds + RING_OFF);
    LAS unsigned* okarr = hist;
    LAS u16* keyarr = (LAS u16*)(hist + 32 * IDX_LCAP);
    LAS unsigned* ovf = hist + 32 * IDX_LCAP + 16 * IDX_LCAP;
    LAS unsigned* img = ovf + 32 * IDX_OVF * 2;
    volatile LAS unsigned* segcnt = (volatile LAS unsigned*)(F.lds + 2048);
    volatile LAS IdxSt* st = (volatile LAS IdxSt*)(F.lds + 1024);
    volatile LAS unsigned* flag = (volatile LAS unsigned*)(F.lds + 512);
    const size_t row = (size_t)b * SEQ + qpos;
    const u16* QI = (const u16*)(F.ws + WS_QI) + row * 512; const float* WI = (const float*)(F.ws + WS_WI) + row * 8;
    const u16* KIb = (const u16*)(F.ws + WS_KIH) + (size_t)b * SEQ * 64;
    float ch[8];
    { const f32x4 w0 = *(const f32x4*)WI, w1 = *(const f32x4*)(WI + 4);
      const float ssq_ = ((w0[0] * w0[0] + w0[1] * w0[1]) + (w0[2] * w0[2] + w0[3] * w0[3])) + ((w1[0] * w1[0] + w1[1] * w1[1]) + (w1[2] * w1[2] + w1[3] * w1[3]));
      const float fac_ = 0.0625f * 90.5f / sqrtf(ssq_ > 1e-30f ? ssq_ : 1e-30f);
      for (int j = 0; j < 4; ++j) { ch[j] = w0[j] * fac_; ch[4 + j] = w1[j] * fac_; } }
    f16x8 qf[8][2], qt[2];
#pragma unroll
    for (int h = 0; h < 8; ++h)
#pragma unroll
        for (int s = 0; s < 2; ++s) qf[h][s] = *(const f16x8*)(QI + h * 64 + 32 * s + 8 * fq);
#pragma unroll
    for (int s = 0; s < 2; ++s) {
#pragma unroll
        for (int i = 0; i < 8; ++i) { float a = 0.f;
#pragma unroll
            for (int h = 0; h < 8; ++h) a += ch[h] * (float)qf[h][s][i];
            qt[s][i] = (_Float16)a; } }
    const int nT = (g >> 1) + 1;
#define IDX_TILE(k0_, k1_, sc) do { \
        sc = __builtin_amdgcn_mfma_f32_16x16x32_f16(k0_, qt[0], (f32x4){0.f, 0.f, 0.f, 0.f}, 0, 0, 0); sc = __builtin_amdgcn_mfma_f32_16x16x32_f16(k1_, qt[1], sc, 0, 0, 0); \
        _Pragma("unroll") for (int h = 0; h < 8; ++h) { f32x4 dh_ = __builtin_amdgcn_mfma_f32_16x16x32_f16(k0_, qf[h][0], (f32x4){0.f, 0.f, 0.f, 0.f}, 0, 0, 0); dh_ = __builtin_amdgcn_mfma_f32_16x16x32_f16(k1_, qf[h][1], dh_, 0, 0, 0); \
            _Pragma("unroll") for (int i = 0; i < 4; ++i) sc[i] = __builtin_fmaf(__builtin_fabsf(dh_[i]), ch[h], sc[i]); } } while (0)
#define IDX_TILE_NS(k0_, k1_, sc) do {   \
        sc = __builtin_amdgcn_mfma_f32_16x16x32_f16(k0_, qt[0], (f32x4){0.f, 0.f, 0.f, 0.f}, 0, 0, 0); sc = __builtin_amdgcn_mfma_f32_16x16x32_f16(k1_, qt[1], sc, 0, 0, 0); \
        _Pragma("unroll") for (int h = 0; h < 8; ++h) { f32x4 dh_ = __builtin_amdgcn_mfma_f32_16x16x32_f16(k0_, qf[h][0], (f32x4){0.f, 0.f, 0.f, 0.f}, 0, 0, 0); dh_ = __builtin_amdgcn_mfma_f32_16x16x32_f16(k1_, qf[h][1], dh_, 0, 0, 0); \
            _Pragma("unroll") for (int i = 0; i < 4; ++i) { float a_ = __builtin_fmaf(__builtin_fabsf(dh_[i]), ch[h], sc[i]); if (i) asm("" : "+v"(a_)); sc[i] = a_; } } } while (0)
#define IDX_KTILE(dst, T, m) do { const u16* kp_ = KIb + (size_t)(64 * (T) + 16 * (m) + l15_) * 64 + 8 * fq_; dst[0] = *(const f16x8*)kp_; dst[1] = *(const f16x8*)(kp_ + 32); } while (0)

    const int floorb = 0;
#pragma unroll 1
    for (int attempt = (g >= 16) ? 0 : 1; attempt < 2; ++attempt) {
        const bool sampled = (attempt == 0);
        for (int i = F.tid; i < 8192; i += NWAVES * 64) ((LAS v4u*)hist)[i] = (v4u){0u, 0u, 0u, 0u};
        if (F.tid < 32) { st[F.tid].lo = 0u; st[F.tid].hi = 0xFFFFFFFFu; st[F.tid].need = 256u; st[F.tid].shift = 0u; st[F.tid].cnt = 0u; st[F.tid].above = 0u; st[F.tid].ready = 0u; st[F.tid].pad = 0u; }
        if (F.tid < 2) flag[F.tid] = 0u;
        __syncthreads();
        for (int level = 0; level < 8; ++level) {
            int l15_ = l15, fq_ = fq; asm volatile("" : "+v"(l15_), "+v"(fq_)); const int qloc_ = 16 * set + l15_; LAS unsigned* hq = hist + qloc_ * 1024;
            const unsigned rdy = st[qloc_].ready, lo = rdy ? 1u : st[qloc_].lo, width = rdy ? 0u : st[qloc_].hi - lo, sh = st[qloc_].shift;
            LDS_WAIT();
            const int Tstep = sampled ? 16 : 4, fl_ = sampled ? 0 : floorb;
            f16x8 kc[4][2];
#pragma unroll
            for (int m = 0; m < 4; ++m) IDX_KTILE(kc[m], wsub < nT ? wsub : 0, m);
            if (level == 0) {
                for (int T = wsub; T < nT; T += Tstep) { const int Tn = T + Tstep < nT ? T + Tstep : T; const bool diag = (64 * T + 63 > q0);
#pragma unroll
                    for (int m = 0; m < 4; ++m) { const int kt = 64 * T + 16 * m;
                        f32x4 sc; IDX_TILE_NS(kc[m][0], kc[m][1], sc);
                        IDX_KTILE(kc[m], Tn, m);
                        if (diag) { const int lim = qpos - kt - 4 * fq_;
#pragma unroll
                            for (int i = 0; i < 4; ++i) { int bin = (int)__builtin_floorf(sc[i]) + 512; bin = bin < 0 ? 0 : (bin > 1023 ? 1023 : bin);
                                if ((bin >= fl_) & (i <= lim)) lds_add(hq + bin, 1u); } }
                        else {
#pragma unroll
                            for (int i = 0; i < 4; ++i) { int bin = (int)__builtin_floorf(sc[i]) + 512; bin = bin < 0 ? 0 : (bin > 1023 ? 1023 : bin);
                                if (bin >= fl_) lds_add(hq + bin, 1u); } } } }
            } else {
                for (int T = wsub; T < nT; T += 4) { const int Tn = T + 4 < nT ? T + 4 : T;
#pragma unroll
                    for (int m = 0; m < 4; ++m) { const int kt = 64 * T + 16 * m;
                        f32x4 sc; IDX_TILE(kc[m][0], kc[m][1], sc);
                        IDX_KTILE(kc[m], Tn, m);
                        const int lim = qpos - kt - 4 * fq_;
#pragma unroll
                        for (int i = 0; i < 4; ++i) { const unsigned d = ok_key(sc[i]) - lo; unsigned bin = d >> sh; bin = bin > 1023u ? 1023u : bin;
                            if ((d <= width) & (i <= lim)) lds_add(hq + bin, 1u); } } }
            }
            __syncthreads();
#pragma unroll 1
            for (int qq = 0; qq < 4; ++qq) { const int q = 4 * wid + qq; if (st[q].ready) continue;
                int ln = lane; asm volatile("" : "+v"(ln));
                LAS unsigned* hw = hist + q * 1024 + 16 * ln; unsigned wv[16]; unsigned s_ = 0u;
#pragma unroll
                for (int i = 0; i < 16; ++i) { wv[i] = hw[i]; s_ += wv[i]; }
                unsigned suf = s_;
#pragma unroll
                for (int o = 1; o < 64; o <<= 1) { const unsigned t = __shfl_down(suf, o); if (ln + o < 64) suf += t; }
                const unsigned total = __shfl(suf, 0), aboveL = suf - s_;
                const unsigned qlo = st[q].lo, qhi = st[q].hi, qsh = st[q].shift, qneed = st[q].need;
                if (sampled) {
                    const int p_ = q0 + q, tm_ = p_ >> 6; const int ns_ = 64 * (4 * (tm_ >> 4) + ((tm_ & 15) < 4 ? (tm_ & 15) : 4)) + (((tm_ & 15) < 4) ? (p_ & 63) + 1 : 0);
                    const float f_ = (float)ns_ / (float)(p_ + 1), mean_ = 256.0f * f_, sd_ = sqrtf(256.0f * f_ * (1.0f - f_));
                    const int rhi_ = (int)(mean_ - 4.0f * sd_), rlo_ = (int)(mean_ + 4.0f * sd_) + 1; const unsigned thi_ = rhi_ < 1 ? 1u : (unsigned)rhi_, tlo_ = (unsigned)rlo_;
                    if (total < tlo_) { if (ln == 0) flag[1] = 1u; }
                    else {
#pragma unroll 1
                        for (int which = 0; which < 2; ++which) { const unsigned tgt = which ? tlo_ : thi_;
                            if (aboveL < tgt && tgt <= aboveL + s_) { unsigned accu = aboveL, bin = 0u; bool found = false;
#pragma unroll
                                for (int i = 15; i >= 0; --i) { if (!found && accu + wv[i] >= tgt) { found = true; bin = 16u * (unsigned)ln + i; } if (!found) accu += wv[i]; }
                                if (which) st[q].lo = ok_key((float)((int)bin - 512)); else st[q].hi = (bin == 1023u) ? 0xFFFFFFFFu : ok_key((float)((int)bin - 511)) - 1u; } }
                    }
                    if (ln == 0) st[q].ready = 1u;
                } else if (qneed > total) {
                    if (ln == 0) { if (level == 0) { st[q].hi = ok_key((float)(floorb - 512)) - 1u; st[q].lo = 0u; } else { st[q].hi = qlo - 1u; st[q].lo = 0u; } st[q].need = qneed - total; } }
                else if (aboveL < qneed && qneed <= aboveL + s_) {
                    unsigned accu = aboveL, bin = 0u, cbin = 0u; bool found = false;
#pragma unroll
                    for (int i = 15; i >= 0; --i) { if (!found && accu + wv[i] >= qneed) { found = true; bin = 16u * (unsigned)ln + i; cbin = wv[i]; } if (!found) accu += wv[i]; }
                    unsigned nlo, nhi;
                    if (level == 0) { nlo = (bin == 0u) ? 0u : ok_key((float)((int)bin - 512)); nhi = (bin == 1023u) ? 0xFFFFFFFFu : ok_key((float)((int)bin - 511)) - 1u; }
                    else { nlo = qlo + (bin << qsh); nhi = nlo + ((1u << qsh) - 1u); if (nhi < nlo || nhi > qhi || bin == 1023u) nhi = qhi; }
                    st[q].lo = nlo; st[q].hi = nhi; st[q].need = qneed - accu;
                    if (cbin <= (unsigned)IDX_CAP || (level > 0 && qsh == 0u)) st[q].ready = 1u; }
                LDS_WAIT();
                if (!st[q].ready) { const unsigned w_ = st[q].hi - st[q].lo; const unsigned nb = 32u - (unsigned)__builtin_clz(w_ | 1u); if (ln == 0) { st[q].shift = nb > 10u ? nb - 10u : 0u; flag[0] = 1u; } }
#pragma unroll
                for (int i = 0; i < 16; ++i) hw[i] = 0u;
            }
            __syncthreads();
            const unsigned again = flag[0];
            __syncthreads();
            if (F.tid == 0) flag[0] = 0u;
            if (!again) break;
        }
        { const unsigned fail_ = flag[1]; __syncthreads(); if (sampled && fail_) continue; }
        {
            int l15_ = l15, fq_ = fq; asm volatile("" : "+v"(l15_), "+v"(fq_)); const int qloc_ = 16 * set + l15_;
            const unsigned lo = st[qloc_].lo, hiK = st[qloc_].hi, width = hiK - lo;
            LDS_WAIT();
            float flo = __builtin_bit_cast(float, (lo & 0x80000000u) ? (lo ^ 0x80000000u) : ~lo), fhi = __builtin_bit_cast(float, (hiK & 0x80000000u) ? (hiK ^ 0x80000000u) : ~hiK);
            if (!(flo == flo)) flo = -INFINITY; if (!(fhi == fhi)) fhi = INFINITY;
            const int seg_ = wsub * 4 + fq_; LAS unsigned* okl = okarr + qloc_ * IDX_LCAP + seg_ * IDX_SEG; LAS u16* keyl = keyarr + qloc_ * IDX_LCAP + seg_ * IDX_SEG;
            unsigned nabove = 0u, mycnt = 0u;
            f16x8 kc[4][2];
#pragma unroll
            for (int m = 0; m < 4; ++m) IDX_KTILE(kc[m], wsub < nT ? wsub : 0, m);
            for (int T = wsub; T < NT64; T += 4) { unsigned part = 0u;
                if (T < nT) { const int Tn = T + 4 < nT ? T + 4 : T; const bool diag = (64 * T + 63 > q0);
#pragma unroll
                    for (int m = 0; m < 4; ++m) { const int kt = 64 * T + 16 * m;
                        f32x4 sc; IDX_TILE_NS(kc[m][0], kc[m][1], sc);
                        IDX_KTILE(kc[m], Tn, m);
                        if (diag) { const int lim = qpos - kt - 4 * fq_;
#pragma unroll
                            for (int i = 0; i < 4; ++i) sc[i] = (i <= lim) ? sc[i] : __builtin_nanf(""); }
                        const unsigned kb = (unsigned)(kt + 4 * fq_);
                        if (__builtin_amdgcn_ballot_w64(mycnt > (unsigned)(IDX_SEG - 4)) != 0ull) {
#pragma unroll
                            for (int i = 0; i < 4; ++i) { const bool sure = sc[i] > fhi;
                                part |= sure ? (1u << (16 * (m >> 1) + 8 * (m & 1) + i)) : 0u;
                                if ((sc[i] >= flo) & !sure) { if (mycnt < (unsigned)IDX_SEG) { okl[mycnt] = ok_key(sc[i]); keyl[mycnt] = (u16)(kb + i); }
                                    else { const unsigned pos = lds_add_rtn((LAS unsigned*)&st[qloc_].pad, 1u); if (pos < (unsigned)IDX_OVF) { ovf[(qloc_ * IDX_OVF + pos) * 2] = ok_key(sc[i]); ovf[(qloc_ * IDX_OVF + pos) * 2 + 1] = kb + i; } }
                                    mycnt += 1u; } }
                        } else {
#pragma unroll
                            for (int i = 0; i < 4; ++i) { const bool sure = sc[i] > fhi;
                                part |= sure ? (1u << (16 * (m >> 1) + 8 * (m & 1) + i)) : 0u;
                                okl[mycnt] = ok_key(sc[i]); keyl[mycnt] = (u16)(kb + i);
                                mycnt += ((sc[i] >= flo) & !sure) ? 1u : 0u; } }
                    }
                    nabove += (unsigned)__builtin_popcount(part);
                }
                part <<= 4 * (fq_ >> 1);
                const unsigned word = part | (unsigned)__shfl_xor((int)part, 32);
                if (fq_ < 2) img[T * 64 + qloc_ + 32 * (fq_ & 1)] = word; }
            lds_add((LAS unsigned*)&st[qloc_].above, nabove); lds_add((LAS unsigned*)&st[qloc_].cnt, mycnt);
            segcnt[qloc_ * 16 + seg_] = mycnt < (unsigned)IDX_SEG ? mycnt : (unsigned)IDX_SEG;
        }
        __syncthreads();
        if (sampled) {
            if (F.tid < 32) { const unsigned a = st[F.tid].above, c = st[F.tid].cnt; if (!(a < 256u && a + c >= 256u && st[F.tid].pad <= (unsigned)IDX_OVF)) flag[1] = 1u; else st[F.tid].need = 256u - a; }
            __syncthreads();
            const unsigned fail_ = flag[1]; __syncthreads();
            if (fail_) continue;
        }
#pragma unroll 1
        for (int qq = 0; qq < 4; ++qq) { int ln = lane; asm volatile("" : "+v"(ln)); const int q = 4 * wid + qq;
            const unsigned need = st[q].need;
            const LAS unsigned* lw = okarr + q * IDX_LCAP; const LAS u16* lk = keyarr + q * IDX_LCAP;
            const LAS unsigned* lo_ = ovf + q * IDX_OVF * 2; const unsigned novf = st[q].pad < (unsigned)IDX_OVF ? st[q].pad : (unsigned)IDX_OVF;
            unsigned ek[8];
#pragma unroll
            for (int k = 0; k < 7; ++k) { const unsigned j = (unsigned)ln + 64u * k; ek[k] = ((j % IDX_SEG) < segcnt[q * 16 + (j / IDX_SEG)]) ? lw[j] : 0u; }
            ek[7] = ((unsigned)ln < novf) ? lo_[2 * ln] : 0u;
            const unsigned rlo_ = st[q].lo, rhi_ = st[q].hi; const int topbit = 31 - (int)__builtin_clz((rlo_ ^ rhi_) | 1u);
            unsigned Tv = (topbit >= 31) ? 0u : (rlo_ & ~((2u << topbit) - 1u));
#pragma unroll 1
            for (int bit = topbit; bit >= 0; --bit) { const unsigned cand = Tv | (1u << bit); unsigned c = 0u;
#pragma unroll
                for (int k = 0; k < 8; ++k) c += (unsigned)__popcll(__ballot(ek[k] >= cand));
                if (c >= need) Tv = cand; }
            unsigned cgt = 0u, ceq = 0u;
#pragma unroll
            for (int k = 0; k < 8; ++k) { cgt += (unsigned)__popcll(__ballot(ek[k] > Tv)); ceq += (unsigned)__popcll(__ballot(ek[k] == Tv && ek[k] != 0u)); }
            const unsigned need_eq = need > cgt ? need - cgt : 0u;
#pragma unroll
            for (int k = 0; k < 8; ++k) { bool sel = ek[k] > Tv; const unsigned myj = (unsigned)ln + 64u * k;
                const unsigned mykey = (k < 7) ? (unsigned)lk[myj < (unsigned)IDX_LCAP ? myj : 0u] : lo_[2 * ln + 1];
                if (ek[k] == Tv && ek[k] != 0u) { if (need_eq >= ceq) sel = true; else { unsigned rk = 0u;
                        for (unsigned j = 0; j < (unsigned)IDX_LCAP; ++j) rk += ((j % IDX_SEG) < segcnt[q * 16 + (j / IDX_SEG)] && lw[j] == Tv && lk[j] < mykey) ? 1u : 0u;
                        for (unsigned j = 0; j < novf; ++j) rk += (lo_[2 * j] == Tv && lo_[2 * j + 1] < mykey) ? 1u : 0u; sel = rk < need_eq; } }
                if (sel) { const unsigned ki = mykey, T = ki >> 6, k64 = ki & 63u, half = k64 >> 5, k32 = k64 & 31u, khi = (k32 >> 2) & 1u, r = (k32 & 3u) + 4u * (k32 >> 3);
                    (void)__hip_atomic_fetch_or(img + T * 64 + (unsigned)q + 32u * khi, 1u << (16u * half + r), __ATOMIC_RELAXED, __HIP_MEMORY_SCOPE_WORKGROUP); } }
        }
        __syncthreads();
        { int t_ = F.tid; asm volatile("" : "+v"(t_)); for (int i = t_; i < NT64 * 16; i += NWAVES * 64) ((v4u*)BMu)[i] = ((const LAS v4u*)img)[i]; }
        break;
    }
    __syncthreads();
#undef IDX_TILE
#undef IDX_TILE_NS
#undef IDX_KTILE
}

__device__ __forceinline__ void final_norm(Frame& F, float* out, const float* part, const float* gfin) {
    const int gw = F.vcu * NWAVES + F.wave, NGW = F.G * NWAVES;
    for (int m = gw; m < MTOK; m += NGW) {
        float p = (F.lane < 16) ? part[(size_t)m * 16 + F.lane] : 0.f; p = wave_sum(p);
        const float r = 1.0f / sqrtf(p * (1.0f / DM) + EPS);
        f32x4* xr = (f32x4*)(out + (size_t)m * DM) + F.lane; const f32x4* gr = (const f32x4*)gfin + F.lane;
#pragma unroll
        for (int j = 0; j < 4; ++j) { const f32x4 v = xr[64 * j] * r * gr[64 * j]; xr[64 * j] = v; }
    }
}

struct Args { const float* in[13]; float* out; unsigned char* ws; int ph_lo, ph_hi, li, pad; };
__global__ void __launch_bounds__(NWAVES * 64, 2) hymba_fwd(Args args) {
    extern __shared__ __attribute__((aligned(16))) unsigned char lds_raw[];
    Frame F;
    F.lds = (LAS unsigned char*)lds_raw; F.ws = args.ws; F.mix = (u16*)args.out;
    F.tid = threadIdx.x; F.lane = F.tid & 63; F.wave = __builtin_amdgcn_readfirstlane(F.tid >> 6);
    F.G = gridDim.x; { const int bx = blockIdx.x; F.vcu = (F.G % 8 == 0) ? (bx % 8) * (F.G / 8) + bx / 8 : bx; }
    for (int u = F.tid; u < LCTL_BYTES / 4; u += NWAVES * 64) ((LAS unsigned*)F.lds)[u] = 0u;
    __syncthreads();
    gu32* ctl = (gu32*)(args.ws + WS_CTL);
    XcdBarrier bar; bar.bar = (unsigned*)(ctl + CW_BAR) + args.li * XCD_BAR_WORDS; bar.x = 0; bar.st = nullptr;
    if (N_LAUNCHES != N_PHASES) bar = xcd_barrier_post((unsigned*)(ctl + CW_BAR) + args.li * XCD_BAR_WORDS, (volatile LAS unsigned*)(F.lds + 64));
#define GRID_BAR() do { if (N_LAUNCHES != N_PHASES) xcd_barrier(bar); } while (0)
    const int lo = args.ph_lo, hi = args.ph_hi;
#ifndef PHASE_MASK
#define PHASE_MASK 0x1ff
#endif
#define IN(k) (((PHASE_MASK >> (k)) & 1) && lo <= (k) && (k) < hi)
#define BOTH(k) (IN(k) && IN((k) + 1))
#define PH_TID() do { int t_ = threadIdx.x; asm volatile("" : "+v"(t_)); F.tid = t_; F.lane = t_ & 63; F.wave = __builtin_amdgcn_readfirstlane(t_ >> 6); } while (0)
#ifdef PROBE_PHASE
#define PH_BEGIN(k) const unsigned long long t0_##k = ((k) == PROBE_PHASE) ? __builtin_amdgcn_s_memrealtime() : 0ull
#define PH_END(k) do { if ((k) == PROBE_PHASE) { const unsigned long long t1_ = __builtin_amdgcn_s_memrealtime(), dt_ = t1_ - t0_##k; while (__builtin_amdgcn_s_memrealtime() - t1_ < (unsigned long long)(PROBE_MULT) * dt_) __builtin_amdgcn_s_sleep(8); } } while (0)
#else
#define PH_BEGIN(k) do {} while (0)
#define PH_END(k) do {} while (0)
#endif
    const float* x = args.in[0];
    unsigned char* ws = args.ws;
    LAS unsigned char* ring = F.lds + RING_OFF;

    if (IN(0)) { PH_TID(); PH_BEGIN(0);
        P0Args A{x, args.in[1], args.in[2], args.in[5], args.in[7], args.in[8], args.in[9], args.in[10], args.in[11]};
        p0_prologue<0>(F, A, F.vcu, 0, F.G);
        if (F.G != 256) p0_prologue<1>(F, A, F.vcu, 0, F.G);
        PH_END(0);
        if (BOTH(0)) GRID_BAR();
    }
    if (IN(1)) { PH_TID(); PH_BEGIN(1);
        pg8::Gemm g{(const u16*)(ws + WS_XH), (const u16*)(ws + WS_WIN), MTOK, N_IN, DM}; pg8::StaticOrder S; S.init(MTOK, N_IN, F.G, (int)blockIdx.x);
        pg8::EpiProj E{ws + WS_QA, (float*)(ws + WS_KIRAW), (float*)(ws + WS_WI), (const float*)(ws + WS_RINV1)};
        pg8::gemm_phase<pg8::EpiProj, pg8::StaticOrder, true, true>(ring, g, S, E);
        if (F.G == 256) { P0Args A{x, args.in[1], args.in[2], args.in[5], args.in[7], args.in[8], args.in[9], args.in[10], args.in[11]}; __syncthreads(); p0_prologue<1>(F, A, (int)blockIdx.x, 128, 128); }
        PH_END(1);
        if (BOTH(1)) GRID_BAR();
    }
    if (IN(2)) { PH_TID(); PH_BEGIN(2);
        ki_layernorm(F, args.in[3], args.in[4]);
        for (int u = F.vcu; u < 1024; u += F.G) ret_r1_unit(F, u);
        PH_END(2);
        if (BOTH(2)) GRID_BAR();
    }
    if (IN(3)) { PH_TID(); PH_BEGIN(3);
        { PH_BEGIN(9); ret_r2_scan(F); PH_END(9); }
        PH_BEGIN(10);
        { const bool deal = (F.G == 256); const int bb = F.vcu >> 6, s = F.vcu & 63, nun = deal ? 4 : (1024 - F.vcu + F.G - 1) / F.G;
          _Pragma("unroll 1") for (int i = 0; i < nun; ++i) { int ub, ug; if (deal) { ub = bb; ug = (i == 0) ? 255 - s : (i == 1) ? 128 + s : (i == 2) ? 127 - s : s; } else { const int u = F.vcu + i * F.G; ub = u >> 8; ug = u & 255; }
              idx_unit(F, ub, ug); } }
        PH_END(10);
        PH_END(3);
        if (BOTH(3)) GRID_BAR();
    }
    if (IN(4)) { PH_TID(); PH_BEGIN(4);
        { PH_BEGIN(11); for (int u = F.vcu; u < 1024; u += F.G) ret_r3_unit(F, u, args.in[6]); PH_END(11); }
        PH_BEGIN(12);
        const attn_body::AttnTensors AT{(const attn_body::bf16*)(ws + WS_QA), (const attn_body::bf16*)(ws + WS_KA), (const attn_body::bf16*)(ws + WS_VA), F.mix, (const unsigned*)(ws + WS_BM), (const float*)(ws + WS_BIAS)};
        if (F.G == 256) { const attn_body::StaticOrder S((int)F.G, (int)blockIdx.x); attn_body::attn_phase<attn_body::StaticOrder>((char*)lds_raw + RING_OFF, AT, S); }
        else { const attn_body::StridedOrder S((int)F.G, (int)blockIdx.x); attn_body::attn_phase<attn_body::StridedOrder>((char*)lds_raw + RING_OFF, AT, S); }
        PH_END(12);
        PH_END(4);
        if (BOTH(4)) GRID_BAR();
    }
    if (IN(5)) { PH_TID(); PH_BEGIN(5);
        pg8::Gemm g{(const u16*)F.mix, (const u16*)(ws + WS_WOUT), MTOK, DM, DM}; pg8::StaticOrder S; S.init(MTOK, DM, F.G, (int)blockIdx.x);
        pg8::EpiX2 E{(const u16*)(ws + WS_XH), (u16*)(ws + WS_X2H), (float*)(ws + WS_PART2)};
        pg8::gemm_phase<pg8::EpiX2, pg8::StaticOrder, true, true>(ring, g, S, E);
        PH_END(5);
        if (BOTH(5)) GRID_BAR();
    }
    if (IN(6)) { PH_TID(); PH_BEGIN(6);
        pg8::Gemm g{(const u16*)(ws + WS_X2H), (const u16*)(ws + WS_WGU), MTOK, 2 * DFF, DM}; pg8::StaticOrder S; S.init(MTOK, 2 * DFF, F.G, (int)blockIdx.x);
        pg8::EpiGU E{(u16*)(ws + WS_U), (const float*)(ws + WS_PART2)};
        pg8::gemm_phase<pg8::EpiGU, pg8::StaticOrder, true, true>(ring, g, S, E);
        PH_END(6);
        if (BOTH(6)) GRID_BAR();
    }
    if (IN(7)) { PH_TID(); PH_BEGIN(7);
        pg8::Gemm g{(const u16*)(ws + WS_U), (const u16*)(ws + WS_WD), MTOK, DM, DFF}; pg8::StaticOrder S; S.init(MTOK, DM, F.G, (int)blockIdx.x);
#ifdef UNFUSED_FINAL_NORM
        pg8::EpiDown E{(const u16*)(ws + WS_X2H), args.out, (float*)(ws + WS_PART3)};
        pg8::gemm_phase<pg8::EpiDown, pg8::StaticOrder, true, true>(ring, g, S, E);
        PH_END(7);
        if (BOTH(7)) GRID_BAR();
#else
        pg8::EpiDownNorm E{(const u16*)(ws + WS_X2H), args.out, (float*)(ws + WS_PART3), (unsigned*)(ctl + 16384), args.in[12]};
        pg8::gemm_phase<pg8::EpiDownNorm, pg8::StaticOrder, true, true>(ring, g, S, E);
        PH_END(7);
#endif
    }
#ifdef UNFUSED_FINAL_NORM
    if (IN(8)) { PH_TID(); PH_BEGIN(8); final_norm(F, args.out, (const float*)(ws + WS_PART3), args.in[12]); PH_END(8); }
#endif
#undef IN
#undef BOTH
#undef GRID_BAR
}


#ifdef DIAG_DETERMINISM
__global__ void k_checksum(const unsigned* p, size_t nwords, unsigned long long* slot) {
    unsigned long long s = 0; for (size_t i = (size_t)blockIdx.x * blockDim.x + threadIdx.x; i < nwords; i += (size_t)gridDim.x * blockDim.x) s += (unsigned long long)p[i] * (unsigned long long)((i & 1023u) + 1u);
    for (int o = 32; o >= 1; o >>= 1) s += __shfl_xor(s, o);
    if ((threadIdx.x & 63) == 0) atomicAdd(slot, s);
}
#ifndef DIAG_PASSES
#define DIAG_PASSES 4
#endif
__global__ void k_checksum_cols(const unsigned* p, int rows, int pitchw, int c0, int c1, unsigned long long* slot) {
    unsigned long long s = 0; const int w = c1 - c0; for (size_t i = (size_t)blockIdx.x * blockDim.x + threadIdx.x; i < (size_t)rows * w; i += (size_t)gridDim.x * blockDim.x) { const size_t r = i / w, c = c0 + i % w; s += (unsigned long long)p[r * pitchw + c] * (unsigned long long)((i & 1023u) + 1u); }
    for (int o = 32; o >= 1; o >>= 1) s += __shfl_xor(s, o);
    if ((threadIdx.x & 63) == 0) atomicAdd(slot, s);
}
__global__ void k_report(float* out, const unsigned long long* cs, const int* phase_of, int nbuf, size_t n) {
    int ph = -1; for (int i = 0; i < nbuf && ph < 0; ++i) for (int p = 1; p < DIAG_PASSES; ++p) if (cs[i] != cs[64 * p + i]) { ph = phase_of[i]; break; }
    if (ph < 0) return; const float delta = 0.1f * (float)(ph + 1);
    for (size_t i = (size_t)blockIdx.x * blockDim.x + threadIdx.x; i < n; i += (size_t)gridDim.x * blockDim.x) out[i] += delta;
}
__global__ void k_setphase(int* phase_of, unsigned long long packed_lo, unsigned long long packed_hi) { const int i = threadIdx.x; if (i < 32) phase_of[i] = (int)(((i < 16 ? packed_lo : packed_hi) >> (4 * (i & 15))) & 15ull); }
extern "C" void kernel_launch(void* const* d_in, const int* in_sizes, int n_in, void* d_out, int out_size, void* d_ws, size_t ws_size, hipStream_t stream) {
    static int grid = 0;
    if (grid == 0) { int dev = 0, cus = 0; hipGetDevice(&dev); hipDeviceGetAttribute(&cus, hipDeviceAttributeMultiprocessorCount, dev);
        if (hipFuncSetAttribute((const void*)hymba_fwd, hipFuncAttributeMaxDynamicSharedMemorySize, LDS_BYTES) != hipSuccess) { grid = -1; return; } grid = cus; }
    if (grid < 0) return;
    hipMemsetAsync((char*)d_ws + WS_CTL, 0, CTL_ZERO_BYTES, stream);
    Args a{}; for (int i = 0; i < 13; ++i) a.in[i] = (const float*)d_in[i]; a.out = (float*)d_out; a.ws = (unsigned char*)d_ws;
    unsigned char* ws = (unsigned char*)d_ws; unsigned long long* cs = (unsigned long long*)(ws + 100 * 1024);
    struct B { int ph; const void* p; size_t bytes; };
    const B bufs[] = { {0, ws + WS_XH, (size_t)MTOK * DM * 2}, {0, ws + WS_RINV1, (size_t)MTOK * 4}, {0, ws + WS_WIN, (size_t)N_IN * 1024 * 2}, {1, ws + WS_WOUT, (size_t)1024 * 1024 * 2}, {1, ws + WS_WGU, (size_t)5632 * 1024 * 2}, {1, ws + WS_WD, (size_t)1024 * DFF * 2}, {1, ws + WS_CS, (size_t)SEQ * 64 * 8}, {0, ws + WS_BIAS, (size_t)8 * 128 * 4},
        {1, ws + WS_QA, 32 * MiB}, {1, ws + WS_KA, 32 * MiB}, {1, ws + WS_VA, 32 * MiB}, {1, ws + WS_QI, 32 * MiB}, {1, ws + WS_QB, 32 * MiB}, {1, ws + WS_KB, 32 * MiB}, {1, ws + WS_VB, 32 * MiB}, {1, ws + WS_GB, 32 * MiB}, {1, ws + WS_KIRAW, 8 * MiB}, {1, ws + WS_WI, 1 * MiB},
        {2, ws + WS_KIH, 4 * MiB}, {2, ws + WS_DS, 64 * MiB}, {3, ws + WS_ST, 32 * MiB}, {3, ws + WS_BM, 32 * MiB}, {4, d_out, 1}, {9, d_out, 2},
        {5, ws + WS_X2H, 64 * MiB}, {5, ws + WS_PART2, 2 * MiB}, {6, ws + WS_U, (size_t)MTOK * DFF * 2}, {7, d_out, 128 * MiB}, {7, ws + WS_PART3, 2 * MiB} };
    const int nbuf = (int)(sizeof(bufs) / sizeof(bufs[0]));
    for (int pass = 0; pass < DIAG_PASSES; ++pass)
        for (int li = 0; li < N_PHASES; ++li) {
            a.ph_lo = li; a.ph_hi = li + 1; a.li = 0; a.pad = 0;
            hipLaunchKernelGGL(hymba_fwd, dim3(grid), dim3(NWAVES * 64), LDS_BYTES, stream, a);
            for (int k = 0; k < nbuf; ++k) { if (bufs[k].bytes <= 2) { if (li == 4) hipLaunchKernelGGL(k_checksum_cols, dim3(1024), dim3(256), 0, stream, (const unsigned*)bufs[k].p, MTOK, 512, bufs[k].bytes == 1 ? 0 : 256, bufs[k].bytes == 1 ? 256 : 512, cs + pass * 64 + k); }
                else if (bufs[k].ph == li) hipLaunchKernelGGL(k_checksum, dim3(1024), dim3(256), 0, stream, (const unsigned*)bufs[k].p, bufs[k].bytes / 4, cs + pass * 64 + k); }
        }
    unsigned long long plo = 0, phi = 0; for (int k = 0; k < nbuf; ++k) { if (k < 16) plo |= (unsigned long long)bufs[k].ph << (4 * k); else phi |= (unsigned long long)bufs[k].ph << (4 * (k - 16)); }
    int* phase_of = (int*)(ws + 104 * 1024);
    hipLaunchKernelGGL(k_setphase, dim3(1), dim3(64), 0, stream, phase_of, plo, phi);
    hipLaunchKernelGGL(k_report, dim3(1024), dim3(256), 0, stream, (float*)d_out, (const unsigned long long*)cs, (const int*)phase_of, nbuf, (size_t)MTOK * DM);
}
#else
extern "C" void kernel_launch(void* const* d_in, const int* in_sizes, int n_in, void* d_out, int out_size, void* d_ws, size_t ws_size, hipStream_t stream) {
    static int grid = 0;
    if (grid == 0) {
        if (n_in != 13 || in_sizes[0] != MTOK * DM || out_size != MTOK * DM || ws_size < WS_END) { fprintf(stderr, "kernel_launch: unexpected shapes / workspace (%d inputs, ws %zu)\n", n_in, ws_size); grid = -1; return; }
        int dev = 0, cus = 0, per_cu = 0;
        if (hipGetDevice(&dev) != hipSuccess || hipDeviceGetAttribute(&cus, hipDeviceAttributeMultiprocessorCount, dev) != hipSuccess) { grid = -1; return; }
        if (hipFuncSetAttribute((const void*)hymba_fwd, hipFuncAttributeMaxDynamicSharedMemorySize, LDS_BYTES) != hipSuccess) { fprintf(stderr, "kernel_launch: hipFuncSetAttribute failed\n"); grid = -1; return; }
        if (hipOccupancyMaxActiveBlocksPerMultiprocessor(&per_cu, (const void*)hymba_fwd, NWAVES * 64, LDS_BYTES) != hipSuccess || per_cu < 1) { fprintf(stderr, "kernel_launch: occupancy query reports %d workgroups per CU\n", per_cu); }
        (void)hipGetLastError();
        grid = cus;
    }
    if (grid < 0) return;
    if (hipMemsetAsync((char*)d_ws + WS_CTL, 0, CTL_ZERO_BYTES, stream) != hipSuccess) return;
    Args a{};
    for (int i = 0; i < 13; ++i) a.in[i] = (const float*)d_in[i];
    a.out = (float*)d_out; a.ws = (unsigned char*)d_ws;
    for (int li = 0; li < N_LAUNCHES; ++li) {
        a.ph_lo = (N_LAUNCHES == N_PHASES) ? li : 0; a.ph_hi = (N_LAUNCHES == N_PHASES) ? li + 1 : N_PHASES; a.li = (N_LAUNCHES == N_PHASES) ? 0 : li; a.pad = 0;
        hipLaunchKernelGGL(hymba_fwd, dim3(grid), dim3(NWAVES * 64), LDS_BYTES, stream, a);
    }
}
#endif
```
